# Optimizing an MI355X kernel written in HIP

```python
import jax
import jax.numpy as jnp
from jax import lax
import numpy as np

D_MODEL = 1024
BATCH = 8
SEQ = 4096
DEPTH = 1

D_CONV = D_MODEL // 2
D_LRU = D_MODEL // 2
D_MIX = D_CONV + D_LRU
CONV_WIDTH = 31
N_LRU_HEADS = 8
LRU_HEAD_DIM = D_LRU // N_LRU_HEADS
LRU_CONV_WIDTH = 4
LRU_C = 8.0
N_EXPERTS = 32
TOP_K = 4
D_EXPERT = D_MODEL
SWIGLU_ALPHA = 1.702
SWIGLU_LIMIT = 7.0
ROW_BLOCK = 128
N_MOD = 6
EPS = 1e-6

kernel_name = "hymba_conformer_rglru_moe_adaln"


def rms_norm(x, g):
    xf = x.astype(jnp.float32)
    y = xf * lax.rsqrt(jnp.mean(xf * xf, axis=-1, keepdims=True) + EPS)
    return (y * g.astype(jnp.float32)).astype(x.dtype)


def layer_norm(x, g, b):
    xf = x.astype(jnp.float32)
    mu = jnp.mean(xf, axis=-1, keepdims=True)
    var = jnp.mean(jnp.square(xf - mu), axis=-1, keepdims=True)
    y = (xf - mu) * lax.rsqrt(var + EPS)
    return (y * g.astype(jnp.float32) + b.astype(jnp.float32)).astype(x.dtype)


def causal_depthwise_conv(x, w, b):
    width, ch = w.shape
    xp = jnp.pad(x, ((0, 0), (width - 1, 0), (0, 0)))
    y = lax.conv_general_dilated(
        xp, w[:, None, :].astype(x.dtype), window_strides=(1,), padding="VALID",
        dimension_numbers=("NWC", "WIO", "NWC"), feature_group_count=ch)
    return y + b.astype(x.dtype)


def conformer_conv_group(u, conv_w, conv_b, ln_g, ln_b):
    val, gate = jnp.split(u, 2, axis=-1)
    v = val * jax.nn.sigmoid(gate)
    v = causal_depthwise_conv(v, conv_w, conv_b)
    v = layer_norm(v, ln_g, ln_b)
    return jax.nn.silu(v)


def rglru_group(u_gate, u_rec, conv_w, conv_b, w_a, b_a, w_x, b_x, lam):
    bsz, seq, _ = u_rec.shape
    xr = causal_depthwise_conv(u_rec, conv_w, conv_b)
    xh = xr.reshape(bsz, seq, N_LRU_HEADS, LRU_HEAD_DIM)
    r = jax.nn.sigmoid(jnp.einsum("bshi,hij->bshj", xh, w_a) + b_a).reshape(bsz, seq, D_LRU)
    i = jax.nn.sigmoid(jnp.einsum("bshi,hij->bshj", xh, w_x) + b_x).reshape(bsz, seq, D_LRU)
    log_a = -LRU_C * r.astype(jnp.float32) * jax.nn.softplus(-lam.astype(jnp.float32))
    a = jnp.exp(log_a)
    inp = jnp.sqrt(-jnp.expm1(2.0 * log_a)) * (i * xr).astype(jnp.float32)

    def combine(left, right):
        a1, b1 = left
        a2, b2 = right
        return a1 * a2, a2 * b1 + b2

    _, h = lax.associative_scan(combine, (a, inp), axis=1)
    return jax.nn.gelu(u_gate) * h.astype(u_gate.dtype)


def routed_experts(h, w_router, b_router, w_gate_up, b_gate_up, w_down, b_down):
    bsz, seq, dm = h.shape
    xt = h.reshape(bsz * seq, dm)
    n_tok = xt.shape[0]
    logits = (xt @ w_router + b_router).astype(jnp.float32)
    top_val, top_idx = lax.top_k(logits, TOP_K)
    gates = jax.nn.softmax(top_val, axis=-1)

    n_assign = n_tok * TOP_K
    flat_e = top_idx.reshape(-1)
    flat_g = gates.reshape(-1)
    order = jnp.argsort(flat_e)
    sorted_e = flat_e[order]
    counts = jnp.bincount(flat_e, length=N_EXPERTS)
    starts = jnp.cumsum(counts) - counts
    padded = (counts + ROW_BLOCK - 1) // ROW_BLOCK * ROW_BLOCK
    pad_ends = jnp.cumsum(padded)
    pad_starts = pad_ends - padded
    dest = pad_starts[sorted_e] + (jnp.arange(n_assign) - starts[sorted_e])
    n_rows = ((n_assign + ROW_BLOCK - 1) // ROW_BLOCK + N_EXPERTS) * ROW_BLOCK
    n_blocks = n_rows // ROW_BLOCK
    row_token = jnp.full((n_rows,), n_tok, jnp.int32).at[dest].set((order // TOP_K).astype(jnp.int32))
    row_gate = jnp.zeros((n_rows,), jnp.float32).at[dest].set(flat_g[order])
    block_expert = jnp.minimum(
        jnp.searchsorted(pad_ends, jnp.arange(n_blocks) * ROW_BLOCK, side="right"), N_EXPERTS - 1)

    x_pad = jnp.concatenate([xt, jnp.zeros((1, dm), xt.dtype)], axis=0)
    x_blocks = x_pad[row_token].reshape(n_blocks, ROW_BLOCK, dm)

    def expert_block(args):
        xb, e = args
        gu = xb @ w_gate_up[e] + b_gate_up[e]
        g = jnp.minimum(gu[:, :D_EXPERT], SWIGLU_LIMIT)
        u = jnp.clip(gu[:, D_EXPERT:], -SWIGLU_LIMIT, SWIGLU_LIMIT)
        act = (u + 1.0) * (g * jax.nn.sigmoid(SWIGLU_ALPHA * g))
        return act @ w_down[e] + b_down[e]

    y_blocks = lax.map(expert_block, (x_blocks, block_expert))
    y_rows = y_blocks.reshape(n_rows, dm) * row_gate[:, None].astype(h.dtype)
    y = jnp.zeros((n_tok + 1, dm), h.dtype).at[row_token].add(y_rows)[:n_tok]
    return y.reshape(bsz, seq, dm)


def setup_inputs(seed: int = 0) -> dict:
    key = jax.random.key(seed)
    ks = jax.random.split(key, 28)
    f32 = jnp.float32
    nrm = lambda k, shape, s: jax.random.normal(k, shape, f32) * s
    L = DEPTH
    a_c = jax.random.uniform(ks[16], (L, D_LRU), f32, minval=0.9, maxval=0.999)
    a0 = a_c ** (1.0 / LRU_C)
    lru_lambda = jnp.log(a0) - jnp.log1p(-a0)
    return {
        "x": nrm(ks[0], (BATCH, SEQ, D_MODEL), 1.0),
        "c": nrm(ks[1], (BATCH, D_MODEL), 1.0),
        "w_ada": nrm(ks[2], (L, D_MODEL, N_MOD * D_MODEL), D_MODEL ** -0.5),
        "b_ada": nrm(ks[3], (L, N_MOD * D_MODEL), 0.01),
        "norm1_g": 1.0 + nrm(ks[4], (L, D_MODEL), 0.02),
        "w_in": nrm(ks[5], (L, D_MODEL, 2 * D_MIX), D_MODEL ** -0.5),
        "conv_w": nrm(ks[6], (L, CONV_WIDTH, D_CONV), CONV_WIDTH ** -0.5),
        "conv_b": nrm(ks[7], (L, D_CONV), 0.01),
        "conv_ln_g": 1.0 + nrm(ks[8], (L, D_CONV), 0.02),
        "conv_ln_b": nrm(ks[9], (L, D_CONV), 0.01),
        "lru_conv_w": nrm(ks[10], (L, LRU_CONV_WIDTH, D_LRU), LRU_CONV_WIDTH ** -0.5),
        "lru_conv_b": nrm(ks[11], (L, D_LRU), 0.01),
        "lru_w_a": nrm(ks[12], (L, N_LRU_HEADS, LRU_HEAD_DIM, LRU_HEAD_DIM), LRU_HEAD_DIM ** -0.5),
        "lru_b_a": nrm(ks[13], (L, N_LRU_HEADS, LRU_HEAD_DIM), 0.01),
        "lru_w_x": nrm(ks[14], (L, N_LRU_HEADS, LRU_HEAD_DIM, LRU_HEAD_DIM), LRU_HEAD_DIM ** -0.5),
        "lru_b_x": nrm(ks[15], (L, N_LRU_HEADS, LRU_HEAD_DIM), 0.01),
        "lru_lambda": lru_lambda,
        "mix_norm_g": 1.0 + nrm(ks[17], (L, D_MIX), 0.02),
        "w_out": nrm(ks[18], (L, D_MIX, D_MODEL), D_MIX ** -0.5),
        "norm2_g": 1.0 + nrm(ks[19], (L, D_MODEL), 0.02),
        "w_router": nrm(ks[20], (L, D_MODEL, N_EXPERTS), D_MODEL ** -0.5),
        "b_router": nrm(ks[21], (L, N_EXPERTS), 0.01),
        "w_gate_up": nrm(ks[22], (L, N_EXPERTS, D_MODEL, 2 * D_EXPERT), D_MODEL ** -0.5),
        "b_gate_up": nrm(ks[23], (L, N_EXPERTS, 2 * D_EXPERT), 0.01),
        "w_down": nrm(ks[24], (L, N_EXPERTS, D_EXPERT, D_MODEL), D_EXPERT ** -0.5),
        "b_down": nrm(ks[25], (L, N_EXPERTS, D_MODEL), 0.01),
        "final_norm_g": 1.0 + nrm(ks[26], (D_MODEL,), 0.02),
    }


def reference(x, c, w_ada, b_ada, norm1_g, w_in, conv_w, conv_b, conv_ln_g, conv_ln_b,
              lru_conv_w, lru_conv_b, lru_w_a, lru_b_a, lru_w_x, lru_b_x, lru_lambda,
              mix_norm_g, w_out, norm2_g, w_router, b_router, w_gate_up, b_gate_up,
              w_down, b_down, final_norm_g):
    bsz, seq, dm = x.shape
    c_act = jax.nn.silu(c)
    for l in range(DEPTH):
        mod = (c_act @ w_ada[l] + b_ada[l]).reshape(bsz, N_MOD, 1, dm)
        shift1, scale1, gate1, shift2, scale2, gate2 = [mod[:, j] for j in range(N_MOD)]

        h = rms_norm(x, norm1_g[l]) * (1.0 + scale1) + shift1
        u = h @ w_in[l]
        u_conv = u[..., :2 * D_CONV]
        u_lru_gate = u[..., 2 * D_CONV:2 * D_CONV + D_LRU]
        u_lru_rec = u[..., 2 * D_CONV + D_LRU:]
        y_conv = conformer_conv_group(u_conv, conv_w[l], conv_b[l], conv_ln_g[l], conv_ln_b[l])
        y_lru = rglru_group(u_lru_gate, u_lru_rec, lru_conv_w[l], lru_conv_b[l], lru_w_a[l],
                            lru_b_a[l], lru_w_x[l], lru_b_x[l], lru_lambda[l])
        y = jnp.concatenate([y_conv, y_lru], axis=-1).reshape(bsz, seq, 2, D_MIX // 2)
        y = rms_norm(y, mix_norm_g[l].reshape(2, D_MIX // 2)).reshape(bsz, seq, D_MIX)
        x = x + gate1 * (y @ w_out[l])

        h = rms_norm(x, norm2_g[l]) * (1.0 + scale2) + shift2
        x = x + gate2 * routed_experts(h, w_router[l], b_router[l], w_gate_up[l], b_gate_up[l],
                                       w_down[l], b_down[l])
    return rms_norm(x, final_norm_g)
```

```cpp
#include <hip/hip_runtime.h>
#include <cstdio>
#include <cstdint>

#define GAS __attribute__((address_space(1)))
#define LAS __attribute__((address_space(3)))
typedef unsigned short bf16;
typedef unsigned v4u __attribute__((ext_vector_type(4)));
typedef unsigned v2u __attribute__((ext_vector_type(2)));
typedef float f32x4 __attribute__((ext_vector_type(4)));
typedef float f32x2 __attribute__((ext_vector_type(2)));
typedef short bf16x8 __attribute__((ext_vector_type(8)));
typedef GAS unsigned gu32;
#define RLX_AGENT __ATOMIC_RELAXED, __HIP_MEMORY_SCOPE_AGENT
#define LDS_WAIT() asm volatile("s_waitcnt lgkmcnt(0)" ::: "memory")
#define VM_WAIT() asm volatile("s_waitcnt vmcnt(0)" ::: "memory")

constexpr int NB = 8, SEQ = 4096, T = NB * SEQ, D = 1024, DC = 512, NE = 32, TOPK = 4, DE = 1024, NMODW = 6 * D;
constexpr int NPAIR = T * TOPK, MAXROWS = NPAIR + NE * 256, MAXMT = MAXROWS / 256;
constexpr float EPS = 1e-6f;
constexpr int NWAVES = 8;
#ifndef MK_N_LAUNCHES
#define MK_N_LAUNCHES 1
#endif
constexpr int N_LAUNCHES = MK_N_LAUNCHES;
constexpr int PER_PHASE = 11;

constexpr size_t MiB = 1u << 20, KiB = 1024;
constexpr size_t WS_CTL = 0, CTL_ZERO_BYTES = 1 * MiB;
constexpr size_t WS_MODP = 1 * MiB;
constexpr size_t WS_MODF = 2 * MiB;
constexpr size_t WS_WRH = 2 * MiB + 256 * KiB, WS_WRL = WS_WRH + 64 * KiB;
constexpr size_t WS_SUMA = 2 * MiB + 512 * KiB, WS_SUMH = 3 * MiB;
constexpr size_t WS_TOPI = 3 * MiB + 512 * KiB, WS_TOPG = 4 * MiB, WS_LRANK = 4 * MiB + 512 * KiB, WS_POSOF = 5 * MiB;
constexpr size_t WS_BCNT = 5 * MiB + 512 * KiB, WS_META = WS_BCNT + 64 * KiB;
constexpr size_t WS_ROWTOK = 6 * MiB;
constexpr size_t WS_LRUB = 7 * MiB;
constexpr size_t WS_WIN = 16 * MiB, WS_WOUT = 20 * MiB, WS_WD = 24 * MiB, WS_WGU = 88 * MiB;
constexpr size_t WS_H = 216 * MiB;
constexpr size_t WS_V = 280 * MiB, WS_GG = 312 * MiB, WS_UREC = 344 * MiB;
constexpr size_t WS_X1 = 376 * MiB;
constexpr size_t WS_ACT = 504 * MiB;
constexpr size_t WS_Y = 88 * MiB;
constexpr size_t WS_END = 776 * MiB;
static_assert(WS_Y + (size_t)MAXROWS * DE * 2 <= WS_X1 && WS_ACT + (size_t)MAXROWS * DE * 2 <= WS_END, "ws map");
constexpr int CW_BAR = 4096;

constexpr int RING_BYTES = 131072, AUX_OFF = 131072, AUX_BYTES = 24576, LDSCTL_OFF = AUX_OFF + AUX_BYTES, MISC_OFF = LDSCTL_OFF + 320, LDS_BYTES = LDSCTL_OFF + 1024;
constexpr int AUX_TEXP = 18432;
static_assert(AUX_TEXP + MAXMT * 4 <= AUX_BYTES, "aux");

__device__ __forceinline__ unsigned f2bf(float f) { unsigned u = __builtin_bit_cast(unsigned, f); return (u + 0x7fffu + ((u >> 16) & 1u)) >> 16; }
__device__ __forceinline__ unsigned pk2(float lo, float hi) { return f2bf(lo) | (f2bf(hi) << 16); }
__device__ __forceinline__ float bf2f(unsigned b) { return __builtin_bit_cast(float, b << 16); }
__device__ __forceinline__ float bflo(unsigned w) { return __builtin_bit_cast(float, w << 16); }
__device__ __forceinline__ float bfhi(unsigned w) { return __builtin_bit_cast(float, w & 0xffff0000u); }
__device__ __forceinline__ float sigmoidf_(float z) { return __builtin_amdgcn_rcpf(1.0f + __expf(-z)); }

namespace pg8 {
#define PG8_LAS __attribute__((address_space(3)))
typedef unsigned short bf16_t;
typedef unsigned u32x4 __attribute__((ext_vector_type(4)));
constexpr int BM = 256, BK = 64, HALF = 128, HTB = HALF * BK * 2, STAGE_BYTES = 8 * HTB, NXCD = 8, WGM = 8;
__host__ __device__ __forceinline__ int lds_byte(int r, int c) { const int st = (r >> 4) * 2 + (c >> 5), rr = r & 15, cc = c & 31, ob = rr * 64 + cc * 2; return st * 1024 + (ob ^ (((ob >> 9) & 1) << 5)); }
__host__ __device__ __forceinline__ void stage_rc(int b, int& R, int& C) { const int st = b / 1024, sb = b % 1024, swz = sb ^ (((sb >> 9) & 1) << 5); R = (st >> 1) * 16 + swz / 64; C = (st & 1) * 32 + (swz % 64) / 2; }
__host__ __device__ __forceinline__ int perm32(int rho) { const int n = rho >> 4, i = rho & 15; return 8 * (i >> 2) + 4 * n + (i & 3); }
__device__ __forceinline__ unsigned cvt_pk_bf16(float lo, float hi) { unsigned r; asm volatile("v_cvt_pk_bf16_f32 %0, %1, %2" : "=v"(r) : "v"(lo), "v"(hi)); return r; }

struct Unit { int pm, pn, e; };

struct Order {
    int nM, nN, nwg, G, c; const char* A; const char* Bt; size_t tstep, estep; const PG8_LAS int* texp; bool gather;
    __device__ __forceinline__ void init(int nM_, int nN_, int G_, int c_, const void* A_, const void* Bt_, int K, size_t estep_, const PG8_LAS int* texp_, bool gather_) {
        nM = nM_; nN = nN_; nwg = nM * nN; G = G_; c = c_; A = (const char*)A_; Bt = (const char*)Bt_; tstep = (size_t)BM * K * 2; estep = estep_; texp = texp_; gather = gather_; }
    __device__ __forceinline__ bool next(int i, Unit& u) const {
        const long L = (long)i * G + c; if (L >= nwg) return false;
        int wgid = (int)L; { const int q = nwg / NXCD, r = nwg % NXCD, xcd = wgid % NXCD, off = wgid / NXCD; wgid = (xcd < r ? xcd * (q + 1) : r * (q + 1) + (xcd - r) * q) + off; }
        const int nig = WGM * nN, gid = wgid / nig, fm = gid * WGM, gsz = (nM - fm) < WGM ? (nM - fm) : WGM;
        u.pm = fm + ((wgid % nig) % gsz); u.pn = (wgid % nig) / gsz; u.e = texp ? texp[u.pm] : 0; return true;
    }
    __device__ __forceinline__ const char* a_base(const Unit& u) const { return gather ? A : A + (size_t)u.pm * tstep; }
    __device__ __forceinline__ const char* b_base(const Unit& u) const { return Bt + (size_t)u.e * estep + (size_t)u.pn * tstep; }
};

template <class Epi, class Sched, bool GATHER, bool ALIGN_EPI, bool SP2>
__device__ __forceinline__ void gemm_phase(PG8_LAS unsigned char* lds, const int K, const Sched& S, const Epi& E, const PG8_LAS unsigned* gtab) {
    const int tid = threadIdx.x, wid = __builtin_amdgcn_readfirstlane(tid >> 6), lane = tid & 63, wr = wid >> 2, wc = wid & 3, fr = lane & 15, fq = lane >> 4;
    const int nt = K / BK;
    unsigned voffA[2], voffB[2]; unsigned offA[2][2]; int gR[2]; unsigned gC[2];
#pragma unroll
    for (int i = 0; i < 2; ++i) { int R, C; stage_rc(tid * 16 + i * 8192, R, C); const int Rb = Epi::PERM ? ((R & ~31) + perm32(R & 31)) : R;
        voffA[i] = (unsigned)(R * K + C) * 2u; voffB[i] = (unsigned)(Rb * K + C) * 2u; gR[i] = R; gC[i] = (unsigned)C * 2u; offA[0][i] = 0; offA[1][i] = 0; }
    const size_t kstep = (size_t)(BK * 2);
    const size_t hstep = (size_t)HALF * K * 2;
    const unsigned ldsw = (unsigned)wid * 1024u;
    const int aoff = lds_byte(wr * 64 + fr, fq * 8), boff = lds_byte(wc * 32 + fr, fq * 8);
#define PG8_SA(b, h) (((b) * 2 + (h)) * HTB)
#define PG8_SB(b, h) ((4 + (b) * 2 + (h)) * HTB)
#define PG8_STAGE(bufoff, gbase, voff) do { _Pragma("unroll") for (int _i = 0; _i < 2; ++_i) \
        __builtin_amdgcn_global_load_lds((const unsigned*)((const char*)(gbase) + (voff)[_i]), (PG8_LAS unsigned*)(lds + (bufoff) + ldsw + _i * 8192), 16, 0, 0); } while (0)
#define PG8_STAGE_A(b, h, kbase) do { if constexpr (GATHER) { PG8_STAGE(PG8_SA(b, h), (kbase), offA[h]); } else { PG8_STAGE(PG8_SA(b, h), (kbase) + (h) * hstep, voffA); } } while (0)
#define PG8_STAGE_B(b, h, kbase) PG8_STAGE(PG8_SB(b, h), (kbase) + (h) * hstep, voffB)
#define PG8_LOAD_OFFS(slot) do { _Pragma("unroll") for (int _h = 0; _h < 2; ++_h) _Pragma("unroll") for (int _i = 0; _i < 2; ++_i) offA[_h][_i] = gtab[(slot) * 256 + _h * 128 + gR[_i]] + gC[_i]; } while (0)
#define PG8_LDA(dst, b, h) do { _Pragma("unroll") for (int m = 0; m < 4; ++m) _Pragma("unroll") for (int k = 0; k < 2; ++k) dst[m][k] = *(const PG8_LAS bf16x8*)(lds + PG8_SA(b, h) + aoff + m * 2048 + k * 1024); } while (0)
#define PG8_LDB(dst, b, h) do { _Pragma("unroll") for (int n = 0; n < 2; ++n) _Pragma("unroll") for (int k = 0; k < 2; ++k) dst[n][k] = *(const PG8_LAS bf16x8*)(lds + PG8_SB(b, h) + boff + n * 2048 + k * 1024); } while (0)
#define PG8_MMA(ai, bj, At, Bt) do { __builtin_amdgcn_s_setprio(1); _Pragma("unroll") for (int m = 0; m < 4; ++m) _Pragma("unroll") for (int n = 0; n < 2; ++n) _Pragma("unroll") for (int k = 0; k < 2; ++k) \
        acc[ai][bj][m][n] = __builtin_amdgcn_mfma_f32_16x16x32_bf16(Bt[n][k], At[m][k], acc[ai][bj][m][n], 0, 0, 0); __builtin_amdgcn_s_setprio(0); } while (0)
#define PG8_WAIT_V(n) asm volatile("s_waitcnt vmcnt(" #n ")" ::: "memory")
#define PG8_WAIT_L(n) asm volatile("s_waitcnt lgkmcnt(" #n ")" ::: "memory")
#define PG8_BAR __builtin_amdgcn_s_barrier()
#define PG8_SCHED __builtin_amdgcn_sched_barrier(0)
    Unit cur, nxt; int ui = 0;
    if (!S.next(0, cur)) return;
    f32x4 acc[2][2][4][2];
#pragma unroll
    for (int a = 0; a < 2; ++a)
#pragma unroll
        for (int b = 0; b < 2; ++b)
#pragma unroll
            for (int m = 0; m < 4; ++m)
#pragma unroll
                for (int n = 0; n < 2; ++n) acc[a][b][m][n] = (f32x4){0.f, 0.f, 0.f, 0.f};
    bf16x8 At[4][2], B0[2][2], B1[2][2];
    const char* cA = S.a_base(cur); const char* cB = S.b_base(cur);
    if constexpr (GATHER) { PG8_LOAD_OFFS(0); }
    if constexpr (SP2) {
        PG8_STAGE_B(0, 0, cB); PG8_STAGE_B(0, 1, cB); PG8_STAGE_A(0, 0, cA); PG8_STAGE_A(0, 1, cA);
        if (wr == 1) PG8_BAR;
        PG8_WAIT_V(2); PG8_BAR;
        PG8_STAGE_B(1, 0, cB + kstep); PG8_STAGE_A(1, 0, cA + kstep); PG8_STAGE_B(1, 1, cB + kstep);
        PG8_WAIT_V(6); PG8_BAR;
    } else {
        PG8_STAGE_B(0, 0, cB); PG8_STAGE_A(0, 0, cA); PG8_STAGE_B(0, 1, cB); PG8_STAGE_A(0, 1, cA);
        if (wr == 1) PG8_BAR;
        PG8_WAIT_V(4); PG8_BAR;
        PG8_STAGE_B(1, 0, cB + kstep); PG8_STAGE_A(1, 0, cA + kstep); PG8_STAGE_B(1, 1, cB + kstep);
        PG8_WAIT_V(6); PG8_BAR;
    }
    for (;;) {
        const bool has_next = S.next(ui + 1, nxt);
        const char* nA = has_next ? S.a_base(nxt) : cA; const char* nB = has_next ? S.b_base(nxt) : cB;
        for (int t = 0; t < nt; t += 2) {
            const bool last = (t == nt - 2);
            const char* a1 = cA + (size_t)(t + 1) * kstep;
            const char* a2 = last ? nA : cA + (size_t)(t + 2) * kstep; const char* b2 = last ? nB : cB + (size_t)(t + 2) * kstep;
            const char* a3 = a2 + kstep; const char* b3 = b2 + kstep;
            if constexpr (SP2) {
            PG8_LDB(B0, 0, 0); PG8_LDB(B1, 0, 1); PG8_SCHED; PG8_LDA(At, 0, 0); PG8_STAGE_A(1, 1, a1);
            PG8_WAIT_V(8); PG8_WAIT_L(0); PG8_BAR; PG8_MMA(0, 0, At, B0); PG8_MMA(0, 1, At, B1); PG8_BAR; PG8_SCHED;
            if constexpr (GATHER) { if (last && has_next) { PG8_LOAD_OFFS(ui + 1); } }
            PG8_LDA(At, 0, 1); PG8_STAGE_B(0, 0, b2); PG8_STAGE_B(0, 1, b2); PG8_STAGE_A(0, 0, a2);
            PG8_WAIT_V(8); PG8_WAIT_L(0); PG8_BAR; PG8_MMA(1, 0, At, B0); PG8_MMA(1, 1, At, B1); PG8_BAR; PG8_SCHED;
            PG8_LDB(B0, 1, 0); PG8_LDB(B1, 1, 1); PG8_SCHED; PG8_LDA(At, 1, 0); PG8_STAGE_A(0, 1, a2);
            PG8_WAIT_V(8); PG8_WAIT_L(0); PG8_BAR; PG8_MMA(0, 0, At, B0); PG8_MMA(0, 1, At, B1); PG8_BAR; PG8_SCHED;
            PG8_LDA(At, 1, 1); PG8_STAGE_B(1, 0, b3); PG8_STAGE_B(1, 1, b3); PG8_STAGE_A(1, 0, a3);
            PG8_WAIT_V(8); PG8_WAIT_L(0); PG8_BAR; PG8_MMA(1, 0, At, B0); PG8_MMA(1, 1, At, B1); PG8_BAR; PG8_SCHED;
            } else {
            PG8_LDB(B0, 0, 0); PG8_SCHED; PG8_LDA(At, 0, 0); PG8_STAGE_A(1, 1, a1);
            PG8_WAIT_L(8); PG8_BAR; PG8_WAIT_L(0); PG8_MMA(0, 0, At, B0); PG8_BAR; PG8_SCHED;
            if constexpr (GATHER) { if (last && has_next) { PG8_LOAD_OFFS(ui + 1); } }
            PG8_LDB(B1, 0, 1); PG8_STAGE_B(0, 0, b2);
            PG8_BAR; PG8_WAIT_L(0); PG8_MMA(0, 1, At, B1); PG8_BAR;
            PG8_LDA(At, 0, 1); PG8_STAGE_A(0, 0, a2);
            PG8_BAR; PG8_WAIT_L(0); PG8_MMA(1, 0, At, B0); PG8_BAR; PG8_SCHED;
            PG8_STAGE_B(0, 1, b2);
            PG8_WAIT_V(6); PG8_BAR; PG8_MMA(1, 1, At, B1); PG8_BAR;
            PG8_LDB(B0, 1, 0); PG8_SCHED; PG8_LDA(At, 1, 0); PG8_STAGE_A(0, 1, a2);
            PG8_WAIT_L(8); PG8_BAR; PG8_WAIT_L(0); PG8_MMA(0, 0, At, B0); PG8_BAR; PG8_SCHED;
            PG8_LDB(B1, 1, 1); PG8_STAGE_B(1, 0, b3);
            PG8_BAR; PG8_WAIT_L(0); PG8_MMA(0, 1, At, B1); PG8_BAR;
            PG8_LDA(At, 1, 1); PG8_STAGE_A(1, 0, a3);
            PG8_BAR; PG8_WAIT_L(0); PG8_MMA(1, 0, At, B0); PG8_BAR; PG8_SCHED;
            PG8_STAGE_B(1, 1, b3);
            PG8_WAIT_V(6); PG8_BAR; PG8_MMA(1, 1, At, B1); PG8_BAR;
            }
        }
        if constexpr (ALIGN_EPI) { if (wr == 0) PG8_BAR; }
        E(acc, cur, wr, wc, fr, fq);
        if (!has_next) break;
#pragma unroll
        for (int a = 0; a < 2; ++a)
#pragma unroll
            for (int b = 0; b < 2; ++b)
#pragma unroll
                for (int m = 0; m < 4; ++m)
#pragma unroll
                    for (int n = 0; n < 2; ++n) acc[a][b][m][n] = (f32x4){0.f, 0.f, 0.f, 0.f};
        cur = nxt; cA = nA; cB = nB; ++ui;
        if constexpr (ALIGN_EPI) { if (wr == 1) PG8_BAR; }
    }
    PG8_WAIT_V(0);
    if constexpr (!ALIGN_EPI) { if (wr == 0) PG8_BAR; }
    PG8_BAR;
#undef PG8_SA
#undef PG8_SB
#undef PG8_STAGE
#undef PG8_STAGE_A
#undef PG8_STAGE_B
#undef PG8_LOAD_OFFS
#undef PG8_LDA
#undef PG8_LDB
#undef PG8_MMA
#undef PG8_WAIT_V
#undef PG8_WAIT_L
#undef PG8_BAR
#undef PG8_SCHED
}

struct EpiInProj {
    static constexpr bool PERM = true;
    bf16_t* V; bf16_t* GG; bf16_t* UR;
    __device__ __forceinline__ void operator()(const f32x4 (&acc)[2][2][4][2], const Unit& u, int wr, int wc, int fr, int fq) const {
        const int row0 = u.pm * BM + wr * 64 + fr, cl = wc * 32 + 8 * fq;
        if (u.pn < 4) {
#pragma unroll
            for (int ai = 0; ai < 2; ++ai)
#pragma unroll
                for (int m = 0; m < 4; ++m) { float o[8];
#pragma unroll
                    for (int n = 0; n < 2; ++n)
#pragma unroll
                        for (int j = 0; j < 4; ++j) o[4 * n + j] = acc[ai][0][m][n][j] * sigmoidf_(acc[ai][1][m][n][j]);
                    u32x4 w; w.x = cvt_pk_bf16(o[0], o[1]); w.y = cvt_pk_bf16(o[2], o[3]); w.z = cvt_pk_bf16(o[4], o[5]); w.w = cvt_pk_bf16(o[6], o[7]);
                    *(u32x4*)(V + (size_t)(row0 + ai * HALF + m * 16) * 512 + u.pn * 128 + cl) = w; }
        } else {
            const bool gel = u.pn < 6; bf16_t* base = gel ? GG : UR; const int c0 = (gel ? u.pn - 4 : u.pn - 6) * 256 + cl;
#pragma unroll
            for (int ai = 0; ai < 2; ++ai)
#pragma unroll
                for (int m = 0; m < 4; ++m)
#pragma unroll
                    for (int bj = 0; bj < 2; ++bj) { float o[8];
#pragma unroll
                        for (int n = 0; n < 2; ++n)
#pragma unroll
                            for (int j = 0; j < 4; ++j) { const float x = acc[ai][bj][m][n][j];
                                o[4 * n + j] = gel ? x * sigmoidf_(1.5957691216f * (x + 0.044715f * x * x * x)) : x; }
                        u32x4 w; w.x = cvt_pk_bf16(o[0], o[1]); w.y = cvt_pk_bf16(o[2], o[3]); w.z = cvt_pk_bf16(o[4], o[5]); w.w = cvt_pk_bf16(o[6], o[7]);
                        *(u32x4*)(base + (size_t)(row0 + ai * HALF + m * 16) * 512 + c0 + bj * HALF) = w; }
        }
    }
};
struct EpiOutProj {
    static constexpr bool PERM = false;
    const float* X; float* X1; const float* modf;
    __device__ __forceinline__ void operator()(const f32x4 (&acc)[2][2][4][2], const Unit& u, int wr, int wc, int fr, int fq) const {
        const int row0 = u.pm * BM + wr * 64 + fr, col0 = u.pn * BM + wc * 32 + 4 * fq; const int b = (u.pm * BM) / SEQ;
        f32x4 gv[2][2];
#pragma unroll
        for (int bj = 0; bj < 2; ++bj)
#pragma unroll
            for (int n = 0; n < 2; ++n) gv[bj][n] = *(const f32x4*)(modf + (size_t)b * NMODW + 2 * D + col0 + bj * HALF + n * 16);
#pragma unroll
        for (int ai = 0; ai < 2; ++ai)
#pragma unroll
            for (int m = 0; m < 4; ++m) { const size_t off = (size_t)(row0 + ai * HALF + m * 16) * D + col0;
#pragma unroll
                for (int bj = 0; bj < 2; ++bj)
#pragma unroll
                    for (int n = 0; n < 2; ++n) { const f32x4 xv = *(const f32x4*)(X + off + bj * HALF + n * 16); *(f32x4*)(X1 + off + bj * HALF + n * 16) = xv + gv[bj][n] * acc[ai][bj][m][n]; }
                asm volatile("" ::: "memory"); }
    }
};
struct EpiSwiglu {
    static constexpr bool PERM = true;
    bf16_t* ACT; const float* bgu;
    __device__ __forceinline__ void operator()(const f32x4 (&acc)[2][2][4][2], const Unit& u, int wr, int wc, int fr, int fq) const {
        const int row0 = u.pm * BM + wr * 64 + fr, col0 = u.pn * 128 + wc * 32 + 8 * fq;
        const float* bb = bgu + (size_t)u.e * 2 * DE + col0;
        const f32x4 bg0 = *(const f32x4*)(bb), bg1 = *(const f32x4*)(bb + 4), bu0 = *(const f32x4*)(bb + DE), bu1 = *(const f32x4*)(bb + DE + 4);
#pragma unroll
        for (int ai = 0; ai < 2; ++ai)
#pragma unroll
            for (int m = 0; m < 4; ++m) { float o[8];
#pragma unroll
                for (int n = 0; n < 2; ++n)
#pragma unroll
                    for (int j = 0; j < 4; ++j) { float g = acc[ai][0][m][n][j] + (n ? bg1[j] : bg0[j]), uu = acc[ai][1][m][n][j] + (n ? bu1[j] : bu0[j]);
                        g = fminf(g, 7.0f); uu = fminf(fmaxf(uu, -7.0f), 7.0f); o[4 * n + j] = (uu + 1.0f) * (g * sigmoidf_(1.702f * g)); }
                u32x4 w; w.x = cvt_pk_bf16(o[0], o[1]); w.y = cvt_pk_bf16(o[2], o[3]); w.z = cvt_pk_bf16(o[4], o[5]); w.w = cvt_pk_bf16(o[6], o[7]);
                *(u32x4*)(ACT + (size_t)(row0 + ai * HALF + m * 16) * DE + col0) = w; }
    }
};
struct EpiDown {
    static constexpr bool PERM = true;
    bf16_t* Y; const float* bd;
    __device__ __forceinline__ void operator()(const f32x4 (&acc)[2][2][4][2], const Unit& u, int wr, int wc, int fr, int fq) const {
        const int row0 = u.pm * BM + wr * 64 + fr, col0 = u.pn * BM + wc * 32 + 8 * fq;
        const float* bb = bd + (size_t)u.e * D + col0;
        f32x4 bv[2][2];
#pragma unroll
        for (int bj = 0; bj < 2; ++bj) { bv[bj][0] = *(const f32x4*)(bb + bj * HALF); bv[bj][1] = *(const f32x4*)(bb + bj * HALF + 4); }
#pragma unroll
        for (int ai = 0; ai < 2; ++ai)
#pragma unroll
            for (int m = 0; m < 4; ++m)
#pragma unroll
                for (int bj = 0; bj < 2; ++bj) { const f32x4 v0 = acc[ai][bj][m][0] + bv[bj][0], v1 = acc[ai][bj][m][1] + bv[bj][1];
                    u32x4 w; w.x = cvt_pk_bf16(v0[0], v0[1]); w.y = cvt_pk_bf16(v0[2], v0[3]); w.z = cvt_pk_bf16(v1[0], v1[1]); w.w = cvt_pk_bf16(v1[2], v1[3]);
                    *(u32x4*)(Y + (size_t)(row0 + ai * HALF + m * 16) * D + col0 + bj * HALF) = w; }
    }
};
}

#define XB_TMO      128
#define XB_XCNT(j)  (256  + 64 * (j))
#define XB_XSUB(j)  (1280 + 64 * (j))
#define XB_XGEN(j)  (2304 + 64 * (j))
#define XB_TOP      3328
#define XB_TOPGEN   3392
#define XCD_BAR_WORDS 3456
#define XB_SPIN_CAP (1u << 18)
__device__ __forceinline__ unsigned xb_ld(unsigned* p)              { return __hip_atomic_load(p, __ATOMIC_RELAXED, __HIP_MEMORY_SCOPE_AGENT); }
__device__ __forceinline__ unsigned xb_add(unsigned* p, unsigned v) { return __hip_atomic_fetch_add(p, v, __ATOMIC_RELAXED, __HIP_MEMORY_SCOPE_AGENT); }
__device__ __forceinline__ unsigned xb_xcc_id() { return (unsigned)__builtin_amdgcn_s_getreg((3 << 11) | 20) & 0xFu; }
#define XB_SPIN(cond, bar) do { unsigned _sp = 0; while (cond) { __builtin_amdgcn_s_sleep(1); \
    if ((++_sp & 255u) == 0u) { if (xb_ld(&(bar)[XB_TMO])) break; if (_sp > XB_SPIN_CAP) { atomicAdd(&(bar)[XB_TMO], 1u); break; } } } } while (0)
struct XcdBarrier { unsigned* bar; unsigned x; volatile LAS unsigned* st; };
__device__ __forceinline__ XcdBarrier xcd_barrier_post(unsigned* bar, volatile LAS unsigned* st) {
    XcdBarrier b; b.bar = bar; b.x = xb_xcc_id(); b.st = st;
    if (threadIdx.x == 0) (void)xb_add(&bar[XB_XCNT(b.x)], 1u);
    return b;
}
__device__ __forceinline__ void xcd_barrier_complete(unsigned* bar, unsigned x, unsigned& nloc, unsigned& nx) {
    const unsigned G = gridDim.x * gridDim.y * gridDim.z;
    unsigned sum, cnt, mine, sp = 0u;
    for (;;) {
        sum = 0u; cnt = 0u; mine = 0u;
#pragma unroll
        for (unsigned j = 0; j < 16; ++j) { const unsigned c = xb_ld(&bar[XB_XCNT(j)]); sum += c; cnt += (c > 0u) ? 1u : 0u; mine = (j == x) ? c : mine; }
        if (sum == G) break;
        __builtin_amdgcn_s_sleep(1);
        if ((++sp & 255u) == 0u) { if (xb_ld(&bar[XB_TMO])) break; if (sp > XB_SPIN_CAP) { atomicAdd(&bar[XB_TMO], 1u); break; } }
    }
    nloc = mine > 0u ? mine : 1u; nx = cnt > 0u ? cnt : 1u;
}
__device__ __forceinline__ void xcd_barrier(const XcdBarrier& b) {
    asm volatile("s_waitcnt vmcnt(0)" ::: "memory");
    __syncthreads();
    if (threadIdx.x == 0) {
        unsigned* bar = b.bar;
        __builtin_amdgcn_s_waitcnt(0);
        unsigned nloc = b.st[0], nx = b.st[1];
        if (nloc == 0u) { xcd_barrier_complete(bar, b.x, nloc, nx); b.st[0] = nloc; b.st[1] = nx; }
        const unsigned old = xb_add(&bar[XB_XSUB(b.x)], 1u);
        const unsigned gen = old / nloc;
        if (old + 1u == (gen + 1u) * nloc) {
            __builtin_amdgcn_fence(__ATOMIC_RELEASE, "agent");
            asm volatile("s_waitcnt vmcnt(0)" ::: "memory");
            const unsigned og = xb_add(&bar[XB_TOP], 1u);
            const unsigned tg = og / nx;
            if (og + 1u == (tg + 1u) * nx) xb_add(&bar[XB_TOPGEN], 1u);
            else XB_SPIN(xb_ld(&bar[XB_TOPGEN]) == tg, bar);
            __builtin_amdgcn_fence(__ATOMIC_ACQUIRE, "agent");
            xb_add(&bar[XB_XGEN(b.x)], 1u);
            asm volatile("s_waitcnt vmcnt(0)" ::: "memory");
        } else {
            XB_SPIN(xb_ld(&bar[XB_XGEN(b.x)]) == gen, bar);
            __builtin_amdgcn_fence(__ATOMIC_ACQUIRE, "agent");
            asm volatile("s_waitcnt vmcnt(0)" ::: "memory");
        }
    }
    __syncthreads();
}

struct Frame {
    LAS unsigned char* lds;
    volatile LAS unsigned* MISC;
    gu32* ctl;
    int tid, lane, wave, G, bx;
    float* out; unsigned char* ws;
};
struct Args { const float* in[27]; float* out; unsigned char* ws; int ph_lo, ph_hi, li, pad; };
enum { I_X = 0, I_C, I_WADA, I_BADA, I_N1G, I_WIN, I_CONVW, I_CONVB, I_CLNG, I_CLNB, I_LCW, I_LCB, I_LWA, I_LBA, I_LWX, I_LBX, I_LAM, I_MIXG, I_WOUT, I_N2G, I_WR, I_BR, I_WGU, I_BGU, I_WD, I_BD, I_FNG };

__device__ __forceinline__ float wave_sum(float v) {
#pragma unroll
    for (int o = 1; o < 64; o <<= 1) v += __shfl_xor(v, o);
    return v;
}

__device__ __forceinline__ void p0_transpose_item(const float* W, int K, int N, bf16* WT, int drow0, LAS float* scr, int k0, int n0, int lane) {
#pragma unroll 8
    for (int i = 0; i < 32; ++i) { const int kk = 2 * i + (lane >> 5); scr[kk * 33 + (lane & 31)] = W[(size_t)(k0 + kk) * N + n0 + (lane & 31)]; }
    LDS_WAIT(); asm volatile("" ::: "memory");
    const int c = lane & 7;
#pragma unroll
    for (int j = 0; j < 4; ++j) { const int n = (lane >> 3) + 8 * j; const LAS float* s = scr + (8 * c) * 33 + n;
        v4u o; o.x = pk2(s[0 * 33], s[1 * 33]); o.y = pk2(s[2 * 33], s[3 * 33]); o.z = pk2(s[4 * 33], s[5 * 33]); o.w = pk2(s[6 * 33], s[7 * 33]);
        *(GAS v4u*)(WT + (size_t)(drow0 + n) * K + k0 + 8 * c) = o; }
    LDS_WAIT(); asm volatile("" ::: "memory");
}
__device__ __forceinline__ void p0_router_item(const float* W, bf16* WH, bf16* WL, LAS float* scr, int k0, int lane) {
#pragma unroll 8
    for (int i = 0; i < 32; ++i) { const int kk = 2 * i + (lane >> 5); scr[kk * 33 + (lane & 31)] = W[(size_t)(k0 + kk) * NE + (lane & 31)]; }
    LDS_WAIT(); asm volatile("" ::: "memory");
    const int c = lane & 7;
#pragma unroll
    for (int j = 0; j < 4; ++j) { const int n = (lane >> 3) + 8 * j; const LAS float* s = scr + (8 * c) * 33 + n;
        float v[8]; unsigned h[8], l[8];
#pragma unroll
        for (int e = 0; e < 8; ++e) { v[e] = s[e * 33]; h[e] = f2bf(v[e]); l[e] = f2bf(v[e] - bf2f(h[e])); }
        v4u oh, ol; oh.x = h[0] | (h[1] << 16); oh.y = h[2] | (h[3] << 16); oh.z = h[4] | (h[5] << 16); oh.w = h[6] | (h[7] << 16);
        ol.x = l[0] | (l[1] << 16); ol.y = l[2] | (l[3] << 16); ol.z = l[4] | (l[5] << 16); ol.w = l[6] | (l[7] << 16);
        *(GAS v4u*)(WH + (size_t)n * D + k0 + 8 * c) = oh; *(GAS v4u*)(WL + (size_t)n * D + k0 + 8 * c) = ol; }
    LDS_WAIT(); asm volatile("" ::: "memory");
}
__device__ __forceinline__ void p0_mod_item(Frame& F, const Args& args, LAS float* scr, int item) {
    const int cg = item % 96, ks = item / 96, col = cg * 64 + F.lane, k0 = ks * 256;
    const float* c = args.in[I_C]; const float* W = args.in[I_WADA];
#pragma unroll 4
    for (int i = 0; i < 32; ++i) { const int idx = i * 64 + F.lane, b = idx >> 8, kk = idx & 255; const float v = c[b * D + k0 + kk]; scr[idx] = v / (1.0f + __expf(-v)); }
    LDS_WAIT(); asm volatile("" ::: "memory");
    float acc[8];
#pragma unroll
    for (int b = 0; b < 8; ++b) acc[b] = 0.f;
#pragma unroll 4
    for (int kk = 0; kk < 256; kk += 4) {
        const float* wp = W + (size_t)(k0 + kk) * NMODW + col;
        const float w0 = wp[0], w1 = wp[NMODW], w2 = wp[2 * NMODW], w3 = wp[3 * NMODW];
#pragma unroll
        for (int b = 0; b < 8; ++b) { const f32x4 cv = *(const LAS f32x4*)(scr + b * 256 + kk); acc[b] += (cv.x * w0 + cv.y * w1) + (cv.z * w2 + cv.w * w3); }
    }
    float* mp = (float*)(F.ws + WS_MODP);
#pragma unroll
    for (int b = 0; b < 8; ++b) mp[(size_t)(ks * 8 + b) * NMODW + col] = acc[b];
    LDS_WAIT(); asm volatile("" ::: "memory");
}
__device__ __forceinline__ void p0_lrufrag_item(const Args& args, unsigned char* ws, int h, int lane) {
    const int j = lane & 15, q = lane >> 4;
#pragma unroll 1
    for (int f = 0; f < 16; ++f) { const int mat = f >> 3, n = (f >> 1) & 3, s = f & 1;
        const float* p = (mat ? args.in[14] : args.in[12]) + (size_t)(h * 64 + 32 * s + 8 * q) * 64 + 16 * n + j;
        v4u o; o.x = pk2(p[0], p[64]); o.y = pk2(p[128], p[192]); o.z = pk2(p[256], p[320]); o.w = pk2(p[384], p[448]);
        *((GAS v4u*)(ws + WS_LRUB) + (size_t)((h * 2 + mat) * 8 + n * 2 + s) * 64 + lane) = o; }
}
__device__ __forceinline__ int glu_row(int n, int half) {
    return n < half ? 256 * (n >> 7) + (n & 127) : 256 * ((n - half) >> 7) + 128 + ((n - half) & 127);
}
__device__ __forceinline__ void p0_prologue(Frame& F, const Args& args) {
    LAS float* scr = (LAS float*)(F.lds + F.wave * 16384);
    const int gw = F.bx * NWAVES + F.wave, NGW = F.G * NWAVES;
    if (gw >= NGW - 8) p0_lrufrag_item(args, F.ws, gw - (NGW - 8), F.lane);
    constexpr int I_MOD = 96 * 4, I_RT = 16, I_IN = 16 * 64, I_OUT = 16 * 32, I_GU = 32 * 16 * 64, I_DN = 32 * 16 * 32;
    constexpr int NITEMS = I_MOD + I_RT + I_IN + I_OUT + I_GU + I_DN;
    for (int it = gw; it < NITEMS; it += NGW) {
        int r = it;
        if (r < I_MOD) { p0_mod_item(F, args, scr, r); continue; } r -= I_MOD;
        if (r < I_RT) { p0_router_item(args.in[I_WR], (bf16*)(F.ws + WS_WRH), (bf16*)(F.ws + WS_WRL), scr, 64 * r, F.lane); continue; } r -= I_RT;
        if (r < I_IN) { const int kb = r >> 6, nb = r & 63, n0 = 32 * nb; const int dr = n0 < 1024 ? glu_row(n0, 512) : n0;
            p0_transpose_item(args.in[I_WIN], D, 2048, (bf16*)(F.ws + WS_WIN), dr, scr, 64 * kb, n0, F.lane); continue; } r -= I_IN;
        if (r < I_OUT) { const int kb = r >> 5, nb = r & 31; p0_transpose_item(args.in[I_WOUT], D, D, (bf16*)(F.ws + WS_WOUT), 32 * nb, scr, 64 * kb, 32 * nb, F.lane); continue; } r -= I_OUT;
        if (r < I_GU) { const int e = r >> 10, q = r & 1023, kb = q >> 6, nb = q & 63, n0 = 32 * nb;
            p0_transpose_item(args.in[I_WGU] + (size_t)e * D * 2048, D, 2048, (bf16*)(F.ws + WS_WGU) + (size_t)e * 2048 * D, glu_row(n0, 1024), scr, 64 * kb, n0, F.lane); continue; } r -= I_GU;
        { const int e = r >> 9, q = r & 511, kb = q >> 5, nb = q & 31;
            p0_transpose_item(args.in[I_WD] + (size_t)e * DE * D, DE, D, (bf16*)(F.ws + WS_WD) + (size_t)e * D * DE, 32 * nb, scr, 64 * kb, 32 * nb, F.lane); }
    }
}
__device__ __forceinline__ float mod_from_parts(const float* mp, const float* bada, int b, int j) {
    return bada[j] + ((mp[(size_t)(0 * 8 + b) * NMODW + j] + mp[(size_t)(1 * 8 + b) * NMODW + j]) + (mp[(size_t)(2 * 8 + b) * NMODW + j] + mp[(size_t)(3 * 8 + b) * NMODW + j]));
}
__device__ __forceinline__ void p1_norm1(Frame& F, const Args& args) {
    const float* mp = (const float*)(F.ws + WS_MODP); const float* bada = args.in[I_BADA]; float* mf = (float*)(F.ws + WS_MODF);
    for (int idx = F.bx * 512 + F.tid; idx < NB * NMODW; idx += F.G * 512) { const int b = idx / NMODW, j = idx - b * NMODW; mf[idx] = mod_from_parts(mp, bada, b, j); }
    const float* x = args.in[I_X]; const float* g1 = args.in[I_N1G]; bf16* H = (bf16*)(F.ws + WS_H);
    for (int rb = F.bx; rb < T / 128; rb += F.G) {
        const int b = rb >> 5;
        f32x4 A1[4], B1[4];
#pragma unroll
        for (int i = 0; i < 4; ++i)
#pragma unroll
            for (int e = 0; e < 4; ++e) { const int k = 256 * i + 4 * F.lane + e; A1[i][e] = g1[k] * (1.0f + mod_from_parts(mp, bada, b, D + k)); B1[i][e] = mod_from_parts(mp, bada, b, k); }
        for (int r = F.wave; r < 128; r += NWAVES) {
            const size_t row = (size_t)rb * 128 + r;
            const GAS f32x4* xr = (const GAS f32x4*)(x + row * D) + F.lane;
            f32x4 v[4]; float s = 0.f;
#pragma unroll
            for (int i = 0; i < 4; ++i) { v[i] = xr[64 * i]; s += (v[i].x * v[i].x + v[i].y * v[i].y) + (v[i].z * v[i].z + v[i].w * v[i].w); }
            const float rstd = rsqrtf(wave_sum(s) * (1.0f / D) + EPS);
            GAS v2u* o8 = (GAS v2u*)(H + row * D) + F.lane;
#pragma unroll
            for (int i = 0; i < 4; ++i) { const f32x4 h = v[i] * rstd * A1[i] + B1[i]; v2u w; w.x = pk2(h.x, h.y); w.y = pk2(h.z, h.w); o8[64 * i] = w; }
        }
    }
}

template <int N, int OFF> struct TRed {
    template <int M> static __device__ __forceinline__ void run(float (&v)[M], int lane) {
        constexpr int half = N / 2; const bool up = (lane & OFF) != 0;
#pragma unroll
        for (int i = 0; i < half; ++i) { const float send = up ? v[i] : v[i + half]; const float keep = up ? v[i + half] : v[i]; v[i] = keep + __shfl_xor(send, OFF); }
        if constexpr (half > 1) TRed<half, OFF / 2>::run(v, lane);
    }
};
template <int N> __device__ __forceinline__ float treduce(float (&v)[N], int lane) {
    TRed<N, 32>::run(v, lane);
    if (N == 32) v[0] += __shfl_xor(v[0], 1);
    return v[0];
}

__device__ __forceinline__ void conv_unit(Frame& F, const Args& args, int u) {
    const int t0 = 64 * u; const bool first = (t0 & (SEQ - 1)) == 0;
    LAS unsigned char* tile = F.lds;
    LAS float* RED = (LAS float*)(F.lds + 98304);
    LAS f32x2* ST = (LAS f32x2*)(F.lds + 98304 + 2048);
    LAS float* RED2 = (LAS float*)(F.lds + 98304 + 4096);
    LAS float* ST2 = (LAS float*)(F.lds + 98304 + 6144);
    const bf16* V = (const bf16*)(F.ws + WS_V);
    for (int p = F.tid; p < 94 * 64; p += 512) { const int row = p >> 6, c16 = p & 63;
        v4u val = (v4u){0u, 0u, 0u, 0u};
        if (!(first && row < 30)) val = *(const GAS v4u*)(V + (size_t)(t0 - 30 + row) * DC + c16 * 8);
        *(LAS v4u*)(tile + row * 1024 + c16 * 16) = val; }
    __syncthreads();
    int otid = F.tid; asm volatile("" : "+v"(otid));
    const int cp = otid & 255, th = otid >> 8, wq = F.wave & 3;
    float w0[31], w1[31];
    { const float* cw = args.in[I_CONVW] + 2 * cp;
#pragma unroll
      for (int k = 0; k < 31; ++k) { const f32x2 t = *(const f32x2*)(cw + k * DC); w0[k] = t.x; w1[k] = t.y; } }
    const f32x2 cb = *(const f32x2*)(args.in[I_CONVB] + 2 * cp);
    float o0[32], o1[32];
#pragma unroll
    for (int g = 0; g < 4; ++g) {
        float a0[8], a1[8];
#pragma unroll
        for (int j = 0; j < 8; ++j) { a0[j] = cb.x; a1[j] = cb.y; }
        const LAS unsigned char* tp = tile + (32 * th + 8 * g) * 1024 + cp * 4;
#pragma unroll
        for (int i = 0; i < 38; ++i) { const unsigned xw = *(const LAS unsigned*)(tp + i * 1024); const float x0 = bflo(xw), x1 = bfhi(xw);
#pragma unroll
            for (int j = 0; j < 8; ++j) { const int k = i - j; if (k >= 0 && k <= 30) { a0[j] += w0[k] * x0; a1[j] += w1[k] * x1; } } }
#pragma unroll
        for (int j = 0; j < 8; ++j) { o0[8 * g + j] = a0[j]; o1[8 * g + j] = a1[j]; }
    }
    { float vals[64];
#pragma unroll
      for (int t = 0; t < 32; ++t) { vals[t] = o0[t] + o1[t]; vals[32 + t] = o0[t] * o0[t] + o1[t] * o1[t]; }
      const float r = treduce<64>(vals, F.lane);
      RED[(th * 4 + wq) * 64 + F.lane] = r; }
    __syncthreads();
    if (F.tid < 64) { const int hh = F.tid >> 5, tk = F.tid & 31; float s1 = 0.f, s2 = 0.f;
#pragma unroll
        for (int w = 0; w < 4; ++w) { s1 += RED[(hh * 4 + w) * 64 + tk]; s2 += RED[(hh * 4 + w) * 64 + 32 + tk]; }
        const float mean = s1 * (1.0f / DC); const float var = fmaxf(s2 * (1.0f / DC) - mean * mean, 0.f);
        ST[F.tid] = (f32x2){mean, rsqrtf(var + EPS)}; }
    __syncthreads();
    const f32x2 lg = *(const f32x2*)(args.in[I_CLNG] + 2 * cp), lb = *(const f32x2*)(args.in[I_CLNB] + 2 * cp);
    { float vals[32];
#pragma unroll
      for (int t = 0; t < 32; ++t) { const f32x2 st = ST[th * 32 + t];
          const float y0 = (o0[t] - st.x) * st.y * lg.x + lb.x, y1 = (o1[t] - st.x) * st.y * lg.y + lb.y;
          o0[t] = y0 * sigmoidf_(y0); o1[t] = y1 * sigmoidf_(y1); vals[t] = o0[t] * o0[t] + o1[t] * o1[t]; }
      const float r = treduce<32>(vals, F.lane);
      if ((F.lane & 1) == 0) RED2[(th * 4 + wq) * 32 + (F.lane >> 1)] = r; }
    __syncthreads();
    if (F.tid < 64) { const int hh = F.tid >> 5, tk = F.tid & 31; float s = 0.f;
#pragma unroll
        for (int w = 0; w < 4; ++w) s += RED2[(hh * 4 + w) * 32 + tk];
        ST2[F.tid] = rsqrtf(s * (1.0f / DC) + EPS); }
    __syncthreads();
    const f32x2 mg = *(const f32x2*)(args.in[I_MIXG] + 2 * cp);
    bf16* YA = (bf16*)(F.ws + WS_H);
#pragma unroll
    for (int t = 0; t < 32; ++t) { const float rs = ST2[th * 32 + t];
        *(GAS unsigned*)(YA + (size_t)(t0 + 32 * th + t) * D + 2 * cp) = pk2(o0[t] * rs * mg.x, o1[t] * rs * mg.y); }
}

constexpr int LRU_WB = 7680;
template <int PASS>
__device__ __forceinline__ void lru_unit(Frame& F, const Args& args, int ck) {
    int lane = F.lane; asm volatile("" : "+v"(lane));
    const int h = F.wave, j = lane & 15, q = lane >> 4;
    const int b = ck >> 5, cs = ck & 31, t0 = ck * 128;
    LAS unsigned char* wl = F.lds + h * LRU_WB;
    LAS unsigned char* xt = wl + 35 * 144;
    LAS float* SS = (LAS float*)(F.lds + 8 * LRU_WB);
    const bf16* UREC = (const bf16*)(F.ws + WS_UREC); const bf16* GG = (const bf16*)(F.ws + WS_GG); bf16* YA = (bf16*)(F.ws + WS_H);
    float* SUMA = (float*)(F.ws + WS_SUMA); float* SUMH = (float*)(F.ws + WS_SUMH);
    LAS float* cst = (LAS float*)(F.lds + 8 * LRU_WB + 2048) + h * 512;
    { const int c = 64 * h + lane;
#pragma unroll
      for (int k = 0; k < 4; ++k) cst[k * 64 + lane] = args.in[I_LCW][k * 512 + c];
      cst[4 * 64 + lane] = args.in[I_LCB][c]; cst[5 * 64 + lane] = args.in[I_LBA][c]; cst[6 * 64 + lane] = args.in[I_LBX][c];
      const float z = -args.in[I_LAM][c]; cst[7 * 64 + lane] = fmaxf(z, 0.f) + log1pf(__expf(-fabsf(z))); }
    bf16x8 Ba[4][2], Bx[4][2];
    const unsigned l16 = (unsigned)lane * 16u;
#pragma unroll
    for (int n = 0; n < 4; ++n)
#pragma unroll
        for (int s = 0; s < 2; ++s) { const GAS unsigned char* fb = (const GAS unsigned char*)(F.ws + WS_LRUB) + (size_t)h * 16384 + (n * 2 + s) * 1024;
            Ba[n][s] = *(const GAS bf16x8*)(fb + l16); Bx[n][s] = *(const GAS bf16x8*)(fb + 8192 + l16); }
    float hc[4], Pt[4];
#pragma unroll
    for (int n = 0; n < 4; ++n) { hc[n] = 0.f; Pt[n] = 1.f; }
    if (PASS == 2) {
        float hv = 0.f;
        for (int c2 = 0; c2 < cs; ++c2) { const size_t idx = (size_t)(b * 32 + c2) * 512 + 64 * h + lane; hv = SUMA[idx] * hv + SUMH[idx]; }
#pragma unroll
        for (int n = 0; n < 4; ++n) hc[n] = __shfl(hv, 16 * n + j);
    }
    for (int sc = 0; sc < 4; ++sc) {
        const int ts = t0 + 32 * sc;
        v4u ggv[4];
        const unsigned lrow = (unsigned)(lane >> 3) * 1024u + (unsigned)h * 128u + (unsigned)(lane & 7) * 16u;
        if (PASS == 2) {
#pragma unroll
            for (int i = 0; i < 4; ++i) { const GAS unsigned char* gb = (const GAS unsigned char*)GG + (size_t)(ts + 8 * i) * 1024; ggv[i] = *(const GAS v4u*)(gb + lrow); }
        }
#pragma unroll
        for (int i = 0; i < 5; ++i) { const int p = lane + 64 * i;
            if (p < 280) { const int row = p >> 3, c8 = p & 7; v4u val = (v4u){0u, 0u, 0u, 0u};
                if (!(cs == 0 && sc == 0 && row < 3)) { const GAS unsigned char* ub = (const GAS unsigned char*)UREC + (size_t)(ts - 3 + 8 * i) * 1024; val = *(const GAS v4u*)(ub + lrow); }
                *(LAS v4u*)(wl + row * 144 + c8 * 16) = val; } }
#pragma unroll 1
        for (int tile = 0; tile < 2; ++tile) {
            float xr[4][4];
#pragma unroll
            for (int n = 0; n < 4; ++n) { float uu[7];
#pragma unroll
                for (int m = 0; m < 7; ++m) uu[m] = bf2f(*(const LAS unsigned short*)(wl + (16 * tile + 4 * q + m) * 144 + (16 * n + j) * 2));
                const float c0 = cst[16 * n + j], c1 = cst[64 + 16 * n + j], c2 = cst[128 + 16 * n + j], c3 = cst[192 + 16 * n + j], cbn = cst[256 + 16 * n + j];
#pragma unroll
                for (int r = 0; r < 4; ++r) xr[n][r] = cbn + ((c0 * uu[r] + c1 * uu[r + 1]) + (c2 * uu[r + 2] + c3 * uu[r + 3])); }
#pragma unroll
            for (int n = 0; n < 4; ++n)
#pragma unroll
                for (int r = 0; r < 4; ++r) *(LAS unsigned short*)(xt + (4 * q + r) * 144 + (16 * n + j) * 2) = (unsigned short)f2bf(xr[n][r]);
            const bf16x8 a0 = *(const LAS bf16x8*)(xt + j * 144 + 16 * q), a1 = *(const LAS bf16x8*)(xt + j * 144 + 64 + 16 * q);
#pragma unroll
            for (int n = 0; n < 4; ++n) {
                f32x4 za = (f32x4){0.f, 0.f, 0.f, 0.f}, zx = (f32x4){0.f, 0.f, 0.f, 0.f};
                za = __builtin_amdgcn_mfma_f32_16x16x32_bf16(a0, Ba[n][0], za, 0, 0, 0); za = __builtin_amdgcn_mfma_f32_16x16x32_bf16(a1, Ba[n][1], za, 0, 0, 0);
                zx = __builtin_amdgcn_mfma_f32_16x16x32_bf16(a0, Bx[n][0], zx, 0, 0, 0); zx = __builtin_amdgcn_mfma_f32_16x16x32_bf16(a1, Bx[n][1], zx, 0, 0, 0);
                float pp[4], hh[4];
                const float ban = cst[320 + 16 * n + j], bxn = cst[384 + 16 * n + j], spn = cst[448 + 16 * n + j];
#pragma unroll
                for (int r = 0; r < 4; ++r) { const float rg = sigmoidf_(za[r] + ban), ig = sigmoidf_(zx[r] + bxn);
                    const float la = -8.0f * rg * spn; const float a = __expf(la); const float mult = sqrtf(fmaxf(1.0f - a * a, 0.f)); const float inp = mult * (ig * xr[n][r]);
                    if (r == 0) { pp[0] = a; hh[0] = inp; } else { pp[r] = a * pp[r - 1]; hh[r] = a * hh[r - 1] + inp; } }
                float P = pp[3], H = hh[3];
                { const float Pp = __shfl_up(P, 16), Hp = __shfl_up(H, 16); if (q >= 1) { H = P * Hp + H; P = P * Pp; } }
                { const float Pp = __shfl_up(P, 32), Hp = __shfl_up(H, 32); if (q >= 2) { H = P * Hp + H; P = P * Pp; } }
                float Pe = __shfl_up(P, 16), He = __shfl_up(H, 16); if (q == 0) { Pe = 1.f; He = 0.f; }
                const float hq = Pe * hc[n] + He;
                if (PASS == 2) {
#pragma unroll
                    for (int r = 0; r < 4; ++r) *(LAS unsigned short*)(wl + (16 * tile + 4 * q + r) * 144 + (16 * n + j) * 2) = (unsigned short)f2bf(pp[r] * hq + hh[r]);
                }
                const float Pl = __shfl(P, 48 + j), Hl = __shfl(H, 48 + j);
                hc[n] = Pl * hc[n] + Hl; Pt[n] *= Pl;
            }
        }
        if (PASS == 2) {
            LAS float* ssb = SS + (sc & 1) * 256;
#pragma unroll
            for (int i = 0; i < 4; ++i) { const int tk = (lane >> 3) + 8 * i; const v4u hw = *(const LAS v4u*)(wl + tk * 144 + 16 * (lane & 7));
                float y[8];
                y[0] = bflo(ggv[i].x) * bflo(hw.x); y[1] = bfhi(ggv[i].x) * bfhi(hw.x); y[2] = bflo(ggv[i].y) * bflo(hw.y); y[3] = bfhi(ggv[i].y) * bfhi(hw.y);
                y[4] = bflo(ggv[i].z) * bflo(hw.z); y[5] = bfhi(ggv[i].z) * bfhi(hw.z); y[6] = bflo(ggv[i].w) * bflo(hw.w); y[7] = bfhi(ggv[i].w) * bfhi(hw.w);
                float s = 0.f;
#pragma unroll
                for (int e = 0; e < 8; ++e) s += y[e] * y[e];
                s += __shfl_xor(s, 1); s += __shfl_xor(s, 2); s += __shfl_xor(s, 4);
                if ((lane & 7) == 0) ssb[tk * 8 + h] = s; }
            __syncthreads();
            float mg[8];
            { const f32x4 m0 = *(const f32x4*)(args.in[I_MIXG] + 512 + 64 * h + 8 * (lane & 7)), m1 = *(const f32x4*)(args.in[I_MIXG] + 512 + 64 * h + 8 * (lane & 7) + 4);
              mg[0] = m0.x; mg[1] = m0.y; mg[2] = m0.z; mg[3] = m0.w; mg[4] = m1.x; mg[5] = m1.y; mg[6] = m1.z; mg[7] = m1.w; }
#pragma unroll
            for (int i = 0; i < 4; ++i) { const int tk = (lane >> 3) + 8 * i; const f32x4 s0 = *(const LAS f32x4*)(ssb + tk * 8), s1 = *(const LAS f32x4*)(ssb + tk * 8 + 4);
                const float rs = rsqrtf(((s0.x + s0.y) + (s0.z + s0.w) + (s1.x + s1.y) + (s1.z + s1.w)) * (1.0f / 512.0f) + EPS);
                const v4u hw = *(const LAS v4u*)(wl + tk * 144 + 16 * (lane & 7));
                float y[8];
                y[0] = bflo(ggv[i].x) * bflo(hw.x); y[1] = bfhi(ggv[i].x) * bfhi(hw.x); y[2] = bflo(ggv[i].y) * bflo(hw.y); y[3] = bfhi(ggv[i].y) * bfhi(hw.y);
                y[4] = bflo(ggv[i].z) * bflo(hw.z); y[5] = bfhi(ggv[i].z) * bfhi(hw.z); y[6] = bflo(ggv[i].w) * bflo(hw.w); y[7] = bfhi(ggv[i].w) * bfhi(hw.w);
                v4u w; w.x = pk2(y[0] * rs * mg[0], y[1] * rs * mg[1]); w.y = pk2(y[2] * rs * mg[2], y[3] * rs * mg[3]);
                w.z = pk2(y[4] * rs * mg[4], y[5] * rs * mg[5]); w.w = pk2(y[6] * rs * mg[6], y[7] * rs * mg[7]);
                { GAS unsigned char* yb = (GAS unsigned char*)YA + (size_t)(ts + 8 * i) * 2048 + 1024; *(GAS v4u*)(yb + ((unsigned)(lane >> 3) * 2048u + (unsigned)h * 128u + (unsigned)(lane & 7) * 16u)) = w; } }
        }
    }
    if (PASS == 1) {
        const float pv = q == 0 ? Pt[0] : q == 1 ? Pt[1] : q == 2 ? Pt[2] : Pt[3];
        const float hv = q == 0 ? hc[0] : q == 1 ? hc[1] : q == 2 ? hc[2] : hc[3];
        SUMA[(size_t)ck * 512 + 64 * h + lane] = pv; SUMH[(size_t)ck * 512 + 64 * h + lane] = hv;
    }
}

__device__ __forceinline__ void p6_router(Frame& F, const Args& args) {
    constexpr int RS = 2064;
    LAS unsigned char* HI = F.lds; LAS unsigned char* LO = F.lds + 16 * RS;
    LAS float* PLOG = (LAS float*)(F.lds + 32 * RS);
    LAS int* SEL = (LAS int*)(F.lds + 32 * RS + 16384);
    LAS int* CNTW = (LAS int*)(F.lds + 32 * RS + 16384 + 2048);
    const float* X1 = (const float*)(F.ws + WS_X1); bf16* H2 = (bf16*)(F.ws + WS_H); const float* mf = (const float*)(F.ws + WS_MODF);
    const bf16* WRH = (const bf16*)(F.ws + WS_WRH); const bf16* WRL = (const bf16*)(F.ws + WS_WRL);
    int* TOPI = (int*)(F.ws + WS_TOPI); float* TOPG = (float*)(F.ws + WS_TOPG); int* LRANK = (int*)(F.ws + WS_LRANK); int* BCNT = (int*)(F.ws + WS_BCNT);
    const int lane = F.lane, w = F.wave, j = lane & 15, q = lane >> 4;
    for (int rb = F.bx; rb < T / 128; rb += F.G) {
        const int b = rb >> 5;
        f32x4 A2[4], B2[4];
#pragma unroll
        for (int i = 0; i < 4; ++i) { const int k = 256 * i + 4 * lane; const f32x4 g = *(const f32x4*)(args.in[I_N2G] + k), sc = *(const f32x4*)(mf + (size_t)b * NMODW + 4 * D + k);
            A2[i] = g * (sc + 1.0f); B2[i] = *(const f32x4*)(mf + (size_t)b * NMODW + 3 * D + k); }
        bf16x8 bh[4][2], bl[4][2];
#pragma unroll
        for (int s = 0; s < 4; ++s)
#pragma unroll
            for (int n = 0; n < 2; ++n) { const size_t o = (size_t)(16 * n + j) * D + 128 * w + 32 * s + 8 * q; bh[s][n] = *(const GAS bf16x8*)(WRH + o); bl[s][n] = *(const GAS bf16x8*)(WRL + o); }
        f32x4 xv[2][4];
#pragma unroll
        for (int rr = 0; rr < 2; ++rr)
#pragma unroll
            for (int i = 0; i < 4; ++i) xv[rr][i] = *((const GAS f32x4*)(X1 + ((size_t)rb * 128 + 2 * w + rr) * D) + lane + 64 * i);
        for (int tile = 0; tile < 8; ++tile) {
#pragma unroll
            for (int rr = 0; rr < 2; ++rr) { const int r = 2 * w + rr; const size_t t = (size_t)rb * 128 + 16 * tile + r;
                float s = 0.f;
#pragma unroll
                for (int i = 0; i < 4; ++i) s += (xv[rr][i].x * xv[rr][i].x + xv[rr][i].y * xv[rr][i].y) + (xv[rr][i].z * xv[rr][i].z + xv[rr][i].w * xv[rr][i].w);
                const float rstd = rsqrtf(wave_sum(s) * (1.0f / D) + EPS);
#pragma unroll
                for (int i = 0; i < 4; ++i) { const f32x4 hv = xv[rr][i] * rstd * A2[i] + B2[i];
                    unsigned hb[4], lb[4];
#pragma unroll
                    for (int e = 0; e < 4; ++e) { hb[e] = f2bf(hv[e]); lb[e] = f2bf(hv[e] - bf2f(hb[e])); }
                    v2u wh, wl2; wh.x = hb[0] | (hb[1] << 16); wh.y = hb[2] | (hb[3] << 16); wl2.x = lb[0] | (lb[1] << 16); wl2.y = lb[2] | (lb[3] << 16);
                    *((GAS v2u*)(H2 + t * D) + lane + 64 * i) = wh;
                    *(LAS v2u*)(HI + r * RS + (4 * lane + 256 * i) * 2) = wh; *(LAS v2u*)(LO + r * RS + (4 * lane + 256 * i) * 2) = wl2; }
            }
            if (tile < 7) {
#pragma unroll
                for (int rr = 0; rr < 2; ++rr)
#pragma unroll
                    for (int i = 0; i < 4; ++i) xv[rr][i] = *((const GAS f32x4*)(X1 + ((size_t)rb * 128 + 16 * (tile + 1) + 2 * w + rr) * D) + lane + 64 * i);
            }
            __syncthreads();
            f32x4 acc[2]; acc[0] = (f32x4){0.f, 0.f, 0.f, 0.f}; acc[1] = acc[0];
#pragma unroll
            for (int s = 0; s < 4; ++s) { const int ko = (128 * w + 32 * s + 8 * q) * 2;
                const bf16x8 ah = *(const LAS bf16x8*)(HI + j * RS + ko), al = *(const LAS bf16x8*)(LO + j * RS + ko);
#pragma unroll
                for (int n = 0; n < 2; ++n) { acc[n] = __builtin_amdgcn_mfma_f32_16x16x32_bf16(ah, bh[s][n], acc[n], 0, 0, 0);
                    acc[n] = __builtin_amdgcn_mfma_f32_16x16x32_bf16(ah, bl[s][n], acc[n], 0, 0, 0); acc[n] = __builtin_amdgcn_mfma_f32_16x16x32_bf16(al, bh[s][n], acc[n], 0, 0, 0); } }
#pragma unroll
            for (int n = 0; n < 2; ++n)
#pragma unroll
                for (int r = 0; r < 4; ++r) PLOG[(w * 16 + 4 * q + r) * 32 + 16 * n + j] = acc[n][r];
            __syncthreads();
            { const int tk = F.tid >> 5, e = F.tid & 31;
              float lg = args.in[I_BR][e];
#pragma unroll
              for (int w2 = 0; w2 < 8; ++w2) lg += PLOG[(w2 * 16 + tk) * 32 + e];
              float tv[4]; int ti[4]; float v = lg;
#pragma unroll
              for (int k = 0; k < 4; ++k) { float bv = v; int bi = e;
#pragma unroll
                  for (int off = 1; off < 32; off <<= 1) { const float ov = __shfl_xor(bv, off); const int oi = __shfl_xor(bi, off); if (ov > bv || (ov == bv && oi < bi)) { bv = ov; bi = oi; } }
                  tv[k] = bv; ti[k] = bi; if (e == bi) v = -3.0e38f; }
              const float e1 = __expf(tv[1] - tv[0]), e2 = __expf(tv[2] - tv[0]), e3 = __expf(tv[3] - tv[0]); const float inv = 1.0f / (1.0f + e1 + e2 + e3);
              if (e < 4) { const float gk = (e == 0 ? 1.0f : e == 1 ? e1 : e == 2 ? e2 : e3) * inv; const int ik = e == 0 ? ti[0] : e == 1 ? ti[1] : e == 2 ? ti[2] : ti[3];
                  const size_t t = (size_t)rb * 128 + 16 * tile + tk; TOPI[t * 4 + e] = ik; TOPG[t * 4 + e] = gk; SEL[(16 * tile + tk) * 4 + e] = ik; } }
        }
        __syncthreads();
        { const int myE = SEL[F.tid]; int rk = 0, cm = 0;
#pragma unroll 1
          for (int e = 0; e < 32; ++e) { const unsigned long long m = __ballot(myE == e); if (myE == e) rk = __popcll(m & ((1ull << lane) - 1ull)); if (lane == e) cm = __popcll(m); }
          if (lane < 32) CNTW[w * 32 + lane] = cm;
          __syncthreads();
          int base = 0;
          for (int w2 = 0; w2 < w; ++w2) base += CNTW[w2 * 32 + myE];
          LRANK[(size_t)rb * 512 + F.tid] = base + rk;
          if (F.tid < 32) { int tot = 0;
#pragma unroll
              for (int w2 = 0; w2 < 8; ++w2) tot += CNTW[w2 * 32 + F.tid];
              BCNT[rb * 32 + F.tid] = tot; } }
        __syncthreads();
    }
}
__device__ __forceinline__ void p7_positions(Frame& F) {
    LAS int* PT = (LAS int*)F.lds; LAS int* PB = PT + 512; LAS int* TOT = PB + 512; LAS int* BEF = TOT + 32; LAS int* PS = BEF + 32;
    const int* BCNT = (const int*)(F.ws + WS_BCNT); const int* TOPI = (const int*)(F.ws + WS_TOPI); const int* LRANK = (const int*)(F.ws + WS_LRANK);
    int* POSOF = (int*)(F.ws + WS_POSOF); int* ROWTOK = (int*)(F.ws + WS_ROWTOK); int* META = (int*)(F.ws + WS_META);
    for (int rb = F.bx; rb < T / 128; rb += F.G) {
        { const int e = F.tid & 31, part = F.tid >> 5; int tot = 0, bef = 0;
          for (int c2 = part * 16; c2 < part * 16 + 16; ++c2) { const int v = BCNT[c2 * 32 + e]; tot += v; if (c2 < rb) bef += v; }
          PT[F.tid] = tot; PB[F.tid] = bef; }
        __syncthreads();
        if (F.tid < 32) { int tot = 0, bef = 0;
#pragma unroll
            for (int p = 0; p < 16; ++p) { tot += PT[p * 32 + F.tid]; bef += PB[p * 32 + F.tid]; }
            TOT[F.tid] = tot; BEF[F.tid] = bef; }
        __syncthreads();
        if (F.tid == 0) { int run = 0; for (int e = 0; e < 32; ++e) { PS[e] = run; run += ((TOT[e] + 255) >> 8) << 8; } PS[32] = run; }
        __syncthreads();
        { const size_t pi = (size_t)rb * 512 + F.tid; const int e = TOPI[pi]; const int pos = PS[e] + BEF[e] + LRANK[pi]; ROWTOK[pos] = rb * 128 + (F.tid >> 2); POSOF[pi] = pos; }
        if (rb < 32) { const int e = rb, lim = ((TOT[e] + 255) >> 8) << 8; for (int r = TOT[e] + F.tid; r < lim; r += 512) ROWTOK[PS[e] + r] = 0; }
        if (rb == 0 && F.tid <= 32) META[F.tid] = PS[F.tid] >> 8;
        __syncthreads();
    }
}
__device__ __forceinline__ int moe_tables(Frame& F, LAS int* texp) {
    const int* META = (const int*)(F.ws + WS_META);
    const int MT = META[32];
    for (int pm = F.tid; pm < MT; pm += 512) { int e = 0;
#pragma unroll 1
        for (int k = 1; k < 32; ++k) if (META[k] <= pm) e = k;
        texp[pm] = e; }
    __syncthreads();
    return MT;
}
__device__ __forceinline__ void p10_combine(Frame& F, const Args& args) {
    const float* X1 = (const float*)(F.ws + WS_X1); const bf16* Y = (const bf16*)(F.ws + WS_Y); const float* mf = (const float*)(F.ws + WS_MODF);
    const int* POSOF = (const int*)(F.ws + WS_POSOF); const float* TOPG = (const float*)(F.ws + WS_TOPG);
    const int lane = F.lane;
    for (int rb = F.bx; rb < T / 128; rb += F.G) {
        const int b = rb >> 5;
        f32x4 g2[4], fg[4];
#pragma unroll
        for (int i = 0; i < 4; ++i) { g2[i] = *(const f32x4*)(mf + (size_t)b * NMODW + 5 * D + 256 * i + 4 * lane); fg[i] = *(const f32x4*)(args.in[I_FNG] + 256 * i + 4 * lane); }
        for (int r = F.wave; r < 128; r += NWAVES) {
            const size_t t = (size_t)rb * 128 + r;
            const int p0 = POSOF[t * 4 + 0], p1 = POSOF[t * 4 + 1], p2 = POSOF[t * 4 + 2], p3 = POSOF[t * 4 + 3];
            const float k0 = TOPG[t * 4 + 0], k1 = TOPG[t * 4 + 1], k2 = TOPG[t * 4 + 2], k3 = TOPG[t * 4 + 3];
            f32x4 o[4]; float s = 0.f;
#pragma unroll
            for (int i = 0; i < 4; ++i) {
                const f32x4 xv = *((const GAS f32x4*)(X1 + t * D) + lane + 64 * i);
                const v2u y0 = *((const GAS v2u*)(Y + (size_t)p0 * D) + lane + 64 * i), y1 = *((const GAS v2u*)(Y + (size_t)p1 * D) + lane + 64 * i);
                const v2u y2 = *((const GAS v2u*)(Y + (size_t)p2 * D) + lane + 64 * i), y3 = *((const GAS v2u*)(Y + (size_t)p3 * D) + lane + 64 * i);
                f32x4 m;
                m.x = (k0 * bflo(y0.x) + k1 * bflo(y1.x)) + (k2 * bflo(y2.x) + k3 * bflo(y3.x)); m.y = (k0 * bfhi(y0.x) + k1 * bfhi(y1.x)) + (k2 * bfhi(y2.x) + k3 * bfhi(y3.x));
                m.z = (k0 * bflo(y0.y) + k1 * bflo(y1.y)) + (k2 * bflo(y2.y) + k3 * bflo(y3.y)); m.w = (k0 * bfhi(y0.y) + k1 * bfhi(y1.y)) + (k2 * bfhi(y2.y) + k3 * bfhi(y3.y));
                o[i] = xv + g2[i] * m; s += (o[i].x * o[i].x + o[i].y * o[i].y) + (o[i].z * o[i].z + o[i].w * o[i].w); }
            const float rstd = rsqrtf(wave_sum(s) * (1.0f / D) + EPS);
#pragma unroll
            for (int i = 0; i < 4; ++i) *((GAS f32x4*)(F.out + t * D) + lane + 64 * i) = o[i] * rstd * fg[i];
        }
    }
}

__global__ void __launch_bounds__(NWAVES * 64, 2) hymba_fwd(Args args) {
    extern __shared__ __attribute__((aligned(16))) unsigned char lds[];
    Frame F;
    F.lds = (LAS unsigned char*)lds;
    F.MISC = (volatile LAS unsigned*)(F.lds + MISC_OFF);
    F.tid = threadIdx.x; F.lane = F.tid & 63; F.wave = __builtin_amdgcn_readfirstlane(F.tid >> 6);
    F.G = gridDim.x; F.bx = blockIdx.x;
    F.out = args.out; F.ws = args.ws; F.ctl = (gu32*)(args.ws + WS_CTL);
    for (int u = F.tid; u < (LDS_BYTES - LDSCTL_OFF) / 4; u += NWAVES * 64) ((LAS unsigned*)(F.lds + LDSCTL_OFF))[u] = 0u;
    __syncthreads();
    XcdBarrier bar; bar.bar = (unsigned*)(F.ctl + CW_BAR); bar.x = 0; bar.st = nullptr;
    if (N_LAUNCHES != PER_PHASE) bar = xcd_barrier_post((unsigned*)(F.ctl + CW_BAR) + args.li * XCD_BAR_WORDS, F.MISC + 8);
#define GRID_BAR() do { if (N_LAUNCHES != PER_PHASE) xcd_barrier(bar); } while (0)
    const int lo = args.ph_lo, hi = args.ph_hi;
#define IN(k) (lo <= (k) && (k) < hi)
#define BOTH(k) (IN(k) && IN((k) + 1))
    const PG8_LAS unsigned* gtab = (const PG8_LAS unsigned*)(F.lds + AUX_OFF);
    LAS int* texp = (LAS int*)(F.lds + AUX_OFF + AUX_TEXP);

    if (IN(0)) { p0_prologue(F, args); if (BOTH(0)) GRID_BAR(); }
    if (IN(1)) { p1_norm1(F, args); if (BOTH(1)) GRID_BAR(); }
    if (IN(2)) {
        pg8::Order S; S.init(T / 256, 2048 / 256, F.G, F.bx, F.ws + WS_H, F.ws + WS_WIN, D, 0, nullptr, false);
        pg8::EpiInProj E{(bf16*)(F.ws + WS_V), (bf16*)(F.ws + WS_GG), (bf16*)(F.ws + WS_UREC)};
        pg8::gemm_phase<pg8::EpiInProj, pg8::Order, false, true, true>(F.lds, D, S, E, gtab);
        if (BOTH(2)) GRID_BAR();
    }
    if (IN(3)) {
        for (int ck = F.bx; ck < T / 128; ck += F.G) { lru_unit<1>(F, args, ck); __syncthreads(); }
        for (int u = F.bx; u < T / 64; u += F.G) { conv_unit(F, args, u); __syncthreads(); }
        if (BOTH(3)) GRID_BAR();
    }
    if (IN(4)) {
        for (int ck = F.bx; ck < T / 128; ck += F.G) { lru_unit<2>(F, args, ck); __syncthreads(); }
        if (BOTH(4)) GRID_BAR();
    }
    if (IN(5)) {
        pg8::Order S; S.init(T / 256, D / 256, F.G, F.bx, F.ws + WS_H, F.ws + WS_WOUT, D, 0, nullptr, false);
        pg8::EpiOutProj E{args.in[I_X], (float*)(F.ws + WS_X1), (const float*)(F.ws + WS_MODF)};
        pg8::gemm_phase<pg8::EpiOutProj, pg8::Order, false, true, true>(F.lds, D, S, E, gtab);
        if (BOTH(5)) GRID_BAR();
    }
    if (IN(6)) { p6_router(F, args); if (BOTH(6)) GRID_BAR(); }
    if (IN(7)) { p7_positions(F); if (BOTH(7)) GRID_BAR(); }
    if (IN(8)) {
        const int MT = moe_tables(F, texp);
        pg8::Order S; S.init(MT, 2048 / 256, F.G, F.bx, F.ws + WS_H, F.ws + WS_WGU, D, (size_t)2048 * D * 2, texp, true);
        { const int* ROWTOK = (const int*)(F.ws + WS_ROWTOK); pg8::Unit u; LAS unsigned* gt = (LAS unsigned*)(F.lds + AUX_OFF);
          for (int i = 0; i < 18 && S.next(i, u); ++i) if (F.tid < 256) gt[i * 256 + F.tid] = (unsigned)ROWTOK[u.pm * 256 + F.tid] * (unsigned)(D * 2); }
        __syncthreads();
        pg8::EpiSwiglu E{(bf16*)(F.ws + WS_ACT), args.in[I_BGU]};
        pg8::gemm_phase<pg8::EpiSwiglu, pg8::Order, true, true, true>(F.lds, D, S, E, gtab);
        if (BOTH(8)) GRID_BAR();
    }
    if (IN(9)) {
        const int MT = moe_tables(F, texp);
        pg8::Order S; S.init(MT, D / 256, F.G, F.bx, F.ws + WS_ACT, F.ws + WS_WD, DE, (size_t)D * DE * 2, texp, false);
        pg8::EpiDown E{(bf16*)(F.ws + WS_Y), args.in[I_BD]};
        pg8::gemm_phase<pg8::EpiDown, pg8::Order, false, true, true>(F.lds, DE, S, E, gtab);
        if (BOTH(9)) GRID_BAR();
    }
    if (IN(10)) { p10_combine(F, args); }
#undef IN
#undef BOTH
}

extern "C" void kernel_launch(void* const* d_in, const int* in_sizes, int n_in, void* d_out, int out_size, void* d_ws, size_t ws_size, hipStream_t stream) {
    static int grid = 0;
    if (grid == 0) {
        if (n_in != 27 || in_sizes[0] != T * D || out_size != T * D || ws_size < WS_END) { fprintf(stderr, "kernel_launch: unexpected shapes (n_in %d, in0 %d, out %d, ws %zu); nothing launched\n", n_in, n_in > 0 ? in_sizes[0] : -1, out_size, ws_size); grid = -1; return; }
        int dev = 0, cus = 0, per_cu = 0;
        if (hipGetDevice(&dev) != hipSuccess || hipDeviceGetAttribute(&cus, hipDeviceAttributeMultiprocessorCount, dev) != hipSuccess) { grid = -1; return; }
        if (hipFuncSetAttribute((const void*)hymba_fwd, hipFuncAttributeMaxDynamicSharedMemorySize, LDS_BYTES) != hipSuccess) { fprintf(stderr, "kernel_launch: hipFuncSetAttribute failed\n"); grid = -1; return; }
        if (hipOccupancyMaxActiveBlocksPerMultiprocessor(&per_cu, (const void*)hymba_fwd, NWAVES * 64, LDS_BYTES) != hipSuccess || per_cu < 1)
            fprintf(stderr, "kernel_launch: note: occupancy query reports %d workgroups per CU\n", per_cu);
        (void)hipGetLastError();
        grid = cus;
    }
    if (grid < 0) return;
    if (hipMemsetAsync((char*)d_ws + WS_CTL, 0, CTL_ZERO_BYTES, stream) != hipSuccess) return;
    Args a{};
    for (int i = 0; i < 27; ++i) a.in[i] = (const float*)d_in[i];
    a.out = (float*)d_out; a.ws = (unsigned char*)d_ws;
    if (N_LAUNCHES == 1) { a.ph_lo = 0; a.ph_hi = PER_PHASE; a.li = 0; hipLaunchKernelGGL(hymba_fwd, dim3(grid), dim3(NWAVES * 64), LDS_BYTES, stream, a); }
    else { for (int li = 0; li < PER_PHASE; ++li) { a.ph_lo = li; a.ph_hi = li + 1; a.li = 0; hipLaunchKernelGGL(hymba_fwd, dim3(grid), dim3(NWAVES * 64), LDS_BYTES, stream, a); } }
    const hipError_t le = hipPeekAtLastError();
    if (le != hipSuccess) fprintf(stderr, "kernel_launch: launch failed: %s\n", hipGetErrorName(le));
}
```

```cpp
#include <hip/hip_runtime.h>
#include <cstdio>
#include <cstdint>

#define GAS __attribute__((address_space(1)))
#define LAS __attribute__((address_space(3)))
typedef unsigned short bf16;
typedef unsigned v4u __attribute__((ext_vector_type(4)));
typedef unsigned v2u __attribute__((ext_vector_type(2)));
typedef float f32x4 __attribute__((ext_vector_type(4)));
typedef float f32x2 __attribute__((ext_vector_type(2)));
typedef short bf16x8 __attribute__((ext_vector_type(8)));
typedef GAS unsigned gu32;
#define RLX_AGENT __ATOMIC_RELAXED, __HIP_MEMORY_SCOPE_AGENT
#define LDS_WAIT() asm volatile("s_waitcnt lgkmcnt(0)" ::: "memory")
#define VM_WAIT() asm volatile("s_waitcnt vmcnt(0)" ::: "memory")

constexpr int NB = 8, SEQ = 4096, T = NB * SEQ, D = 1024, DC = 512, NE = 32, TOPK = 4, DE = 1024, NMODW = 6 * D;
constexpr int NPAIR = T * TOPK, MAXROWS = NPAIR + NE * 256, MAXMT = MAXROWS / 256;
constexpr float EPS = 1e-6f;
constexpr int NWAVES = 8;
#ifndef MK_N_LAUNCHES
#define MK_N_LAUNCHES 1
#endif
constexpr int N_LAUNCHES = MK_N_LAUNCHES;
constexpr int PER_PHASE = 11;

constexpr size_t MiB = 1u << 20, KiB = 1024;
constexpr size_t WS_CTL = 0, CTL_ZERO_BYTES = 1 * MiB;
constexpr size_t WS_MODP = 1 * MiB;
constexpr size_t WS_MODF = 2 * MiB;
constexpr size_t WS_WRH = 2 * MiB + 256 * KiB, WS_WRL = WS_WRH + 64 * KiB;
constexpr size_t WS_SUMA = 2 * MiB + 512 * KiB, WS_SUMH = 3 * MiB;
constexpr size_t WS_TOPI = 3 * MiB + 512 * KiB, WS_TOPG = 4 * MiB, WS_LRANK = 4 * MiB + 512 * KiB, WS_POSOF = 5 * MiB;
constexpr size_t WS_BCNT = 5 * MiB + 512 * KiB, WS_META = WS_BCNT + 64 * KiB;
constexpr size_t WS_ROWTOK = 6 * MiB;
constexpr size_t WS_LRUB = 7 * MiB;
constexpr size_t WS_WIN = 16 * MiB, WS_WOUT = 20 * MiB;
constexpr size_t WS_WD = 24 * MiB;
constexpr size_t WS_WGU = 56 * MiB;
constexpr size_t WS_H = 120 * MiB;
constexpr size_t WS_V = 184 * MiB, WS_GG = 216 * MiB, WS_UREC = 248 * MiB;
constexpr size_t WS_X1 = 280 * MiB;
constexpr size_t WS_ACT = 408 * MiB;
constexpr size_t WS_Y = 544 * MiB;
constexpr size_t WS_END = 816 * MiB;
static_assert(WS_ACT + (size_t)MAXROWS * DE <= WS_Y && WS_Y + (size_t)MAXROWS * D * 2 <= WS_END, "ws map");
constexpr float W8_SCALE = 64.0f, W8_INV = 1.0f / 64.0f;
constexpr int CW_BAR = 4096;

constexpr int RING_BYTES = 131072, AUX_OFF = 131072, AUX_BYTES = 24576, LDSCTL_OFF = AUX_OFF + AUX_BYTES, MISC_OFF = LDSCTL_OFF + 320, LDS_BYTES = LDSCTL_OFF + 1024;
constexpr int AUX_TEXP = 18432;
static_assert(AUX_TEXP + MAXMT * 4 <= AUX_BYTES, "aux");

__device__ __forceinline__ unsigned f2bf(float f) { unsigned u = __builtin_bit_cast(unsigned, f); return (u + 0x7fffu + ((u >> 16) & 1u)) >> 16; }
__device__ __forceinline__ unsigned pk2(float lo, float hi) { return f2bf(lo) | (f2bf(hi) << 16); }
__device__ __forceinline__ float bf2f(unsigned b) { return __builtin_bit_cast(float, b << 16); }
__device__ __forceinline__ float bflo(unsigned w) { return __builtin_bit_cast(float, w << 16); }
__device__ __forceinline__ float bfhi(unsigned w) { return __builtin_bit_cast(float, w & 0xffff0000u); }
__device__ __forceinline__ float sigmoidf_(float z) { return __builtin_amdgcn_rcpf(1.0f + __expf(-z)); }

namespace pg8 {
#define PG8_LAS __attribute__((address_space(3)))
typedef unsigned short bf16_t;
typedef unsigned u32x4 __attribute__((ext_vector_type(4)));
constexpr int BM = 256, BK = 64, HALF = 128, HTB = HALF * BK * 2, STAGE_BYTES = 8 * HTB, NXCD = 8, WGM = 8;
__host__ __device__ __forceinline__ int lds_byte(int r, int c) { const int st = (r >> 4) * 2 + (c >> 5), rr = r & 15, cc = c & 31, ob = rr * 64 + cc * 2; return st * 1024 + (ob ^ (((ob >> 9) & 1) << 5)); }
__host__ __device__ __forceinline__ void stage_rc(int b, int& R, int& C) { const int st = b / 1024, sb = b % 1024, swz = sb ^ (((sb >> 9) & 1) << 5); R = (st >> 1) * 16 + swz / 64; C = (st & 1) * 32 + (swz % 64) / 2; }
__host__ __device__ __forceinline__ int perm32(int rho) { const int n = rho >> 4, i = rho & 15; return 8 * (i >> 2) + 4 * n + (i & 3); }
__device__ __forceinline__ unsigned cvt_pk_bf16(float lo, float hi) { unsigned r; asm volatile("v_cvt_pk_bf16_f32 %0, %1, %2" : "=v"(r) : "v"(lo), "v"(hi)); return r; }

typedef int v8i __attribute__((ext_vector_type(8)));
typedef int v4i __attribute__((ext_vector_type(4)));
__device__ __forceinline__ v8i cat8(bf16x8 lo, bf16x8 hi) { const v4i a = __builtin_bit_cast(v4i, lo), b = __builtin_bit_cast(v4i, hi); return __builtin_shufflevector(a, b, 0, 1, 2, 3, 4, 5, 6, 7); }
struct Unit { int pm, pn, e; };

struct Order {
    int nM, nN, nwg, G, c; const char* A; const char* Bt; size_t tstep, estep; const PG8_LAS int* texp; bool gather;
    __device__ __forceinline__ void init(int nM_, int nN_, int G_, int c_, const void* A_, const void* Bt_, int K, size_t estep_, const PG8_LAS int* texp_, bool gather_) {
        nM = nM_; nN = nN_; nwg = nM * nN; G = G_; c = c_; A = (const char*)A_; Bt = (const char*)Bt_; tstep = (size_t)BM * K * 2; estep = estep_; texp = texp_; gather = gather_; }
    __device__ __forceinline__ bool next(int i, Unit& u) const {
        const long L = (long)i * G + c; if (L >= nwg) return false;
        int wgid = (int)L; { const int q = nwg / NXCD, r = nwg % NXCD, xcd = wgid % NXCD, off = wgid / NXCD; wgid = (xcd < r ? xcd * (q + 1) : r * (q + 1) + (xcd - r) * q) + off; }
        const int nig = WGM * nN, gid = wgid / nig, fm = gid * WGM, gsz = (nM - fm) < WGM ? (nM - fm) : WGM;
        u.pm = fm + ((wgid % nig) % gsz); u.pn = (wgid % nig) / gsz; u.e = texp ? __builtin_amdgcn_readfirstlane(texp[u.pm]) : 0; return true;
    }
    __device__ __forceinline__ unsigned a_off(const Unit& u) const { return gather ? 0u : (unsigned)u.pm * (unsigned)tstep; }
    __device__ __forceinline__ unsigned b_off(const Unit& u) const { return (unsigned)u.e * (unsigned)estep + (unsigned)u.pn * (unsigned)tstep; }
};

template <class Epi, class Sched, bool GATHER, bool ALIGN_EPI, bool SP2, bool FP8>
__device__ __forceinline__ void gemm_phase(PG8_LAS unsigned char* lds, const int K, const Sched& S, const Epi& E, const PG8_LAS unsigned* gtab) {
    const int tid = threadIdx.x, wid = __builtin_amdgcn_readfirstlane(tid >> 6), lane = tid & 63, wr = wid >> 2, wc = wid & 3, fr = lane & 15, fq = lane >> 4;
    const int nt = K / BK;
    const __amdgpu_buffer_rsrc_t rsA = __builtin_amdgcn_make_buffer_rsrc((void*)S.A, 0, -1, 0x00020000);
    const __amdgpu_buffer_rsrc_t rsB = __builtin_amdgcn_make_buffer_rsrc((void*)S.Bt, 0, -1, 0x00020000);
    unsigned voffA[2], voffB[2]; unsigned offA[2][2];
#pragma unroll
    for (int i = 0; i < 2; ++i) { int R, C; stage_rc(tid * 16 + i * 8192, R, C); const int Rb = Epi::PERM ? ((R & ~31) + perm32(R & 31)) : R;
        voffA[i] = (unsigned)(R * K + C) * 2u; voffB[i] = (unsigned)(Rb * K + C) * 2u; offA[0][i] = 0; offA[1][i] = 0; }
    const unsigned kstep = (unsigned)(BK * 2);
    const unsigned hstep = (unsigned)HALF * K * 2;
    const unsigned ldsw = (unsigned)wid * 1024u;
    const int aoff = lds_byte(wr * 64 + fr, fq * 8), boff = lds_byte(wc * 32 + fr, fq * 8);
#define PG8_SA(b, h) (((b) * 2 + (h)) * HTB)
#define PG8_SB(b, h) ((4 + (b) * 2 + (h)) * HTB)
#define PG8_STAGE(rs, bufoff, soff, voff) do { _Pragma("unroll") for (int _i = 0; _i < 2; ++_i) \
        __builtin_amdgcn_raw_ptr_buffer_load_lds(rs, (PG8_LAS void*)(lds + (bufoff) + ldsw + _i * 8192), 16, (int)(voff)[_i], (int)(soff), 0, 0); } while (0)
#define PG8_STAGE_A(b, h, kbase) do { if constexpr (GATHER) { PG8_STAGE(rsA, PG8_SA(b, h), (kbase), offA[h]); } else { PG8_STAGE(rsA, PG8_SA(b, h), (kbase) + (h) * hstep, voffA); } } while (0)
#define PG8_STAGE_B(b, h, kbase) PG8_STAGE(rsB, PG8_SB(b, h), (kbase) + (h) * hstep, voffB)
#define PG8_LOAD_OFFS(slot) do { _Pragma("unroll") for (int _i = 0; _i < 2; ++_i) { int _R, _C; stage_rc(tid * 16 + _i * 8192, _R, _C); \
        _Pragma("unroll") for (int _h = 0; _h < 2; ++_h) offA[_h][_i] = gtab[(slot) * 256 + _h * 128 + _R] + (unsigned)_C * 2u; } } while (0)
#define PG8_LDA(dst, b, h) do { _Pragma("unroll") for (int m = 0; m < 4; ++m) _Pragma("unroll") for (int k = 0; k < 2; ++k) dst[m][k] = *(const PG8_LAS bf16x8*)(lds + PG8_SA(b, h) + aoff + m * 2048 + k * 1024); } while (0)
#define PG8_LDB(dst, b, h) do { _Pragma("unroll") for (int n = 0; n < 2; ++n) _Pragma("unroll") for (int k = 0; k < 2; ++k) dst[n][k] = *(const PG8_LAS bf16x8*)(lds + PG8_SB(b, h) + boff + n * 2048 + k * 1024); } while (0)
#define PG8_MMA(ai, bj, At, Bt) do { __builtin_amdgcn_s_setprio(1); _Pragma("unroll") for (int m = 0; m < 4; ++m) _Pragma("unroll") for (int n = 0; n < 2; ++n) { \
        if constexpr (FP8) { acc[ai][bj][m][n] = __builtin_amdgcn_mfma_scale_f32_16x16x128_f8f6f4(cat8(Bt[n][0], Bt[n][1]), cat8(At[m][0], At[m][1]), acc[ai][bj][m][n], 0, 0, 0, 0, 0, 0); } \
        else { _Pragma("unroll") for (int k = 0; k < 2; ++k) acc[ai][bj][m][n] = __builtin_amdgcn_mfma_f32_16x16x32_bf16(Bt[n][k], At[m][k], acc[ai][bj][m][n], 0, 0, 0); } } __builtin_amdgcn_s_setprio(0); } while (0)
#define PG8_WAIT_V(n) asm volatile("s_waitcnt vmcnt(" #n ")" ::: "memory")
#define PG8_WAIT_L(n) asm volatile("s_waitcnt lgkmcnt(" #n ")" ::: "memory")
#define PG8_BAR __builtin_amdgcn_s_barrier()
#define PG8_SCHED __builtin_amdgcn_sched_barrier(0)
    Unit cur, nxt; int ui = 0;
    if (!S.next(0, cur)) return;
    f32x4 acc[2][2][4][2];
#pragma unroll
    for (int a = 0; a < 2; ++a)
#pragma unroll
        for (int b = 0; b < 2; ++b)
#pragma unroll
            for (int m = 0; m < 4; ++m)
#pragma unroll
                for (int n = 0; n < 2; ++n) acc[a][b][m][n] = (f32x4){0.f, 0.f, 0.f, 0.f};
    bf16x8 At[4][2], B0[2][2], B1[2][2];
    unsigned cA = S.a_off(cur), cB = S.b_off(cur);
    if constexpr (GATHER) { PG8_LOAD_OFFS(0); }
    if constexpr (SP2) {
        PG8_STAGE_B(0, 0, cB); PG8_STAGE_B(0, 1, cB); PG8_STAGE_A(0, 0, cA); PG8_STAGE_A(0, 1, cA);
        if (wr == 1) PG8_BAR;
        PG8_WAIT_V(2); PG8_BAR;
        PG8_STAGE_B(1, 0, cB + kstep); PG8_STAGE_A(1, 0, cA + kstep); PG8_STAGE_B(1, 1, cB + kstep);
        PG8_WAIT_V(6); PG8_BAR;
    } else {
        PG8_STAGE_B(0, 0, cB); PG8_STAGE_A(0, 0, cA); PG8_STAGE_B(0, 1, cB); PG8_STAGE_A(0, 1, cA);
        if (wr == 1) PG8_BAR;
        PG8_WAIT_V(4); PG8_BAR;
        PG8_STAGE_B(1, 0, cB + kstep); PG8_STAGE_A(1, 0, cA + kstep); PG8_STAGE_B(1, 1, cB + kstep);
        PG8_WAIT_V(6); PG8_BAR;
    }
    for (;;) {
        const bool has_next = S.next(ui + 1, nxt);
        const unsigned nA = has_next ? S.a_off(nxt) : cA, nB = has_next ? S.b_off(nxt) : cB;
#pragma unroll 1
        for (int t = 0; t < nt; t += 2) {
            const bool last = (t == nt - 2);
            const unsigned a1 = cA + (unsigned)(t + 1) * kstep;
            const unsigned a2 = last ? nA : cA + (unsigned)(t + 2) * kstep, b2 = last ? nB : cB + (unsigned)(t + 2) * kstep;
            const unsigned a3 = a2 + kstep, b3 = b2 + kstep;
            if constexpr (SP2) {
            PG8_LDB(B0, 0, 0); PG8_LDB(B1, 0, 1); PG8_SCHED; PG8_LDA(At, 0, 0); PG8_STAGE_A(1, 1, a1);
            PG8_WAIT_V(8); PG8_WAIT_L(0); PG8_BAR; PG8_MMA(0, 0, At, B0); PG8_MMA(0, 1, At, B1); PG8_BAR; PG8_SCHED;
            if constexpr (GATHER) { if (last && has_next) { PG8_LOAD_OFFS(ui + 1); } }
            PG8_LDA(At, 0, 1); PG8_STAGE_B(0, 0, b2); PG8_STAGE_B(0, 1, b2); PG8_STAGE_A(0, 0, a2);
            PG8_WAIT_V(8); PG8_WAIT_L(0); PG8_BAR; PG8_MMA(1, 0, At, B0); PG8_MMA(1, 1, At, B1); PG8_BAR; PG8_SCHED;
            PG8_LDB(B0, 1, 0); PG8_LDB(B1, 1, 1); PG8_SCHED; PG8_LDA(At, 1, 0); PG8_STAGE_A(0, 1, a2);
            PG8_WAIT_V(8); PG8_WAIT_L(0); PG8_BAR; PG8_MMA(0, 0, At, B0); PG8_MMA(0, 1, At, B1); PG8_BAR; PG8_SCHED;
            PG8_LDA(At, 1, 1); PG8_STAGE_B(1, 0, b3); PG8_STAGE_B(1, 1, b3); PG8_STAGE_A(1, 0, a3);
            PG8_WAIT_V(8); PG8_WAIT_L(0); PG8_BAR; PG8_MMA(1, 0, At, B0); PG8_MMA(1, 1, At, B1); PG8_BAR; PG8_SCHED;
            } else {
            PG8_LDB(B0, 0, 0); PG8_SCHED; PG8_LDA(At, 0, 0); PG8_STAGE_A(1, 1, a1);
            PG8_WAIT_L(8); PG8_BAR; PG8_WAIT_L(0); PG8_MMA(0, 0, At, B0); PG8_BAR; PG8_SCHED;
            if constexpr (GATHER) { if (last && has_next) { PG8_LOAD_OFFS(ui + 1); } }
            PG8_LDB(B1, 0, 1); PG8_STAGE_B(0, 0, b2);
            PG8_BAR; PG8_WAIT_L(0); PG8_MMA(0, 1, At, B1); PG8_BAR;
            PG8_LDA(At, 0, 1); PG8_STAGE_A(0, 0, a2);
            PG8_BAR; PG8_WAIT_L(0); PG8_MMA(1, 0, At, B0); PG8_BAR; PG8_SCHED;
            PG8_STAGE_B(0, 1, b2);
            PG8_WAIT_V(6); PG8_BAR; PG8_MMA(1, 1, At, B1); PG8_BAR;
            PG8_LDB(B0, 1, 0); PG8_SCHED; PG8_LDA(At, 1, 0); PG8_STAGE_A(0, 1, a2);
            PG8_WAIT_L(8); PG8_BAR; PG8_WAIT_L(0); PG8_MMA(0, 0, At, B0); PG8_BAR; PG8_SCHED;
            PG8_LDB(B1, 1, 1); PG8_STAGE_B(1, 0, b3);
            PG8_BAR; PG8_WAIT_L(0); PG8_MMA(0, 1, At, B1); PG8_BAR;
            PG8_LDA(At, 1, 1); PG8_STAGE_A(1, 0, a3);
            PG8_BAR; PG8_WAIT_L(0); PG8_MMA(1, 0, At, B0); PG8_BAR; PG8_SCHED;
            PG8_STAGE_B(1, 1, b3);
            PG8_WAIT_V(6); PG8_BAR; PG8_MMA(1, 1, At, B1); PG8_BAR;
            }
        }
        if constexpr (ALIGN_EPI) { if (wr == 0) PG8_BAR; }
        E(acc, cur, wr, wc, fr, fq);
        if (!has_next) break;
#pragma unroll
        for (int a = 0; a < 2; ++a)
#pragma unroll
            for (int b = 0; b < 2; ++b)
#pragma unroll
                for (int m = 0; m < 4; ++m)
#pragma unroll
                    for (int n = 0; n < 2; ++n) acc[a][b][m][n] = (f32x4){0.f, 0.f, 0.f, 0.f};
        cur = nxt; cA = nA; cB = nB; ++ui;
        if constexpr (ALIGN_EPI) { if (wr == 1) PG8_BAR; }
    }
    PG8_WAIT_V(0);
    if constexpr (!ALIGN_EPI) { if (wr == 0) PG8_BAR; }
    PG8_BAR;
#undef PG8_SA
#undef PG8_SB
#undef PG8_STAGE
#undef PG8_STAGE_A
#undef PG8_STAGE_B
#undef PG8_LOAD_OFFS
#undef PG8_LDA
#undef PG8_LDB
#undef PG8_MMA
#undef PG8_WAIT_V
#undef PG8_WAIT_L
#undef PG8_BAR
#undef PG8_SCHED
}

struct EpiInProj {
    static constexpr bool PERM = true;
    bf16_t* V; bf16_t* GG; bf16_t* UR;
    __device__ __forceinline__ void operator()(const f32x4 (&acc)[2][2][4][2], const Unit& u, int wr, int wc, int fr, int fq) const {
        const int row0 = u.pm * BM + wr * 64 + fr, cl = wc * 32 + 8 * fq;
        if (u.pn < 4) {
#pragma unroll
            for (int ai = 0; ai < 2; ++ai)
#pragma unroll
                for (int m = 0; m < 4; ++m) { float o[8];
#pragma unroll
                    for (int n = 0; n < 2; ++n)
#pragma unroll
                        for (int j = 0; j < 4; ++j) o[4 * n + j] = acc[ai][0][m][n][j] * sigmoidf_(acc[ai][1][m][n][j]);
                    u32x4 w; w.x = cvt_pk_bf16(o[0], o[1]); w.y = cvt_pk_bf16(o[2], o[3]); w.z = cvt_pk_bf16(o[4], o[5]); w.w = cvt_pk_bf16(o[6], o[7]);
                    *(u32x4*)(V + (size_t)(row0 + ai * HALF + m * 16) * 512 + u.pn * 128 + cl) = w; }
        } else {
            const bool gel = u.pn < 6; bf16_t* base = gel ? GG : UR; const int c0 = (gel ? u.pn - 4 : u.pn - 6) * 256 + cl;
#pragma unroll
            for (int ai = 0; ai < 2; ++ai)
#pragma unroll
                for (int m = 0; m < 4; ++m)
#pragma unroll
                    for (int bj = 0; bj < 2; ++bj) { float o[8];
#pragma unroll
                        for (int n = 0; n < 2; ++n)
#pragma unroll
                            for (int j = 0; j < 4; ++j) { const float x = acc[ai][bj][m][n][j];
                                o[4 * n + j] = gel ? x * sigmoidf_(1.5957691216f * (x + 0.044715f * x * x * x)) : x; }
                        u32x4 w; w.x = cvt_pk_bf16(o[0], o[1]); w.y = cvt_pk_bf16(o[2], o[3]); w.z = cvt_pk_bf16(o[4], o[5]); w.w = cvt_pk_bf16(o[6], o[7]);
                        *(u32x4*)(base + (size_t)(row0 + ai * HALF + m * 16) * 512 + c0 + bj * HALF) = w; }
        }
    }
};
struct EpiOutProj {
    static constexpr bool PERM = false;
    const float* X; float* X1; const float* modf;
    __device__ __forceinline__ void operator()(const f32x4 (&acc)[2][2][4][2], const Unit& u, int wr, int wc, int fr, int fq) const {
        const int row0 = u.pm * BM + wr * 64 + fr, col0 = u.pn * BM + wc * 32 + 4 * fq; const int b = (u.pm * BM) / SEQ;
        f32x4 gv[2][2];
#pragma unroll
        for (int bj = 0; bj < 2; ++bj)
#pragma unroll
            for (int n = 0; n < 2; ++n) gv[bj][n] = *(const f32x4*)(modf + (size_t)b * NMODW + 2 * D + col0 + bj * HALF + n * 16);
#pragma unroll
        for (int ai = 0; ai < 2; ++ai)
#pragma unroll
            for (int m = 0; m < 4; ++m) { const size_t off = (size_t)(row0 + ai * HALF + m * 16) * D + col0;
#pragma unroll
                for (int bj = 0; bj < 2; ++bj)
#pragma unroll
                    for (int n = 0; n < 2; ++n) { const f32x4 xv = *(const f32x4*)(X + off + bj * HALF + n * 16); *(f32x4*)(X1 + off + bj * HALF + n * 16) = xv + gv[bj][n] * acc[ai][bj][m][n]; }
                asm volatile("" ::: "memory"); }
    }
};
struct EpiSwiglu {
    static constexpr bool PERM = true;
    unsigned char* ACT; const float* bgu;
    __device__ __forceinline__ void operator()(const f32x4 (&acc)[2][2][4][2], const Unit& u, int wr, int wc, int fr, int fq) const {
        const int row0 = u.pm * BM + wr * 64 + fr, col0 = u.pn * 128 + wc * 32 + 8 * fq;
        const float* bb = bgu + (size_t)u.e * 2 * DE + col0;
        const f32x4 bg0 = *(const f32x4*)(bb), bg1 = *(const f32x4*)(bb + 4), bu0 = *(const f32x4*)(bb + DE), bu1 = *(const f32x4*)(bb + DE + 4);
#pragma unroll
        for (int ai = 0; ai < 2; ++ai)
#pragma unroll
            for (int m = 0; m < 4; ++m) { float o[8];
#pragma unroll
                for (int n = 0; n < 2; ++n)
#pragma unroll
                    for (int j = 0; j < 4; ++j) { float g = acc[ai][0][m][n][j] * W8_INV + (n ? bg1[j] : bg0[j]), uu = acc[ai][1][m][n][j] * W8_INV + (n ? bu1[j] : bu0[j]);
                        g = fminf(g, 7.0f); uu = fminf(fmaxf(uu, -7.0f), 7.0f); o[4 * n + j] = (uu + 1.0f) * (g * sigmoidf_(1.702f * g)); }
                v2u w; w.x = __builtin_amdgcn_cvt_pk_fp8_f32(o[2], o[3], __builtin_amdgcn_cvt_pk_fp8_f32(o[0], o[1], 0, false), true);
                w.y = __builtin_amdgcn_cvt_pk_fp8_f32(o[6], o[7], __builtin_amdgcn_cvt_pk_fp8_f32(o[4], o[5], 0, false), true);
                *(v2u*)(ACT + (size_t)(row0 + ai * HALF + m * 16) * DE + col0) = w; }
    }
};
struct EpiDown {
    static constexpr bool PERM = true;
    bf16_t* Y; const float* bd;
    __device__ __forceinline__ void operator()(const f32x4 (&acc)[2][2][4][2], const Unit& u, int wr, int wc, int fr, int fq) const {
        const int row0 = u.pm * BM + wr * 64 + fr, col0 = u.pn * BM + wc * 32 + 8 * fq;
        const float* bb = bd + (size_t)u.e * D + col0;
#pragma unroll
        for (int bj = 0; bj < 2; ++bj) { const f32x4 b0 = *(const f32x4*)(bb + bj * HALF), b1 = *(const f32x4*)(bb + bj * HALF + 4);
#pragma unroll
            for (int ai = 0; ai < 2; ++ai)
#pragma unroll
                for (int m = 0; m < 4; ++m) { const f32x4 v0 = acc[ai][bj][m][0] * W8_INV + b0, v1 = acc[ai][bj][m][1] * W8_INV + b1;
                    u32x4 w; w.x = cvt_pk_bf16(v0[0], v0[1]); w.y = cvt_pk_bf16(v0[2], v0[3]); w.z = cvt_pk_bf16(v1[0], v1[1]); w.w = cvt_pk_bf16(v1[2], v1[3]);
                    *(u32x4*)(Y + (size_t)(row0 + ai * HALF + m * 16) * D + col0 + bj * HALF) = w; } }
    }
};
}

#define XB_TMO      128
#define XB_XCNT(j)  (256  + 64 * (j))
#define XB_XSUB(j)  (1280 + 64 * (j))
#define XB_XGEN(j)  (2304 + 64 * (j))
#define XB_TOP      3328
#define XB_TOPGEN   3392
#define XCD_BAR_WORDS 3456
#define XB_SPIN_CAP (1u << 18)
__device__ __forceinline__ unsigned xb_ld(unsigned* p)              { return __hip_atomic_load(p, __ATOMIC_RELAXED, __HIP_MEMORY_SCOPE_AGENT); }
__device__ __forceinline__ unsigned xb_add(unsigned* p, unsigned v) { return __hip_atomic_fetch_add(p, v, __ATOMIC_RELAXED, __HIP_MEMORY_SCOPE_AGENT); }
__device__ __forceinline__ unsigned xb_xcc_id() { return (unsigned)__builtin_amdgcn_s_getreg((3 << 11) | 20) & 0xFu; }
#define XB_SPIN(cond, bar) do { unsigned _sp = 0; while (cond) { __builtin_amdgcn_s_sleep(1); \
    if ((++_sp & 255u) == 0u) { if (xb_ld(&(bar)[XB_TMO])) break; if (_sp > XB_SPIN_CAP) { atomicAdd(&(bar)[XB_TMO], 1u); break; } } } } while (0)
struct XcdBarrier { unsigned* bar; unsigned x; volatile LAS unsigned* st; };
__device__ __forceinline__ XcdBarrier xcd_barrier_post(unsigned* bar, volatile LAS unsigned* st) {
    XcdBarrier b; b.bar = bar; b.x = xb_xcc_id(); b.st = st;
    if (threadIdx.x == 0) (void)xb_add(&bar[XB_XCNT(b.x)], 1u);
    return b;
}
__device__ __forceinline__ void xcd_barrier_complete(unsigned* bar, unsigned x, unsigned& nloc, unsigned& nx) {
    const unsigned G = gridDim.x * gridDim.y * gridDim.z;
    unsigned sum, cnt, mine, sp = 0u;
    for (;;) {
        sum = 0u; cnt = 0u; mine = 0u;
#pragma unroll
        for (unsigned j = 0; j < 16; ++j) { const unsigned c = xb_ld(&bar[XB_XCNT(j)]); sum += c; cnt += (c > 0u) ? 1u : 0u; mine = (j == x) ? c : mine; }
        if (sum == G) break;
        __builtin_amdgcn_s_sleep(1);
        if ((++sp & 255u) == 0u) { if (xb_ld(&bar[XB_TMO])) break; if (sp > XB_SPIN_CAP) { atomicAdd(&bar[XB_TMO], 1u); break; } }
    }
    nloc = mine > 0u ? mine : 1u; nx = cnt > 0u ? cnt : 1u;
}
__device__ __forceinline__ void xcd_barrier(const XcdBarrier& b) {
    asm volatile("s_waitcnt vmcnt(0)" ::: "memory");
    __syncthreads();
    if (threadIdx.x == 0) {
        unsigned* bar = b.bar;
        __builtin_amdgcn_s_waitcnt(0);
        unsigned nloc = b.st[0], nx = b.st[1];
        if (nloc == 0u) { xcd_barrier_complete(bar, b.x, nloc, nx); b.st[0] = nloc; b.st[1] = nx; }
        const unsigned old = xb_add(&bar[XB_XSUB(b.x)], 1u);
        const unsigned gen = old / nloc;
        if (old + 1u == (gen + 1u) * nloc) {
            __builtin_amdgcn_fence(__ATOMIC_RELEASE, "agent");
            asm volatile("s_waitcnt vmcnt(0)" ::: "memory");
            const unsigned og = xb_add(&bar[XB_TOP], 1u);
            const unsigned tg = og / nx;
            if (og + 1u == (tg + 1u) * nx) xb_add(&bar[XB_TOPGEN], 1u);
            else XB_SPIN(xb_ld(&bar[XB_TOPGEN]) == tg, bar);
            __builtin_amdgcn_fence(__ATOMIC_ACQUIRE, "agent");
            xb_add(&bar[XB_XGEN(b.x)], 1u);
            asm volatile("s_waitcnt vmcnt(0)" ::: "memory");
        } else {
            XB_SPIN(xb_ld(&bar[XB_XGEN(b.x)]) == gen, bar);
            __builtin_amdgcn_fence(__ATOMIC_ACQUIRE, "agent");
            asm volatile("s_waitcnt vmcnt(0)" ::: "memory");
        }
    }
    __syncthreads();
}

struct Frame {
    LAS unsigned char* lds;
    volatile LAS unsigned* MISC;
    gu32* ctl;
    int tid, lane, wave, G, bx;
    float* out; unsigned char* ws;
};
struct Args { const float* in[27]; float* out; unsigned char* ws; int ph_lo, ph_hi, li, pad; };
enum { I_X = 0, I_C, I_WADA, I_BADA, I_N1G, I_WIN, I_CONVW, I_CONVB, I_CLNG, I_CLNB, I_LCW, I_LCB, I_LWA, I_LBA, I_LWX, I_LBX, I_LAM, I_MIXG, I_WOUT, I_N2G, I_WR, I_BR, I_WGU, I_BGU, I_WD, I_BD, I_FNG };

__device__ __forceinline__ float wave_sum(float v) {
#pragma unroll
    for (int o = 1; o < 64; o <<= 1) v += __shfl_xor(v, o);
    return v;
}

__device__ __forceinline__ void p0_transpose_item(const float* W, int K, int N, bf16* WT, int drow0, LAS float* scr, int k0, int n0, int lane) {
#pragma unroll 8
    for (int i = 0; i < 32; ++i) { const int kk = 2 * i + (lane >> 5); scr[kk * 33 + (lane & 31)] = W[(size_t)(k0 + kk) * N + n0 + (lane & 31)]; }
    LDS_WAIT(); asm volatile("" ::: "memory");
    const int c = lane & 7;
#pragma unroll
    for (int j = 0; j < 4; ++j) { const int n = (lane >> 3) + 8 * j; const LAS float* s = scr + (8 * c) * 33 + n;
        v4u o; o.x = pk2(s[0 * 33], s[1 * 33]); o.y = pk2(s[2 * 33], s[3 * 33]); o.z = pk2(s[4 * 33], s[5 * 33]); o.w = pk2(s[6 * 33], s[7 * 33]);
        *(GAS v4u*)(WT + (size_t)(drow0 + n) * K + k0 + 8 * c) = o; }
    LDS_WAIT(); asm volatile("" ::: "memory");
}
__device__ __forceinline__ void p0_transpose_item_fp8(const float* W, int K, int N, unsigned char* WT, int drow0, LAS float* scr, int k0, int n0, int lane) {
#pragma unroll 8
    for (int i = 0; i < 32; ++i) { const int kk = 2 * i + (lane >> 5); scr[kk * 33 + (lane & 31)] = W[(size_t)(k0 + kk) * N + n0 + (lane & 31)]; }
    LDS_WAIT(); asm volatile("" ::: "memory");
    const int c = lane & 7;
#pragma unroll
    for (int j = 0; j < 4; ++j) { const int n = (lane >> 3) + 8 * j; const LAS float* s = scr + (8 * c) * 33 + n;
        v2u o; o.x = __builtin_amdgcn_cvt_pk_fp8_f32(s[2 * 33] * W8_SCALE, s[3 * 33] * W8_SCALE, __builtin_amdgcn_cvt_pk_fp8_f32(s[0 * 33] * W8_SCALE, s[1 * 33] * W8_SCALE, 0, false), true);
        o.y = __builtin_amdgcn_cvt_pk_fp8_f32(s[6 * 33] * W8_SCALE, s[7 * 33] * W8_SCALE, __builtin_amdgcn_cvt_pk_fp8_f32(s[4 * 33] * W8_SCALE, s[5 * 33] * W8_SCALE, 0, false), true);
        *(GAS v2u*)(WT + (size_t)(drow0 + n) * K + k0 + 8 * c) = o; }
    LDS_WAIT(); asm volatile("" ::: "memory");
}
__device__ __forceinline__ void p0_router_item(const float* W, bf16* WH, bf16* WL, LAS float* scr, int k0, int lane) {
#pragma unroll 8
    for (int i = 0; i < 32; ++i) { const int kk = 2 * i + (lane >> 5); scr[kk * 33 + (lane & 31)] = W[(size_t)(k0 + kk) * NE + (lane & 31)]; }
    LDS_WAIT(); asm volatile("" ::: "memory");
    const int c = lane & 7;
#pragma unroll
    for (int j = 0; j < 4; ++j) { const int n = (lane >> 3) + 8 * j; const LAS float* s = scr + (8 * c) * 33 + n;
        float v[8]; unsigned h[8], l[8];
#pragma unroll
        for (int e = 0; e < 8; ++e) { v[e] = s[e * 33]; h[e] = f2bf(v[e]); l[e] = f2bf(v[e] - bf2f(h[e])); }
        v4u oh, ol; oh.x = h[0] | (h[1] << 16); oh.y = h[2] | (h[3] << 16); oh.z = h[4] | (h[5] << 16); oh.w = h[6] | (h[7] << 16);
        ol.x = l[0] | (l[1] << 16); ol.y = l[2] | (l[3] << 16); ol.z = l[4] | (l[5] << 16); ol.w = l[6] | (l[7] << 16);
        *(GAS v4u*)(WH + (size_t)n * D + k0 + 8 * c) = oh; *(GAS v4u*)(WL + (size_t)n * D + k0 + 8 * c) = ol; }
    LDS_WAIT(); asm volatile("" ::: "memory");
}
__device__ __forceinline__ void p0_mod_item(Frame& F, const Args& args, LAS float* scr, int item) {
    const int cg = item % 96, ks = item / 96, col = cg * 64 + F.lane, k0 = ks * 256;
    const float* c = args.in[I_C]; const float* W = args.in[I_WADA];
#pragma unroll 4
    for (int i = 0; i < 32; ++i) { const int idx = i * 64 + F.lane, b = idx >> 8, kk = idx & 255; const float v = c[b * D + k0 + kk]; scr[idx] = v / (1.0f + __expf(-v)); }
    LDS_WAIT(); asm volatile("" ::: "memory");
    float acc[8];
#pragma unroll
    for (int b = 0; b < 8; ++b) acc[b] = 0.f;
#pragma unroll 4
    for (int kk = 0; kk < 256; kk += 4) {
        const float* wp = W + (size_t)(k0 + kk) * NMODW + col;
        const float w0 = wp[0], w1 = wp[NMODW], w2 = wp[2 * NMODW], w3 = wp[3 * NMODW];
#pragma unroll
        for (int b = 0; b < 8; ++b) { const f32x4 cv = *(const LAS f32x4*)(scr + b * 256 + kk); acc[b] += (cv.x * w0 + cv.y * w1) + (cv.z * w2 + cv.w * w3); }
    }
    float* mp = (float*)(F.ws + WS_MODP);
#pragma unroll
    for (int b = 0; b < 8; ++b) mp[(size_t)(ks * 8 + b) * NMODW + col] = acc[b];
    LDS_WAIT(); asm volatile("" ::: "memory");
}
__device__ __forceinline__ void p0_lrufrag_item(const Args& args, unsigned char* ws, int h, int lane) {
    const int j = lane & 15, q = lane >> 4;
#pragma unroll 1
    for (int f = 0; f < 16; ++f) { const int mat = f >> 3, n = (f >> 1) & 3, s = f & 1;
        const float* p = (mat ? args.in[14] : args.in[12]) + (size_t)(h * 64 + 32 * s + 8 * q) * 64 + 16 * n + j;
        v4u o; o.x = pk2(p[0], p[64]); o.y = pk2(p[128], p[192]); o.z = pk2(p[256], p[320]); o.w = pk2(p[384], p[448]);
        *((GAS v4u*)(ws + WS_LRUB) + (size_t)((h * 2 + mat) * 8 + n * 2 + s) * 64 + lane) = o; }
}
__device__ __forceinline__ int glu_row(int n, int half) {
    return n < half ? 256 * (n >> 7) + (n & 127) : 256 * ((n - half) >> 7) + 128 + ((n - half) & 127);
}
__device__ __forceinline__ void p0_prologue(Frame& F, const Args& args) {
    LAS float* scr = (LAS float*)(F.lds + F.wave * 16384);
    const int gw = F.bx * NWAVES + F.wave, NGW = F.G * NWAVES;
    if (gw >= NGW - 8) p0_lrufrag_item(args, F.ws, gw - (NGW - 8), F.lane);
    constexpr int I_MOD = 96 * 4, I_RT = 16, I_IN = 16 * 64, I_OUT = 16 * 32, I_GU = 32 * 16 * 64, I_DN = 32 * 16 * 32;
    constexpr int NITEMS = I_MOD + I_RT + I_IN + I_OUT + I_GU + I_DN;
    for (int it = gw; it < NITEMS; it += NGW) {
        int r = it;
        if (r < I_MOD) { p0_mod_item(F, args, scr, r); continue; } r -= I_MOD;
        if (r < I_RT) { p0_router_item(args.in[I_WR], (bf16*)(F.ws + WS_WRH), (bf16*)(F.ws + WS_WRL), scr, 64 * r, F.lane); continue; } r -= I_RT;
        if (r < I_IN) { const int kb = r >> 6, nb = r & 63, n0 = 32 * nb; const int dr = n0 < 1024 ? glu_row(n0, 512) : n0;
            p0_transpose_item(args.in[I_WIN], D, 2048, (bf16*)(F.ws + WS_WIN), dr, scr, 64 * kb, n0, F.lane); continue; } r -= I_IN;
        if (r < I_OUT) { const int kb = r >> 5, nb = r & 31; p0_transpose_item(args.in[I_WOUT], D, D, (bf16*)(F.ws + WS_WOUT), 32 * nb, scr, 64 * kb, 32 * nb, F.lane); continue; } r -= I_OUT;
        if (r < I_GU) { const int e = r >> 10, q = r & 1023, kb = q >> 6, nb = q & 63, n0 = 32 * nb;
            p0_transpose_item_fp8(args.in[I_WGU] + (size_t)e * D * 2048, D, 2048, F.ws + WS_WGU + (size_t)e * 2048 * D, glu_row(n0, 1024), scr, 64 * kb, n0, F.lane); continue; } r -= I_GU;
        { const int e = r >> 9, q = r & 511, kb = q >> 5, nb = q & 31;
            p0_transpose_item_fp8(args.in[I_WD] + (size_t)e * DE * D, DE, D, F.ws + WS_WD + (size_t)e * D * DE, 32 * nb, scr, 64 * kb, 32 * nb, F.lane); }
    }
}
__device__ __forceinline__ float mod_from_parts(const float* mp, const float* bada, int b, int j) {
    return bada[j] + ((mp[(size_t)(0 * 8 + b) * NMODW + j] + mp[(size_t)(1 * 8 + b) * NMODW + j]) + (mp[(size_t)(2 * 8 + b) * NMODW + j] + mp[(size_t)(3 * 8 + b) * NMODW + j]));
}
__device__ __forceinline__ void p1_norm1(Frame& F, const Args& args) {
    const float* mp = (const float*)(F.ws + WS_MODP); const float* bada = args.in[I_BADA]; float* mf = (float*)(F.ws + WS_MODF);
    for (int idx = F.bx * 512 + F.tid; idx < NB * NMODW; idx += F.G * 512) { const int b = idx / NMODW, j = idx - b * NMODW; mf[idx] = mod_from_parts(mp, bada, b, j); }
    const float* x = args.in[I_X]; const float* g1 = args.in[I_N1G]; bf16* H = (bf16*)(F.ws + WS_H);
    for (int rb = F.bx; rb < T / 128; rb += F.G) {
        const int b = rb >> 5;
        f32x4 A1[4], B1[4];
#pragma unroll
        for (int i = 0; i < 4; ++i)
#pragma unroll
            for (int e = 0; e < 4; ++e) { const int k = 256 * i + 4 * F.lane + e; A1[i][e] = g1[k] * (1.0f + mod_from_parts(mp, bada, b, D + k)); B1[i][e] = mod_from_parts(mp, bada, b, k); }
        for (int r = F.wave; r < 128; r += NWAVES) {
            const size_t row = (size_t)rb * 128 + r;
            const GAS f32x4* xr = (const GAS f32x4*)(x + row * D) + F.lane;
            f32x4 v[4]; float s = 0.f;
#pragma unroll
            for (int i = 0; i < 4; ++i) { v[i] = xr[64 * i]; s += (v[i].x * v[i].x + v[i].y * v[i].y) + (v[i].z * v[i].z + v[i].w * v[i].w); }
            const float rstd = rsqrtf(wave_sum(s) * (1.0f / D) + EPS);
            GAS v2u* o8 = (GAS v2u*)(H + row * D) + F.lane;
#pragma unroll
            for (int i = 0; i < 4; ++i) { const f32x4 h = v[i] * rstd * A1[i] + B1[i]; v2u w; w.x = pk2(h.x, h.y); w.y = pk2(h.z, h.w); o8[64 * i] = w; }
        }
    }
}

template <int N, int OFF> struct TRed {
    template <int M> static __device__ __forceinline__ void run(float (&v)[M], int lane) {
        constexpr int half = N / 2; const bool up = (lane & OFF) != 0;
#pragma unroll
        for (int i = 0; i < half; ++i) { const float send = up ? v[i] : v[i + half]; const float keep = up ? v[i + half] : v[i]; v[i] = keep + __shfl_xor(send, OFF); }
        if constexpr (half > 1) TRed<half, OFF / 2>::run(v, lane);
    }
};
template <int N> __device__ __forceinline__ float treduce(float (&v)[N], int lane) {
    TRed<N, 32>::run(v, lane);
    if (N == 32) v[0] += __shfl_xor(v[0], 1);
    return v[0];
}

__device__ __forceinline__ void conv_unit(Frame& F, const Args& args, int u) {
    const int t0 = 64 * u; const bool first = (t0 & (SEQ - 1)) == 0;
    LAS unsigned char* tile = F.lds;
    LAS float* RED = (LAS float*)(F.lds + 98304);
    LAS f32x2* ST = (LAS f32x2*)(F.lds + 98304 + 2048);
    LAS float* RED2 = (LAS float*)(F.lds + 98304 + 4096);
    LAS float* ST2 = (LAS float*)(F.lds + 98304 + 6144);
    const bf16* V = (const bf16*)(F.ws + WS_V);
    for (int p = F.tid; p < 94 * 64; p += 512) { const int row = p >> 6, c16 = p & 63;
        v4u val = (v4u){0u, 0u, 0u, 0u};
        if (!(first && row < 30)) val = *(const GAS v4u*)(V + (size_t)(t0 - 30 + row) * DC + c16 * 8);
        *(LAS v4u*)(tile + row * 1024 + c16 * 16) = val; }
    __syncthreads();
    int otid = F.tid; asm volatile("" : "+v"(otid));
    const int cp = otid & 255, th = otid >> 8, wq = F.wave & 3;
    float w0[31], w1[31];
    { const float* cw = args.in[I_CONVW] + 2 * cp;
#pragma unroll
      for (int k = 0; k < 31; ++k) { const f32x2 t = *(const f32x2*)(cw + k * DC); w0[k] = t.x; w1[k] = t.y; } }
    const f32x2 cb = *(const f32x2*)(args.in[I_CONVB] + 2 * cp);
    float o0[32], o1[32];
#pragma unroll
    for (int g = 0; g < 4; ++g) {
        float a0[8], a1[8];
#pragma unroll
        for (int j = 0; j < 8; ++j) { a0[j] = cb.x; a1[j] = cb.y; }
        const LAS unsigned char* tp = tile + (32 * th + 8 * g) * 1024 + cp * 4;
#pragma unroll
        for (int i = 0; i < 38; ++i) { const unsigned xw = *(const LAS unsigned*)(tp + i * 1024); const float x0 = bflo(xw), x1 = bfhi(xw);
#pragma unroll
            for (int j = 0; j < 8; ++j) { const int k = i - j; if (k >= 0 && k <= 30) { a0[j] += w0[k] * x0; a1[j] += w1[k] * x1; } } }
#pragma unroll
        for (int j = 0; j < 8; ++j) { o0[8 * g + j] = a0[j]; o1[8 * g + j] = a1[j]; }
    }
    { float vals[64];
#pragma unroll
      for (int t = 0; t < 32; ++t) { vals[t] = o0[t] + o1[t]; vals[32 + t] = o0[t] * o0[t] + o1[t] * o1[t]; }
      const float r = treduce<64>(vals, F.lane);
      RED[(th * 4 + wq) * 64 + F.lane] = r; }
    __syncthreads();
    if (F.tid < 64) { const int hh = F.tid >> 5, tk = F.tid & 31; float s1 = 0.f, s2 = 0.f;
#pragma unroll
        for (int w = 0; w < 4; ++w) { s1 += RED[(hh * 4 + w) * 64 + tk]; s2 += RED[(hh * 4 + w) * 64 + 32 + tk]; }
        const float mean = s1 * (1.0f / DC); const float var = fmaxf(s2 * (1.0f / DC) - mean * mean, 0.f);
        ST[F.tid] = (f32x2){mean, rsqrtf(var + EPS)}; }
    __syncthreads();
    const f32x2 lg = *(const f32x2*)(args.in[I_CLNG] + 2 * cp), lb = *(const f32x2*)(args.in[I_CLNB] + 2 * cp);
    { float vals[32];
#pragma unroll
      for (int t = 0; t < 32; ++t) { const f32x2 st = ST[th * 32 + t];
          const float y0 = (o0[t] - st.x) * st.y * lg.x + lb.x, y1 = (o1[t] - st.x) * st.y * lg.y + lb.y;
          o0[t] = y0 * sigmoidf_(y0); o1[t] = y1 * sigmoidf_(y1); vals[t] = o0[t] * o0[t] + o1[t] * o1[t]; }
      const float r = treduce<32>(vals, F.lane);
      if ((F.lane & 1) == 0) RED2[(th * 4 + wq) * 32 + (F.lane >> 1)] = r; }
    __syncthreads();
    if (F.tid < 64) { const int hh = F.tid >> 5, tk = F.tid & 31; float s = 0.f;
#pragma unroll
        for (int w = 0; w < 4; ++w) s += RED2[(hh * 4 + w) * 32 + tk];
        ST2[F.tid] = rsqrtf(s * (1.0f / DC) + EPS); }
    __syncthreads();
    const f32x2 mg = *(const f32x2*)(args.in[I_MIXG] + 2 * cp);
    bf16* YA = (bf16*)(F.ws + WS_H);
#pragma unroll
    for (int t = 0; t < 32; ++t) { const float rs = ST2[th * 32 + t];
        *(GAS unsigned*)(YA + (size_t)(t0 + 32 * th + t) * D + 2 * cp) = pk2(o0[t] * rs * mg.x, o1[t] * rs * mg.y); }
}

constexpr int LRU_WB = 7680;
template <int PASS>
__device__ __forceinline__ void lru_unit(Frame& F, const Args& args, int ck) {
    int lane = F.lane; asm volatile("" : "+v"(lane));
    const int h = F.wave, j = lane & 15, q = lane >> 4;
    const int b = ck >> 5, cs = ck & 31, t0 = ck * 128;
    LAS unsigned char* wl = F.lds + h * LRU_WB;
    LAS unsigned char* xt = wl + 35 * 144;
    LAS float* SS = (LAS float*)(F.lds + 8 * LRU_WB);
    const bf16* UREC = (const bf16*)(F.ws + WS_UREC); const bf16* GG = (const bf16*)(F.ws + WS_GG); bf16* YA = (bf16*)(F.ws + WS_H);
    float* SUMA = (float*)(F.ws + WS_SUMA); float* SUMH = (float*)(F.ws + WS_SUMH);
    LAS float* cst = (LAS float*)(F.lds + 8 * LRU_WB + 2048) + h * 512;
    { const int c = 64 * h + lane;
#pragma unroll
      for (int k = 0; k < 4; ++k) cst[k * 64 + lane] = args.in[I_LCW][k * 512 + c];
      cst[4 * 64 + lane] = args.in[I_LCB][c]; cst[5 * 64 + lane] = args.in[I_LBA][c]; cst[6 * 64 + lane] = args.in[I_LBX][c];
      const float z = -args.in[I_LAM][c]; cst[7 * 64 + lane] = fmaxf(z, 0.f) + log1pf(__expf(-fabsf(z))); }
    bf16x8 Ba[4][2], Bx[4][2];
    const unsigned l16 = (unsigned)lane * 16u;
#pragma unroll
    for (int n = 0; n < 4; ++n)
#pragma unroll
        for (int s = 0; s < 2; ++s) { const GAS unsigned char* fb = (const GAS unsigned char*)(F.ws + WS_LRUB) + (size_t)h * 16384 + (n * 2 + s) * 1024;
            Ba[n][s] = *(const GAS bf16x8*)(fb + l16); Bx[n][s] = *(const GAS bf16x8*)(fb + 8192 + l16); }
    float hc[4], Pt[4];
#pragma unroll
    for (int n = 0; n < 4; ++n) { hc[n] = 0.f; Pt[n] = 1.f; }
    if (PASS == 2) {
        float hv = 0.f;
        for (int c2 = 0; c2 < cs; ++c2) { const size_t idx = (size_t)(b * 32 + c2) * 512 + 64 * h + lane; hv = SUMA[idx] * hv + SUMH[idx]; }
#pragma unroll
        for (int n = 0; n < 4; ++n) hc[n] = __shfl(hv, 16 * n + j);
    }
    for (int sc = 0; sc < 4; ++sc) {
        const int ts = t0 + 32 * sc;
        v4u ggv[4];
        const unsigned lrow = (unsigned)(lane >> 3) * 1024u + (unsigned)h * 128u + (unsigned)(lane & 7) * 16u;
        if (PASS == 2) {
#pragma unroll
            for (int i = 0; i < 4; ++i) { const GAS unsigned char* gb = (const GAS unsigned char*)GG + (size_t)(ts + 8 * i) * 1024; ggv[i] = *(const GAS v4u*)(gb + lrow); }
        }
#pragma unroll
        for (int i = 0; i < 5; ++i) { const int p = lane + 64 * i;
            if (p < 280) { const int row = p >> 3, c8 = p & 7; v4u val = (v4u){0u, 0u, 0u, 0u};
                if (!(cs == 0 && sc == 0 && row < 3)) { const GAS unsigned char* ub = (const GAS unsigned char*)UREC + (size_t)(ts - 3 + 8 * i) * 1024; val = *(const GAS v4u*)(ub + lrow); }
                *(LAS v4u*)(wl + row * 144 + c8 * 16) = val; } }
#pragma unroll 1
        for (int tile = 0; tile < 2; ++tile) {
            float xr[4][4];
#pragma unroll
            for (int n = 0; n < 4; ++n) { float uu[7];
#pragma unroll
                for (int m = 0; m < 7; ++m) uu[m] = bf2f(*(const LAS unsigned short*)(wl + (16 * tile + 4 * q + m) * 144 + (16 * n + j) * 2));
                const float c0 = cst[16 * n + j], c1 = cst[64 + 16 * n + j], c2 = cst[128 + 16 * n + j], c3 = cst[192 + 16 * n + j], cbn = cst[256 + 16 * n + j];
#pragma unroll
                for (int r = 0; r < 4; ++r) xr[n][r] = cbn + ((c0 * uu[r] + c1 * uu[r + 1]) + (c2 * uu[r + 2] + c3 * uu[r + 3])); }
#pragma unroll
            for (int n = 0; n < 4; ++n)
#pragma unroll
                for (int r = 0; r < 4; ++r) *(LAS unsigned short*)(xt + (4 * q + r) * 144 + (16 * n + j) * 2) = (unsigned short)f2bf(xr[n][r]);
            const bf16x8 a0 = *(const LAS bf16x8*)(xt + j * 144 + 16 * q), a1 = *(const LAS bf16x8*)(xt + j * 144 + 64 + 16 * q);
#pragma unroll
            for (int n = 0; n < 4; ++n) {
                f32x4 za = (f32x4){0.f, 0.f, 0.f, 0.f}, zx = (f32x4){0.f, 0.f, 0.f, 0.f};
                za = __builtin_amdgcn_mfma_f32_16x16x32_bf16(a0, Ba[n][0], za, 0, 0, 0); za = __builtin_amdgcn_mfma_f32_16x16x32_bf16(a1, Ba[n][1], za, 0, 0, 0);
                zx = __builtin_amdgcn_mfma_f32_16x16x32_bf16(a0, Bx[n][0], zx, 0, 0, 0); zx = __builtin_amdgcn_mfma_f32_16x16x32_bf16(a1, Bx[n][1], zx, 0, 0, 0);
                float pp[4], hh[4];
                const float ban = cst[320 + 16 * n + j], bxn = cst[384 + 16 * n + j], spn = cst[448 + 16 * n + j];
#pragma unroll
                for (int r = 0; r < 4; ++r) { const float rg = sigmoidf_(za[r] + ban), ig = sigmoidf_(zx[r] + bxn);
                    const float la = -8.0f * rg * spn; const float a = __expf(la); const float mult = sqrtf(fmaxf(1.0f - a * a, 0.f)); const float inp = mult * (ig * xr[n][r]);
                    if (r == 0) { pp[0] = a; hh[0] = inp; } else { pp[r] = a * pp[r - 1]; hh[r] = a * hh[r - 1] + inp; } }
                float P = pp[3], H = hh[3];
                { const float Pp = __shfl_up(P, 16), Hp = __shfl_up(H, 16); if (q >= 1) { H = P * Hp + H; P = P * Pp; } }
                { const float Pp = __shfl_up(P, 32), Hp = __shfl_up(H, 32); if (q >= 2) { H = P * Hp + H; P = P * Pp; } }
                float Pe = __shfl_up(P, 16), He = __shfl_up(H, 16); if (q == 0) { Pe = 1.f; He = 0.f; }
                const float hq = Pe * hc[n] + He;
                if (PASS == 2) {
#pragma unroll
                    for (int r = 0; r < 4; ++r) *(LAS unsigned short*)(wl + (16 * tile + 4 * q + r) * 144 + (16 * n + j) * 2) = (unsigned short)f2bf(pp[r] * hq + hh[r]);
                }
                const float Pl = __shfl(P, 48 + j), Hl = __shfl(H, 48 + j);
                hc[n] = Pl * hc[n] + Hl; Pt[n] *= Pl;
            }
        }
        if (PASS == 2) {
            LAS float* ssb = SS + (sc & 1) * 256;
#pragma unroll
            for (int i = 0; i < 4; ++i) { const int tk = (lane >> 3) + 8 * i; const v4u hw = *(const LAS v4u*)(wl + tk * 144 + 16 * (lane & 7));
                float y[8];
                y[0] = bflo(ggv[i].x) * bflo(hw.x); y[1] = bfhi(ggv[i].x) * bfhi(hw.x); y[2] = bflo(ggv[i].y) * bflo(hw.y); y[3] = bfhi(ggv[i].y) * bfhi(hw.y);
                y[4] = bflo(ggv[i].z) * bflo(hw.z); y[5] = bfhi(ggv[i].z) * bfhi(hw.z); y[6] = bflo(ggv[i].w) * bflo(hw.w); y[7] = bfhi(ggv[i].w) * bfhi(hw.w);
                float s = 0.f;
#pragma unroll
                for (int e = 0; e < 8; ++e) s += y[e] * y[e];
                s += __shfl_xor(s, 1); s += __shfl_xor(s, 2); s += __shfl_xor(s, 4);
                if ((lane & 7) == 0) ssb[tk * 8 + h] = s; }
            __syncthreads();
            float mg[8];
            { const f32x4 m0 = *(const f32x4*)(args.in[I_MIXG] + 512 + 64 * h + 8 * (lane & 7)), m1 = *(const f32x4*)(args.in[I_MIXG] + 512 + 64 * h + 8 * (lane & 7) + 4);
              mg[0] = m0.x; mg[1] = m0.y; mg[2] = m0.z; mg[3] = m0.w; mg[4] = m1.x; mg[5] = m1.y; mg[6] = m1.z; mg[7] = m1.w; }
#pragma unroll
            for (int i = 0; i < 4; ++i) { const int tk = (lane >> 3) + 8 * i; const f32x4 s0 = *(const LAS f32x4*)(ssb + tk * 8), s1 = *(const LAS f32x4*)(ssb + tk * 8 + 4);
                const float rs = rsqrtf(((s0.x + s0.y) + (s0.z + s0.w) + (s1.x + s1.y) + (s1.z + s1.w)) * (1.0f / 512.0f) + EPS);
                const v4u hw = *(const LAS v4u*)(wl + tk * 144 + 16 * (lane & 7));
                float y[8];
                y[0] = bflo(ggv[i].x) * bflo(hw.x); y[1] = bfhi(ggv[i].x) * bfhi(hw.x); y[2] = bflo(ggv[i].y) * bflo(hw.y); y[3] = bfhi(ggv[i].y) * bfhi(hw.y);
                y[4] = bflo(ggv[i].z) * bflo(hw.z); y[5] = bfhi(ggv[i].z) * bfhi(hw.z); y[6] = bflo(ggv[i].w) * bflo(hw.w); y[7] = bfhi(ggv[i].w) * bfhi(hw.w);
                v4u w; w.x = pk2(y[0] * rs * mg[0], y[1] * rs * mg[1]); w.y = pk2(y[2] * rs * mg[2], y[3] * rs * mg[3]);
                w.z = pk2(y[4] * rs * mg[4], y[5] * rs * mg[5]); w.w = pk2(y[6] * rs * mg[6], y[7] * rs * mg[7]);
                { GAS unsigned char* yb = (GAS unsigned char*)YA + (size_t)(ts + 8 * i) * 2048 + 1024; *(GAS v4u*)(yb + ((unsigned)(lane >> 3) * 2048u + (unsigned)h * 128u + (unsigned)(lane & 7) * 16u)) = w; } }
        }
    }
    if (PASS == 1) {
        const float pv = q == 0 ? Pt[0] : q == 1 ? Pt[1] : q == 2 ? Pt[2] : Pt[3];
        const float hv = q == 0 ? hc[0] : q == 1 ? hc[1] : q == 2 ? hc[2] : hc[3];
        SUMA[(size_t)ck * 512 + 64 * h + lane] = pv; SUMH[(size_t)ck * 512 + 64 * h + lane] = hv;
    }
}

__device__ __forceinline__ void p6_router(Frame& F, const Args& args) {
    constexpr int RS = 2064;
    LAS unsigned char* HI = F.lds; LAS unsigned char* LO = F.lds + 16 * RS;
    LAS float* PLOG = (LAS float*)(F.lds + 32 * RS);
    LAS int* SEL = (LAS int*)(F.lds + 32 * RS + 16384);
    LAS int* CNTW = (LAS int*)(F.lds + 32 * RS + 16384 + 2048);
    const float* X1 = (const float*)(F.ws + WS_X1); unsigned char* H2 = F.ws + WS_H; const float* mf = (const float*)(F.ws + WS_MODF);
    const bf16* WRH = (const bf16*)(F.ws + WS_WRH); const bf16* WRL = (const bf16*)(F.ws + WS_WRL);
    int* TOPI = (int*)(F.ws + WS_TOPI); float* TOPG = (float*)(F.ws + WS_TOPG); int* LRANK = (int*)(F.ws + WS_LRANK); int* BCNT = (int*)(F.ws + WS_BCNT);
    const int lane = F.lane, w = F.wave, j = lane & 15, q = lane >> 4;
    for (int rb = F.bx; rb < T / 128; rb += F.G) {
        const int b = rb >> 5;
        f32x4 A2[4], B2[4];
#pragma unroll
        for (int i = 0; i < 4; ++i) { const int k = 256 * i + 4 * lane; const f32x4 g = *(const f32x4*)(args.in[I_N2G] + k), sc = *(const f32x4*)(mf + (size_t)b * NMODW + 4 * D + k);
            A2[i] = g * (sc + 1.0f); B2[i] = *(const f32x4*)(mf + (size_t)b * NMODW + 3 * D + k); }
        bf16x8 bh[4][2], bl[4][2];
#pragma unroll
        for (int s = 0; s < 4; ++s)
#pragma unroll
            for (int n = 0; n < 2; ++n) { const size_t o = (size_t)(16 * n + j) * D + 128 * w + 32 * s + 8 * q; bh[s][n] = *(const GAS bf16x8*)(WRH + o); bl[s][n] = *(const GAS bf16x8*)(WRL + o); }
        f32x4 xv[2][4];
#pragma unroll
        for (int rr = 0; rr < 2; ++rr)
#pragma unroll
            for (int i = 0; i < 4; ++i) xv[rr][i] = *((const GAS f32x4*)(X1 + ((size_t)rb * 128 + 2 * w + rr) * D) + lane + 64 * i);
        for (int tile = 0; tile < 8; ++tile) {
#pragma unroll
            for (int rr = 0; rr < 2; ++rr) { const int r = 2 * w + rr; const size_t t = (size_t)rb * 128 + 16 * tile + r;
                float s = 0.f;
#pragma unroll
                for (int i = 0; i < 4; ++i) s += (xv[rr][i].x * xv[rr][i].x + xv[rr][i].y * xv[rr][i].y) + (xv[rr][i].z * xv[rr][i].z + xv[rr][i].w * xv[rr][i].w);
                const float rstd = rsqrtf(wave_sum(s) * (1.0f / D) + EPS);
#pragma unroll
                for (int i = 0; i < 4; ++i) { const f32x4 hv = xv[rr][i] * rstd * A2[i] + B2[i];
                    unsigned hb[4], lb[4];
#pragma unroll
                    for (int e = 0; e < 4; ++e) { hb[e] = f2bf(hv[e]); lb[e] = f2bf(hv[e] - bf2f(hb[e])); }
                    v2u wh, wl2; wh.x = hb[0] | (hb[1] << 16); wh.y = hb[2] | (hb[3] << 16); wl2.x = lb[0] | (lb[1] << 16); wl2.y = lb[2] | (lb[3] << 16);
                    *((GAS unsigned*)(H2 + t * D) + lane + 64 * i) = __builtin_amdgcn_cvt_pk_fp8_f32(hv[2], hv[3], __builtin_amdgcn_cvt_pk_fp8_f32(hv[0], hv[1], 0, false), true);
                    *(LAS v2u*)(HI + r * RS + (4 * lane + 256 * i) * 2) = wh; *(LAS v2u*)(LO + r * RS + (4 * lane + 256 * i) * 2) = wl2; }
            }
            if (tile < 7) {
#pragma unroll
                for (int rr = 0; rr < 2; ++rr)
#pragma unroll
                    for (int i = 0; i < 4; ++i) xv[rr][i] = *((const GAS f32x4*)(X1 + ((size_t)rb * 128 + 16 * (tile + 1) + 2 * w + rr) * D) + lane + 64 * i);
            }
            __syncthreads();
            f32x4 acc[2]; acc[0] = (f32x4){0.f, 0.f, 0.f, 0.f}; acc[1] = acc[0];
#pragma unroll
            for (int s = 0; s < 4; ++s) { const int ko = (128 * w + 32 * s + 8 * q) * 2;
                const bf16x8 ah = *(const LAS bf16x8*)(HI + j * RS + ko), al = *(const LAS bf16x8*)(LO + j * RS + ko);
#pragma unroll
                for (int n = 0; n < 2; ++n) { acc[n] = __builtin_amdgcn_mfma_f32_16x16x32_bf16(ah, bh[s][n], acc[n], 0, 0, 0);
                    acc[n] = __builtin_amdgcn_mfma_f32_16x16x32_bf16(ah, bl[s][n], acc[n], 0, 0, 0); acc[n] = __builtin_amdgcn_mfma_f32_16x16x32_bf16(al, bh[s][n], acc[n], 0, 0, 0); } }
#pragma unroll
            for (int n = 0; n < 2; ++n)
#pragma unroll
                for (int r = 0; r < 4; ++r) PLOG[(w * 16 + 4 * q + r) * 32 + 16 * n + j] = acc[n][r];
            __syncthreads();
            { const int tk = F.tid >> 5, e = F.tid & 31;
              float lg = args.in[I_BR][e];
#pragma unroll
              for (int w2 = 0; w2 < 8; ++w2) lg += PLOG[(w2 * 16 + tk) * 32 + e];
              float tv[4]; int ti[4]; float v = lg;
#pragma unroll
              for (int k = 0; k < 4; ++k) { float bv = v; int bi = e;
#pragma unroll
                  for (int off = 1; off < 32; off <<= 1) { const float ov = __shfl_xor(bv, off); const int oi = __shfl_xor(bi, off); if (ov > bv || (ov == bv && oi < bi)) { bv = ov; bi = oi; } }
                  tv[k] = bv; ti[k] = bi; if (e == bi) v = -3.0e38f; }
              const float e1 = __expf(tv[1] - tv[0]), e2 = __expf(tv[2] - tv[0]), e3 = __expf(tv[3] - tv[0]); const float inv = 1.0f / (1.0f + e1 + e2 + e3);
              if (e < 4) { const float gk = (e == 0 ? 1.0f : e == 1 ? e1 : e == 2 ? e2 : e3) * inv; const int ik = e == 0 ? ti[0] : e == 1 ? ti[1] : e == 2 ? ti[2] : ti[3];
                  const size_t t = (size_t)rb * 128 + 16 * tile + tk; TOPI[t * 4 + e] = ik; TOPG[t * 4 + e] = gk; SEL[(16 * tile + tk) * 4 + e] = ik; } }
        }
        __syncthreads();
        { const int myE = SEL[F.tid]; int rk = 0, cm = 0;
#pragma unroll 1
          for (int e = 0; e < 32; ++e) { const unsigned long long m = __ballot(myE == e); if (myE == e) rk = __popcll(m & ((1ull << lane) - 1ull)); if (lane == e) cm = __popcll(m); }
          if (lane < 32) CNTW[w * 32 + lane] = cm;
          __syncthreads();
          int base = 0;
          for (int w2 = 0; w2 < w; ++w2) base += CNTW[w2 * 32 + myE];
          LRANK[(size_t)rb * 512 + F.tid] = base + rk;
          if (F.tid < 32) { int tot = 0;
#pragma unroll
              for (int w2 = 0; w2 < 8; ++w2) tot += CNTW[w2 * 32 + F.tid];
              BCNT[rb * 32 + F.tid] = tot; } }
        __syncthreads();
    }
}
__device__ __forceinline__ void p7_positions(Frame& F) {
    LAS int* PT = (LAS int*)F.lds; LAS int* PB = PT + 512; LAS int* TOT = PB + 512; LAS int* BEF = TOT + 32; LAS int* PS = BEF + 32;
    const int* BCNT = (const int*)(F.ws + WS_BCNT); const int* TOPI = (const int*)(F.ws + WS_TOPI); const int* LRANK = (const int*)(F.ws + WS_LRANK);
    int* POSOF = (int*)(F.ws + WS_POSOF); int* ROWTOK = (int*)(F.ws + WS_ROWTOK); int* META = (int*)(F.ws + WS_META);
    for (int rb = F.bx; rb < T / 128; rb += F.G) {
        { const int e = F.tid & 31, part = F.tid >> 5; int tot = 0, bef = 0;
          for (int c2 = part * 16; c2 < part * 16 + 16; ++c2) { const int v = BCNT[c2 * 32 + e]; tot += v; if (c2 < rb) bef += v; }
          PT[F.tid] = tot; PB[F.tid] = bef; }
        __syncthreads();
        if (F.tid < 32) { int tot = 0, bef = 0;
#pragma unroll
            for (int p = 0; p < 16; ++p) { tot += PT[p * 32 + F.tid]; bef += PB[p * 32 + F.tid]; }
            TOT[F.tid] = tot; BEF[F.tid] = bef; }
        __syncthreads();
        if (F.tid == 0) { int run = 0; for (int e = 0; e < 32; ++e) { PS[e] = run; run += ((TOT[e] + 255) >> 8) << 8; } PS[32] = run; }
        __syncthreads();
        { const size_t pi = (size_t)rb * 512 + F.tid; const int e = TOPI[pi]; const int pos = PS[e] + BEF[e] + LRANK[pi]; ROWTOK[pos] = rb * 128 + (F.tid >> 2); POSOF[pi] = pos; }
        if (rb < 32) { const int e = rb, lim = ((TOT[e] + 255) >> 8) << 8; for (int r = TOT[e] + F.tid; r < lim; r += 512) ROWTOK[PS[e] + r] = 0; }
        if (rb == 0 && F.tid <= 32) META[F.tid] = PS[F.tid] >> 8;
        __syncthreads();
    }
}
__device__ __forceinline__ int moe_tables(Frame& F, LAS int* texp) {
    const int* META = (const int*)(F.ws + WS_META);
    const int MT = META[32];
    for (int pm = F.tid; pm < MT; pm += 512) { int e = 0;
#pragma unroll 1
        for (int k = 1; k < 32; ++k) if (META[k] <= pm) e = k;
        texp[pm] = e; }
    __syncthreads();
    return MT;
}
__device__ __forceinline__ void p10_combine(Frame& F, const Args& args) {
    const float* X1 = (const float*)(F.ws + WS_X1); const bf16* Y = (const bf16*)(F.ws + WS_Y); const float* mf = (const float*)(F.ws + WS_MODF);
    const int* POSOF = (const int*)(F.ws + WS_POSOF); const float* TOPG = (const float*)(F.ws + WS_TOPG);
    const int lane = F.lane;
    for (int rb = F.bx; rb < T / 128; rb += F.G) {
        const int b = rb >> 5;
        f32x4 g2[4], fg[4];
#pragma unroll
        for (int i = 0; i < 4; ++i) { g2[i] = *(const f32x4*)(mf + (size_t)b * NMODW + 5 * D + 256 * i + 4 * lane); fg[i] = *(const f32x4*)(args.in[I_FNG] + 256 * i + 4 * lane); }
        for (int r = F.wave; r < 128; r += NWAVES) {
            const size_t t = (size_t)rb * 128 + r;
            const int p0 = POSOF[t * 4 + 0], p1 = POSOF[t * 4 + 1], p2 = POSOF[t * 4 + 2], p3 = POSOF[t * 4 + 3];
            const float k0 = TOPG[t * 4 + 0], k1 = TOPG[t * 4 + 1], k2 = TOPG[t * 4 + 2], k3 = TOPG[t * 4 + 3];
            f32x4 o[4]; float s = 0.f;
#pragma unroll
            for (int i = 0; i < 4; ++i) {
                const f32x4 xv = *((const GAS f32x4*)(X1 + t * D) + lane + 64 * i);
                const v2u y0 = *((const GAS v2u*)(Y + (size_t)p0 * D) + lane + 64 * i), y1 = *((const GAS v2u*)(Y + (size_t)p1 * D) + lane + 64 * i);
                const v2u y2 = *((const GAS v2u*)(Y + (size_t)p2 * D) + lane + 64 * i), y3 = *((const GAS v2u*)(Y + (size_t)p3 * D) + lane + 64 * i);
                f32x4 m;
                m.x = (k0 * bflo(y0.x) + k1 * bflo(y1.x)) + (k2 * bflo(y2.x) + k3 * bflo(y3.x)); m.y = (k0 * bfhi(y0.x) + k1 * bfhi(y1.x)) + (k2 * bfhi(y2.x) + k3 * bfhi(y3.x));
                m.z = (k0 * bflo(y0.y) + k1 * bflo(y1.y)) + (k2 * bflo(y2.y) + k3 * bflo(y3.y)); m.w = (k0 * bfhi(y0.y) + k1 * bfhi(y1.y)) + (k2 * bfhi(y2.y) + k3 * bfhi(y3.y));
                o[i] = xv + g2[i] * m; s += (o[i].x * o[i].x + o[i].y * o[i].y) + (o[i].z * o[i].z + o[i].w * o[i].w); }
            const float rstd = rsqrtf(wave_sum(s) * (1.0f / D) + EPS);
#pragma unroll
            for (int i = 0; i < 4; ++i) *((GAS f32x4*)(F.out + t * D) + lane + 64 * i) = o[i] * rstd * fg[i];
        }
    }
}

__global__ void __launch_bounds__(NWAVES * 64, 2) hymba_fwd(Args args) {
    extern __shared__ __attribute__((aligned(16))) unsigned char lds[];
    Frame F;
    F.lds = (LAS unsigned char*)lds;
    F.MISC = (volatile LAS unsigned*)(F.lds + MISC_OFF);
    F.tid = threadIdx.x; F.lane = F.tid & 63; F.wave = __builtin_amdgcn_readfirstlane(F.tid >> 6);
    F.G = gridDim.x; F.bx = blockIdx.x;
    F.out = args.out; F.ws = args.ws; F.ctl = (gu32*)(args.ws + WS_CTL);
    for (int u = F.tid; u < (LDS_BYTES - LDSCTL_OFF) / 4; u += NWAVES * 64) ((LAS unsigned*)(F.lds + LDSCTL_OFF))[u] = 0u;
    __syncthreads();
    XcdBarrier bar; bar.bar = (unsigned*)(F.ctl + CW_BAR); bar.x = 0; bar.st = nullptr;
    if (N_LAUNCHES != PER_PHASE) bar = xcd_barrier_post((unsigned*)(F.ctl + CW_BAR) + args.li * XCD_BAR_WORDS, F.MISC + 8);
#define GRID_BAR() do { if (N_LAUNCHES != PER_PHASE) xcd_barrier(bar); } while (0)
    const int lo = args.ph_lo, hi = args.ph_hi;
#define IN(k) (lo <= (k) && (k) < hi)
#define BOTH(k) (IN(k) && IN((k) + 1))
    const PG8_LAS unsigned* gtab = (const PG8_LAS unsigned*)(F.lds + AUX_OFF);
    LAS int* texp = (LAS int*)(F.lds + AUX_OFF + AUX_TEXP);

    if (IN(0)) { p0_prologue(F, args); if (BOTH(0)) GRID_BAR(); }
    if (IN(1)) { p1_norm1(F, args); if (BOTH(1)) GRID_BAR(); }
    if (IN(2)) {
        pg8::Order S; S.init(T / 256, 2048 / 256, F.G, F.bx, F.ws + WS_H, F.ws + WS_WIN, D, 0, nullptr, false);
        pg8::EpiInProj E{(bf16*)(F.ws + WS_V), (bf16*)(F.ws + WS_GG), (bf16*)(F.ws + WS_UREC)};
        pg8::gemm_phase<pg8::EpiInProj, pg8::Order, false, true, true, false>(F.lds, D, S, E, gtab);
        if (BOTH(2)) GRID_BAR();
    }
    if (IN(3)) {
        for (int ck = F.bx; ck < T / 128; ck += F.G) { lru_unit<1>(F, args, ck); __syncthreads(); }
        for (int u = F.bx; u < T / 64; u += F.G) { conv_unit(F, args, u); __syncthreads(); }
        if (BOTH(3)) GRID_BAR();
    }
    if (IN(4)) {
        for (int ck = F.bx; ck < T / 128; ck += F.G) { lru_unit<2>(F, args, ck); __syncthreads(); }
        if (BOTH(4)) GRID_BAR();
    }
    if (IN(5)) {
        pg8::Order S; S.init(T / 256, D / 256, F.G, F.bx, F.ws + WS_H, F.ws + WS_WOUT, D, 0, nullptr, false);
        pg8::EpiOutProj E{args.in[I_X], (float*)(F.ws + WS_X1), (const float*)(F.ws + WS_MODF)};
        pg8::gemm_phase<pg8::EpiOutProj, pg8::Order, false, true, true, false>(F.lds, D, S, E, gtab);
        if (BOTH(5)) GRID_BAR();
    }
    if (IN(6)) { p6_router(F, args); if (BOTH(6)) GRID_BAR(); }
    if (IN(7)) { p7_positions(F); if (BOTH(7)) GRID_BAR(); }
    if (IN(8)) {
        const int MT = moe_tables(F, texp);
        pg8::Order S; S.init(MT, 2048 / 256, F.G, F.bx, F.ws + WS_H, F.ws + WS_WGU, D / 2, (size_t)2048 * D, texp, true);
        { const int* ROWTOK = (const int*)(F.ws + WS_ROWTOK); pg8::Unit u; LAS unsigned* gt = (LAS unsigned*)(F.lds + AUX_OFF);
          for (int i = 0; i < 18 && S.next(i, u); ++i) if (F.tid < 256) gt[i * 256 + F.tid] = (unsigned)ROWTOK[u.pm * 256 + F.tid] * (unsigned)D; }
        __syncthreads();
        pg8::EpiSwiglu E{F.ws + WS_ACT, args.in[I_BGU]};
        pg8::gemm_phase<pg8::EpiSwiglu, pg8::Order, true, true, true, true>(F.lds, D / 2, S, E, gtab);
        if (BOTH(8)) GRID_BAR();
    }
    if (IN(9)) {
        const int MT = moe_tables(F, texp);
        pg8::Order S; S.init(MT, D / 256, F.G, F.bx, F.ws + WS_ACT, F.ws + WS_WD, DE / 2, (size_t)D * DE, texp, false);
        pg8::EpiDown E{(bf16*)(F.ws + WS_Y), args.in[I_BD]};
        pg8::gemm_phase<pg8::EpiDown, pg8::Order, false, true, true, true>(F.lds, DE / 2, S, E, gtab);
        if (BOTH(9)) GRID_BAR();
    }
    if (IN(10)) { p10_combine(F, args); }
#undef IN
#undef BOTH
}

extern "C" void kernel_launch(void* const* d_in, const int* in_sizes, int n_in, void* d_out, int out_size, void* d_ws, size_t ws_size, hipStream_t stream) {
    static int grid = 0;
    if (grid == 0) {
        if (n_in != 27 || in_sizes[0] != T * D || out_size != T * D || ws_size < WS_END) { fprintf(stderr, "kernel_launch: unexpected shapes (n_in %d, in0 %d, out %d, ws %zu); nothing launched\n", n_in, n_in > 0 ? in_sizes[0] : -1, out_size, ws_size); grid = -1; return; }
        int dev = 0, cus = 0, per_cu = 0;
        if (hipGetDevice(&dev) != hipSuccess || hipDeviceGetAttribute(&cus, hipDeviceAttributeMultiprocessorCount, dev) != hipSuccess) { grid = -1; return; }
        if (hipFuncSetAttribute((const void*)hymba_fwd, hipFuncAttributeMaxDynamicSharedMemorySize, LDS_BYTES) != hipSuccess) { fprintf(stderr, "kernel_launch: hipFuncSetAttribute failed\n"); grid = -1; return; }
        if (hipOccupancyMaxActiveBlocksPerMultiprocessor(&per_cu, (const void*)hymba_fwd, NWAVES * 64, LDS_BYTES) != hipSuccess || per_cu < 1)
            fprintf(stderr, "kernel_launch: note: occupancy query reports %d workgroups per CU\n", per_cu);
        (void)hipGetLastError();
        grid = cus;
    }
    if (grid < 0) return;
    if (hipMemsetAsync((char*)d_ws + WS_CTL, 0, CTL_ZERO_BYTES, stream) != hipSuccess) return;
    Args a{};
    for (int i = 0; i < 27; ++i) a.in[i] = (const float*)d_in[i];
    a.out = (float*)d_out; a.ws = (unsigned char*)d_ws;
    if (N_LAUNCHES == 1) { a.ph_lo = 0; a.ph_hi = PER_PHASE; a.li = 0; hipLaunchKernelGGL(hymba_fwd, dim3(grid), dim3(NWAVES * 64), LDS_BYTES, stream, a); }
    else { for (int li = 0; li < PER_PHASE; ++li) { a.ph_lo = li; a.ph_hi = li + 1; a.li = 0; hipLaunchKernelGGL(hymba_fwd, dim3(grid), dim3(NWAVES * 64), LDS_BYTES, stream, a); } }
    const hipError_t le = hipPeekAtLastError();
    if (le != hipSuccess) fprintf(stderr, "kernel_launch: launch failed: %s\n", hipGetErrorName(le));
}
```

```cpp
#include <hip/hip_runtime.h>
#include <cstdio>
#include <cstdint>

#define GAS __attribute__((address_space(1)))
#define LAS __attribute__((address_space(3)))
typedef unsigned short bf16;
typedef unsigned v4u __attribute__((ext_vector_type(4)));
typedef unsigned v2u __attribute__((ext_vector_type(2)));
typedef float f32x4 __attribute__((ext_vector_type(4)));
typedef float f32x2 __attribute__((ext_vector_type(2)));
typedef short bf16x8 __attribute__((ext_vector_type(8)));
typedef GAS unsigned gu32;
#define RLX_AGENT __ATOMIC_RELAXED, __HIP_MEMORY_SCOPE_AGENT
#define LDS_WAIT() asm volatile("s_waitcnt lgkmcnt(0)" ::: "memory")
#define VM_WAIT() asm volatile("s_waitcnt vmcnt(0)" ::: "memory")

constexpr int NB = 8, SEQ = 4096, T = NB * SEQ, D = 1024, DC = 512, NE = 32, TOPK = 4, DE = 1024, NMODW = 6 * D;
constexpr int NPAIR = T * TOPK, MAXROWS = NPAIR + NE * 256, MAXMT = MAXROWS / 256;
constexpr float EPS = 1e-6f;
constexpr int NWAVES = 8;
#ifndef MK_N_LAUNCHES
#define MK_N_LAUNCHES 1
#endif
constexpr int N_LAUNCHES = MK_N_LAUNCHES;
constexpr int PER_PHASE = 11;

constexpr size_t MiB = 1u << 20, KiB = 1024;
constexpr size_t WS_CTL = 0, CTL_ZERO_BYTES = 1 * MiB;
constexpr size_t WS_MODP = 1 * MiB;
constexpr size_t WS_MODF = 2 * MiB;
constexpr size_t WS_WRH = 2 * MiB + 256 * KiB, WS_WRL = WS_WRH + 64 * KiB;
constexpr size_t WS_SUMA = 2 * MiB + 512 * KiB, WS_SUMH = 3 * MiB;
constexpr size_t WS_TOPI = 3 * MiB + 512 * KiB, WS_TOPG = 4 * MiB, WS_LRANK = 4 * MiB + 512 * KiB, WS_POSOF = 5 * MiB;
constexpr size_t WS_BCNT = 5 * MiB + 512 * KiB, WS_META = WS_BCNT + 64 * KiB;
constexpr size_t WS_ROWTOK = 6 * MiB;
constexpr size_t WS_LRUB = 7 * MiB;
constexpr size_t WS_WIN = 16 * MiB, WS_WOUT = 20 * MiB;
constexpr size_t WS_WD = 24 * MiB;
constexpr size_t WS_WGU = 56 * MiB;
constexpr size_t WS_H = 120 * MiB;
constexpr size_t WS_V = 184 * MiB, WS_GG = 216 * MiB, WS_UREC = 248 * MiB;
constexpr size_t WS_X1 = 280 * MiB;
constexpr size_t WS_ACT = 408 * MiB;
constexpr size_t WS_Y = 544 * MiB;
constexpr size_t WS_END = 816 * MiB;
static_assert(WS_ACT + (size_t)MAXROWS * DE <= WS_Y && WS_Y + (size_t)MAXROWS * D <= WS_END, "ws map");
constexpr float Y8_SCALE = 16.0f, Y8_INV = 1.0f / 16.0f;
constexpr float W8_SCALE = 64.0f, W8_INV = 1.0f / 64.0f;
constexpr int CW_BAR = 4096;

constexpr int RING_BYTES = 131072, AUX_OFF = 131072, AUX_BYTES = 24576, LDSCTL_OFF = AUX_OFF + AUX_BYTES, MISC_OFF = LDSCTL_OFF + 320, LDS_BYTES = LDSCTL_OFF + 1024;
constexpr int AUX_TEXP = 18432;
static_assert(AUX_TEXP + MAXMT * 4 <= AUX_BYTES, "aux");

__device__ __forceinline__ unsigned f2bf(float f) { unsigned u = __builtin_bit_cast(unsigned, f); return (u + 0x7fffu + ((u >> 16) & 1u)) >> 16; }
__device__ __forceinline__ unsigned pk2(float lo, float hi) { return f2bf(lo) | (f2bf(hi) << 16); }
__device__ __forceinline__ float bf2f(unsigned b) { return __builtin_bit_cast(float, b << 16); }
__device__ __forceinline__ float bflo(unsigned w) { return __builtin_bit_cast(float, w << 16); }
__device__ __forceinline__ float bfhi(unsigned w) { return __builtin_bit_cast(float, w & 0xffff0000u); }
__device__ __forceinline__ float sigmoidf_(float z) { return __builtin_amdgcn_rcpf(1.0f + __expf(-z)); }

namespace pg8 {
#define PG8_LAS __attribute__((address_space(3)))
typedef unsigned short bf16_t;
typedef unsigned u32x4 __attribute__((ext_vector_type(4)));
constexpr int BM = 256, BK = 64, HALF = 128, HTB = HALF * BK * 2, STAGE_BYTES = 8 * HTB, NXCD = 8, WGM = 8;
__host__ __device__ __forceinline__ int lds_byte(int r, int c) { const int st = (r >> 4) * 2 + (c >> 5), rr = r & 15, cc = c & 31, ob = rr * 64 + cc * 2; return st * 1024 + (ob ^ (((ob >> 9) & 1) << 5)); }
__host__ __device__ __forceinline__ void stage_rc(int b, int& R, int& C) { const int st = b / 1024, sb = b % 1024, swz = sb ^ (((sb >> 9) & 1) << 5); R = (st >> 1) * 16 + swz / 64; C = (st & 1) * 32 + (swz % 64) / 2; }
__host__ __device__ __forceinline__ int perm32(int rho) { const int n = rho >> 4, i = rho & 15; return 8 * (i >> 2) + 4 * n + (i & 3); }
__device__ __forceinline__ unsigned cvt_pk_bf16(float lo, float hi) { unsigned r; asm volatile("v_cvt_pk_bf16_f32 %0, %1, %2" : "=v"(r) : "v"(lo), "v"(hi)); return r; }

typedef int v8i __attribute__((ext_vector_type(8)));
typedef int v4i __attribute__((ext_vector_type(4)));
__device__ __forceinline__ v8i cat8(bf16x8 lo, bf16x8 hi) { const v4i a = __builtin_bit_cast(v4i, lo), b = __builtin_bit_cast(v4i, hi); return __builtin_shufflevector(a, b, 0, 1, 2, 3, 4, 5, 6, 7); }
struct Unit { int pm, pn, e; };

struct Order {
    int nM, nN, nwg, G, c; const char* A; const char* Bt; size_t tstep, estep; const PG8_LAS int* texp; bool gather;
    __device__ __forceinline__ void init(int nM_, int nN_, int G_, int c_, const void* A_, const void* Bt_, int K, size_t estep_, const PG8_LAS int* texp_, bool gather_) {
        nM = nM_; nN = nN_; nwg = nM * nN; G = G_; c = c_; A = (const char*)A_; Bt = (const char*)Bt_; tstep = (size_t)BM * K * 2; estep = estep_; texp = texp_; gather = gather_; }
    __device__ __forceinline__ bool next(int i, Unit& u) const {
        const long L = (long)i * G + c; if (L >= nwg) return false;
        int wgid = (int)L; { const int q = nwg / NXCD, r = nwg % NXCD, xcd = wgid % NXCD, off = wgid / NXCD; wgid = (xcd < r ? xcd * (q + 1) : r * (q + 1) + (xcd - r) * q) + off; }
        const int nig = WGM * nN, gid = wgid / nig, fm = gid * WGM, gsz = (nM - fm) < WGM ? (nM - fm) : WGM;
        u.pm = fm + ((wgid % nig) % gsz); u.pn = (wgid % nig) / gsz; u.e = texp ? __builtin_amdgcn_readfirstlane(texp[u.pm]) : 0; return true;
    }
    __device__ __forceinline__ unsigned a_off(const Unit& u) const { return gather ? 0u : (unsigned)u.pm * (unsigned)tstep; }
    __device__ __forceinline__ unsigned b_off(const Unit& u) const { return (unsigned)u.e * (unsigned)estep + (unsigned)u.pn * (unsigned)tstep; }
};

template <class Epi, class Sched, bool GATHER, bool ALIGN_EPI, bool SP2, bool FP8>
__device__ __forceinline__ void gemm_phase(PG8_LAS unsigned char* lds, const int K, const Sched& S, const Epi& E, const PG8_LAS unsigned* gtab) {
    const int tid = threadIdx.x, wid = __builtin_amdgcn_readfirstlane(tid >> 6), lane = tid & 63, wr = wid >> 2, wc = wid & 3, fr = lane & 15, fq = lane >> 4;
    const int nt = K / BK;
    const __amdgpu_buffer_rsrc_t rsA = __builtin_amdgcn_make_buffer_rsrc((void*)S.A, 0, -1, 0x00020000);
    const __amdgpu_buffer_rsrc_t rsB = __builtin_amdgcn_make_buffer_rsrc((void*)S.Bt, 0, -1, 0x00020000);
    unsigned voffA[2], voffB[2]; unsigned offA[2][2];
#pragma unroll
    for (int i = 0; i < 2; ++i) { int R, C; stage_rc(tid * 16 + i * 8192, R, C); const int Rb = Epi::PERM ? ((R & ~31) + perm32(R & 31)) : R;
        voffA[i] = (unsigned)(R * K + C) * 2u; voffB[i] = (unsigned)(Rb * K + C) * 2u; offA[0][i] = 0; offA[1][i] = 0; }
    const unsigned kstep = (unsigned)(BK * 2);
    const unsigned hstep = (unsigned)HALF * K * 2;
    const unsigned ldsw = (unsigned)wid * 1024u;
    const int aoff = lds_byte(wr * 64 + fr, fq * 8), boff = lds_byte(wc * 32 + fr, fq * 8);
#define PG8_SA(b, h) (((b) * 2 + (h)) * HTB)
#define PG8_SB(b, h) ((4 + (b) * 2 + (h)) * HTB)
#define PG8_STAGE(rs, bufoff, soff, voff) do { _Pragma("unroll") for (int _i = 0; _i < 2; ++_i) \
        __builtin_amdgcn_raw_ptr_buffer_load_lds(rs, (PG8_LAS void*)(lds + (bufoff) + ldsw + _i * 8192), 16, (int)(voff)[_i], (int)(soff), 0, 0); } while (0)
#define PG8_STAGE_A(b, h, kbase) do { if constexpr (GATHER) { PG8_STAGE(rsA, PG8_SA(b, h), (kbase), offA[h]); } else { PG8_STAGE(rsA, PG8_SA(b, h), (kbase) + (h) * hstep, voffA); } } while (0)
#define PG8_STAGE_B(b, h, kbase) PG8_STAGE(rsB, PG8_SB(b, h), (kbase) + (h) * hstep, voffB)
#define PG8_LOAD_OFFS(slot) do { _Pragma("unroll") for (int _i = 0; _i < 2; ++_i) { int _R, _C; stage_rc(tid * 16 + _i * 8192, _R, _C); \
        _Pragma("unroll") for (int _h = 0; _h < 2; ++_h) offA[_h][_i] = gtab[(slot) * 256 + _h * 128 + _R] + (unsigned)_C * 2u; } } while (0)
#define PG8_LDA(dst, b, h) do { _Pragma("unroll") for (int m = 0; m < 4; ++m) _Pragma("unroll") for (int k = 0; k < 2; ++k) dst[m][k] = *(const PG8_LAS bf16x8*)(lds + PG8_SA(b, h) + aoff + m * 2048 + k * 1024); } while (0)
#define PG8_LDB(dst, b, h) do { _Pragma("unroll") for (int n = 0; n < 2; ++n) _Pragma("unroll") for (int k = 0; k < 2; ++k) dst[n][k] = *(const PG8_LAS bf16x8*)(lds + PG8_SB(b, h) + boff + n * 2048 + k * 1024); } while (0)
#define PG8_MMA(ai, bj, At, Bt) do { __builtin_amdgcn_s_setprio(1); _Pragma("unroll") for (int m = 0; m < 4; ++m) _Pragma("unroll") for (int n = 0; n < 2; ++n) { \
        if constexpr (FP8) { acc[ai][bj][m][n] = __builtin_amdgcn_mfma_scale_f32_16x16x128_f8f6f4(cat8(Bt[n][0], Bt[n][1]), cat8(At[m][0], At[m][1]), acc[ai][bj][m][n], 0, 0, 0, 0, 0, 0); } \
        else { _Pragma("unroll") for (int k = 0; k < 2; ++k) acc[ai][bj][m][n] = __builtin_amdgcn_mfma_f32_16x16x32_bf16(Bt[n][k], At[m][k], acc[ai][bj][m][n], 0, 0, 0); } } __builtin_amdgcn_s_setprio(0); } while (0)
#define PG8_WAIT_V(n) asm volatile("s_waitcnt vmcnt(" #n ")" ::: "memory")
#define PG8_WAIT_L(n) asm volatile("s_waitcnt lgkmcnt(" #n ")" ::: "memory")
#define PG8_BAR __builtin_amdgcn_s_barrier()
#define PG8_SCHED __builtin_amdgcn_sched_barrier(0)
    Unit cur, nxt; int ui = 0;
    if (!S.next(0, cur)) return;
    f32x4 acc[2][2][4][2];
#pragma unroll
    for (int a = 0; a < 2; ++a)
#pragma unroll
        for (int b = 0; b < 2; ++b)
#pragma unroll
            for (int m = 0; m < 4; ++m)
#pragma unroll
                for (int n = 0; n < 2; ++n) acc[a][b][m][n] = (f32x4){0.f, 0.f, 0.f, 0.f};
    bf16x8 At[4][2], B0[2][2], B1[2][2];
    unsigned cA = S.a_off(cur), cB = S.b_off(cur);
    if constexpr (GATHER) { PG8_LOAD_OFFS(0); }
    if constexpr (SP2) {
        PG8_STAGE_B(0, 0, cB); PG8_STAGE_B(0, 1, cB); PG8_STAGE_A(0, 0, cA); PG8_STAGE_A(0, 1, cA);
        if (wr == 1) PG8_BAR;
        PG8_WAIT_V(2); PG8_BAR;
        PG8_STAGE_B(1, 0, cB + kstep); PG8_STAGE_A(1, 0, cA + kstep); PG8_STAGE_B(1, 1, cB + kstep);
        PG8_WAIT_V(6); PG8_BAR;
    } else {
        PG8_STAGE_B(0, 0, cB); PG8_STAGE_A(0, 0, cA); PG8_STAGE_B(0, 1, cB); PG8_STAGE_A(0, 1, cA);
        if (wr == 1) PG8_BAR;
        PG8_WAIT_V(4); PG8_BAR;
        PG8_STAGE_B(1, 0, cB + kstep); PG8_STAGE_A(1, 0, cA + kstep); PG8_STAGE_B(1, 1, cB + kstep);
        PG8_WAIT_V(6); PG8_BAR;
    }
    for (;;) {
        const bool has_next = S.next(ui + 1, nxt);
        const unsigned nA = has_next ? S.a_off(nxt) : cA, nB = has_next ? S.b_off(nxt) : cB;
#pragma unroll 1
        for (int t = 0; t < nt; t += 2) {
            const bool last = (t == nt - 2);
            const unsigned a1 = cA + (unsigned)(t + 1) * kstep;
            const unsigned a2 = last ? nA : cA + (unsigned)(t + 2) * kstep, b2 = last ? nB : cB + (unsigned)(t + 2) * kstep;
            const unsigned a3 = a2 + kstep, b3 = b2 + kstep;
            if constexpr (SP2) {
            PG8_LDB(B0, 0, 0); PG8_LDB(B1, 0, 1); PG8_SCHED; PG8_LDA(At, 0, 0); PG8_STAGE_A(1, 1, a1);
            PG8_WAIT_V(8); PG8_WAIT_L(0); PG8_BAR; PG8_MMA(0, 0, At, B0); PG8_MMA(0, 1, At, B1); PG8_BAR; PG8_SCHED;
            if constexpr (GATHER) { if (last && has_next) { PG8_LOAD_OFFS(ui + 1); } }
            PG8_LDA(At, 0, 1); PG8_STAGE_B(0, 0, b2); PG8_STAGE_B(0, 1, b2); PG8_STAGE_A(0, 0, a2);
            PG8_WAIT_V(8); PG8_WAIT_L(0); PG8_BAR; PG8_MMA(1, 0, At, B0); PG8_MMA(1, 1, At, B1); PG8_BAR; PG8_SCHED;
            PG8_LDB(B0, 1, 0); PG8_LDB(B1, 1, 1); PG8_SCHED; PG8_LDA(At, 1, 0); PG8_STAGE_A(0, 1, a2);
            PG8_WAIT_V(8); PG8_WAIT_L(0); PG8_BAR; PG8_MMA(0, 0, At, B0); PG8_MMA(0, 1, At, B1); PG8_BAR; PG8_SCHED;
            PG8_LDA(At, 1, 1); PG8_STAGE_B(1, 0, b3); PG8_STAGE_B(1, 1, b3); PG8_STAGE_A(1, 0, a3);
            PG8_WAIT_V(8); PG8_WAIT_L(0); PG8_BAR; PG8_MMA(1, 0, At, B0); PG8_MMA(1, 1, At, B1); PG8_BAR; PG8_SCHED;
            } else {
            PG8_LDB(B0, 0, 0); PG8_SCHED; PG8_LDA(At, 0, 0); PG8_STAGE_A(1, 1, a1);
            PG8_WAIT_L(8); PG8_BAR; PG8_WAIT_L(0); PG8_MMA(0, 0, At, B0); PG8_BAR; PG8_SCHED;
            if constexpr (GATHER) { if (last && has_next) { PG8_LOAD_OFFS(ui + 1); } }
            PG8_LDB(B1, 0, 1); PG8_STAGE_B(0, 0, b2);
            PG8_BAR; PG8_WAIT_L(0); PG8_MMA(0, 1, At, B1); PG8_BAR;
            PG8_LDA(At, 0, 1); PG8_STAGE_A(0, 0, a2);
            PG8_BAR; PG8_WAIT_L(0); PG8_MMA(1, 0, At, B0); PG8_BAR; PG8_SCHED;
            PG8_STAGE_B(0, 1, b2);
            PG8_WAIT_V(6); PG8_BAR; PG8_MMA(1, 1, At, B1); PG8_BAR;
            PG8_LDB(B0, 1, 0); PG8_SCHED; PG8_LDA(At, 1, 0); PG8_STAGE_A(0, 1, a2);
            PG8_WAIT_L(8); PG8_BAR; PG8_WAIT_L(0); PG8_MMA(0, 0, At, B0); PG8_BAR; PG8_SCHED;
            PG8_LDB(B1, 1, 1); PG8_STAGE_B(1, 0, b3);
            PG8_BAR; PG8_WAIT_L(0); PG8_MMA(0, 1, At, B1); PG8_BAR;
            PG8_LDA(At, 1, 1); PG8_STAGE_A(1, 0, a3);
            PG8_BAR; PG8_WAIT_L(0); PG8_MMA(1, 0, At, B0); PG8_BAR; PG8_SCHED;
            PG8_STAGE_B(1, 1, b3);
            PG8_WAIT_V(6); PG8_BAR; PG8_MMA(1, 1, At, B1); PG8_BAR;
            }
        }
        if constexpr (ALIGN_EPI) { if (wr == 0) PG8_BAR; }
        E(acc, cur, wr, wc, fr, fq);
        if (!has_next) break;
#pragma unroll
        for (int a = 0; a < 2; ++a)
#pragma unroll
            for (int b = 0; b < 2; ++b)
#pragma unroll
                for (int m = 0; m < 4; ++m)
#pragma unroll
                    for (int n = 0; n < 2; ++n) acc[a][b][m][n] = (f32x4){0.f, 0.f, 0.f, 0.f};
        cur = nxt; cA = nA; cB = nB; ++ui;
        if constexpr (ALIGN_EPI) { if (wr == 1) PG8_BAR; }
    }
    PG8_WAIT_V(0);
    if constexpr (!ALIGN_EPI) { if (wr == 0) PG8_BAR; }
    PG8_BAR;
#undef PG8_SA
#undef PG8_SB
#undef PG8_STAGE
#undef PG8_STAGE_A
#undef PG8_STAGE_B
#undef PG8_LOAD_OFFS
#undef PG8_LDA
#undef PG8_LDB
#undef PG8_MMA
#undef PG8_WAIT_V
#undef PG8_WAIT_L
#undef PG8_BAR
#undef PG8_SCHED
}

struct EpiInProj {
    static constexpr bool PERM = true;
    bf16_t* V; bf16_t* GG; bf16_t* UR;
    __device__ __forceinline__ void operator()(const f32x4 (&acc)[2][2][4][2], const Unit& u, int wr, int wc, int fr, int fq) const {
        const int row0 = u.pm * BM + wr * 64 + fr, cl = wc * 32 + 8 * fq;
        if (u.pn < 4) {
#pragma unroll
            for (int ai = 0; ai < 2; ++ai)
#pragma unroll
                for (int m = 0; m < 4; ++m) { float o[8];
#pragma unroll
                    for (int n = 0; n < 2; ++n)
#pragma unroll
                        for (int j = 0; j < 4; ++j) o[4 * n + j] = acc[ai][0][m][n][j] * sigmoidf_(acc[ai][1][m][n][j]);
                    u32x4 w; w.x = cvt_pk_bf16(o[0], o[1]); w.y = cvt_pk_bf16(o[2], o[3]); w.z = cvt_pk_bf16(o[4], o[5]); w.w = cvt_pk_bf16(o[6], o[7]);
                    *(u32x4*)(V + (size_t)(row0 + ai * HALF + m * 16) * 512 + u.pn * 128 + cl) = w; }
        } else {
            const bool gel = u.pn < 6; bf16_t* base = gel ? GG : UR; const int c0 = (gel ? u.pn - 4 : u.pn - 6) * 256 + cl;
#pragma unroll
            for (int ai = 0; ai < 2; ++ai)
#pragma unroll
                for (int m = 0; m < 4; ++m)
#pragma unroll
                    for (int bj = 0; bj < 2; ++bj) { float o[8];
#pragma unroll
                        for (int n = 0; n < 2; ++n)
#pragma unroll
                            for (int j = 0; j < 4; ++j) { const float x = acc[ai][bj][m][n][j];
                                o[4 * n + j] = gel ? x * sigmoidf_(1.5957691216f * (x + 0.044715f * x * x * x)) : x; }
                        u32x4 w; w.x = cvt_pk_bf16(o[0], o[1]); w.y = cvt_pk_bf16(o[2], o[3]); w.z = cvt_pk_bf16(o[4], o[5]); w.w = cvt_pk_bf16(o[6], o[7]);
                        *(u32x4*)(base + (size_t)(row0 + ai * HALF + m * 16) * 512 + c0 + bj * HALF) = w; }
        }
    }
};
struct EpiOutProj {
    static constexpr bool PERM = true;
    const float* X; bf16_t* X1; const float* modf;
    __device__ __forceinline__ void operator()(const f32x4 (&acc)[2][2][4][2], const Unit& u, int wr, int wc, int fr, int fq) const {
        const int row0 = u.pm * BM + wr * 64 + fr, col0 = u.pn * BM + wc * 32 + 8 * fq; const int b = (u.pm * BM) / SEQ;
        f32x4 gv[2][2];
#pragma unroll
        for (int bj = 0; bj < 2; ++bj)
#pragma unroll
            for (int n = 0; n < 2; ++n) gv[bj][n] = *(const f32x4*)(modf + (size_t)b * NMODW + 2 * D + col0 + bj * HALF + n * 4);
#pragma unroll
        for (int ai = 0; ai < 2; ++ai)
#pragma unroll
            for (int m = 0; m < 4; ++m) { const size_t off = (size_t)(row0 + ai * HALF + m * 16) * D + col0;
#pragma unroll
                for (int bj = 0; bj < 2; ++bj) { const f32x4 x0 = *(const f32x4*)(X + off + bj * HALF), x1 = *(const f32x4*)(X + off + bj * HALF + 4);
                    const f32x4 v0 = x0 + gv[bj][0] * acc[ai][bj][m][0], v1 = x1 + gv[bj][1] * acc[ai][bj][m][1];
                    u32x4 w; w.x = cvt_pk_bf16(v0[0], v0[1]); w.y = cvt_pk_bf16(v0[2], v0[3]); w.z = cvt_pk_bf16(v1[0], v1[1]); w.w = cvt_pk_bf16(v1[2], v1[3]);
                    *(u32x4*)(X1 + off + bj * HALF) = w; }
                asm volatile("" ::: "memory"); }
    }
};
struct EpiSwiglu {
    static constexpr bool PERM = true;
    unsigned char* ACT; const float* bgu;
    __device__ __forceinline__ void operator()(const f32x4 (&acc)[2][2][4][2], const Unit& u, int wr, int wc, int fr, int fq) const {
        const int row0 = u.pm * BM + wr * 64 + fr, col0 = u.pn * 128 + wc * 32 + 8 * fq;
        const float* bb = bgu + (size_t)u.e * 2 * DE + col0;
        const f32x4 bg0 = *(const f32x4*)(bb), bg1 = *(const f32x4*)(bb + 4), bu0 = *(const f32x4*)(bb + DE), bu1 = *(const f32x4*)(bb + DE + 4);
#pragma unroll
        for (int ai = 0; ai < 2; ++ai)
#pragma unroll
            for (int m = 0; m < 4; ++m) { float o[8];
#pragma unroll
                for (int n = 0; n < 2; ++n)
#pragma unroll
                    for (int j = 0; j < 4; ++j) { float g = acc[ai][0][m][n][j] * W8_INV + (n ? bg1[j] : bg0[j]), uu = acc[ai][1][m][n][j] * W8_INV + (n ? bu1[j] : bu0[j]);
                        g = fminf(g, 7.0f); uu = fminf(fmaxf(uu, -7.0f), 7.0f); o[4 * n + j] = (uu + 1.0f) * (g * sigmoidf_(1.702f * g)); }
                v2u w; w.x = __builtin_amdgcn_cvt_pk_fp8_f32(o[2], o[3], __builtin_amdgcn_cvt_pk_fp8_f32(o[0], o[1], 0, false), true);
                w.y = __builtin_amdgcn_cvt_pk_fp8_f32(o[6], o[7], __builtin_amdgcn_cvt_pk_fp8_f32(o[4], o[5], 0, false), true);
                *(v2u*)(ACT + (size_t)(row0 + ai * HALF + m * 16) * DE + col0) = w; }
    }
};
struct EpiDown {
    static constexpr bool PERM = true;
    unsigned char* Y; const float* bd;
    __device__ __forceinline__ void operator()(const f32x4 (&acc)[2][2][4][2], const Unit& u, int wr, int wc, int fr, int fq) const {
        const int row0 = u.pm * BM + wr * 64 + fr, col0 = u.pn * BM + wc * 32 + 8 * fq;
        const float* bb = bd + (size_t)u.e * D + col0;
#pragma unroll
        for (int bj = 0; bj < 2; ++bj) { const f32x4 b0 = *(const f32x4*)(bb + bj * HALF), b1 = *(const f32x4*)(bb + bj * HALF + 4);
#pragma unroll
            for (int ai = 0; ai < 2; ++ai)
#pragma unroll
                for (int m = 0; m < 4; ++m) { const f32x4 v0 = (acc[ai][bj][m][0] * W8_INV + b0) * Y8_SCALE, v1 = (acc[ai][bj][m][1] * W8_INV + b1) * Y8_SCALE;
                    v2u w; w.x = __builtin_amdgcn_cvt_pk_fp8_f32(v0[2], v0[3], __builtin_amdgcn_cvt_pk_fp8_f32(v0[0], v0[1], 0, false), true);
                    w.y = __builtin_amdgcn_cvt_pk_fp8_f32(v1[2], v1[3], __builtin_amdgcn_cvt_pk_fp8_f32(v1[0], v1[1], 0, false), true);
                    *(v2u*)(Y + (size_t)(row0 + ai * HALF + m * 16) * D + col0 + bj * HALF) = w; } }
    }
};
}

#define XB_TMO      128
#define XB_XCNT(j)  (256  + 64 * (j))
#define XB_XSUB(j)  (1280 + 64 * (j))
#define XB_XGEN(j)  (2304 + 64 * (j))
#define XB_TOP      3328
#define XB_TOPGEN   3392
#define XCD_BAR_WORDS 3456
#define XB_SPIN_CAP (1u << 18)
__device__ __forceinline__ unsigned xb_ld(unsigned* p)              { return __hip_atomic_load(p, __ATOMIC_RELAXED, __HIP_MEMORY_SCOPE_AGENT); }
__device__ __forceinline__ unsigned xb_add(unsigned* p, unsigned v) { return __hip_atomic_fetch_add(p, v, __ATOMIC_RELAXED, __HIP_MEMORY_SCOPE_AGENT); }
__device__ __forceinline__ unsigned xb_xcc_id() { return (unsigned)__builtin_amdgcn_s_getreg((3 << 11) | 20) & 0xFu; }
#define XB_SPIN(cond, bar) do { unsigned _sp = 0; while (cond) { __builtin_amdgcn_s_sleep(1); \
    if ((++_sp & 255u) == 0u) { if (xb_ld(&(bar)[XB_TMO])) break; if (_sp > XB_SPIN_CAP) { atomicAdd(&(bar)[XB_TMO], 1u); break; } } } } while (0)
struct XcdBarrier { unsigned* bar; unsigned x; volatile LAS unsigned* st; };
__device__ __forceinline__ XcdBarrier xcd_barrier_post(unsigned* bar, volatile LAS unsigned* st) {
    XcdBarrier b; b.bar = bar; b.x = xb_xcc_id(); b.st = st;
    if (threadIdx.x == 0) (void)xb_add(&bar[XB_XCNT(b.x)], 1u);
    return b;
}
__device__ __forceinline__ void xcd_barrier_complete(unsigned* bar, unsigned x, unsigned& nloc, unsigned& nx) {
    const unsigned G = gridDim.x * gridDim.y * gridDim.z;
    unsigned sum, cnt, mine, sp = 0u;
    for (;;) {
        sum = 0u; cnt = 0u; mine = 0u;
#pragma unroll
        for (unsigned j = 0; j < 16; ++j) { const unsigned c = xb_ld(&bar[XB_XCNT(j)]); sum += c; cnt += (c > 0u) ? 1u : 0u; mine = (j == x) ? c : mine; }
        if (sum == G) break;
        __builtin_amdgcn_s_sleep(1);
        if ((++sp & 255u) == 0u) { if (xb_ld(&bar[XB_TMO])) break; if (sp > XB_SPIN_CAP) { atomicAdd(&bar[XB_TMO], 1u); break; } }
    }
    nloc = mine > 0u ? mine : 1u; nx = cnt > 0u ? cnt : 1u;
}
__device__ __forceinline__ void xcd_barrier(const XcdBarrier& b) {
    asm volatile("s_waitcnt vmcnt(0)" ::: "memory");
    __syncthreads();
    if (threadIdx.x == 0) {
        unsigned* bar = b.bar;
        __builtin_amdgcn_s_waitcnt(0);
        unsigned nloc = b.st[0], nx = b.st[1];
        if (nloc == 0u) { xcd_barrier_complete(bar, b.x, nloc, nx); b.st[0] = nloc; b.st[1] = nx; }
        const unsigned old = xb_add(&bar[XB_XSUB(b.x)], 1u);
        const unsigned gen = old / nloc;
        if (old + 1u == (gen + 1u) * nloc) {
            __builtin_amdgcn_fence(__ATOMIC_RELEASE, "agent");
            asm volatile("s_waitcnt vmcnt(0)" ::: "memory");
            const unsigned og = xb_add(&bar[XB_TOP], 1u);
            const unsigned tg = og / nx;
            if (og + 1u == (tg + 1u) * nx) xb_add(&bar[XB_TOPGEN], 1u);
            else XB_SPIN(xb_ld(&bar[XB_TOPGEN]) == tg, bar);
            __builtin_amdgcn_fence(__ATOMIC_ACQUIRE, "agent");
            xb_add(&bar[XB_XGEN(b.x)], 1u);
            asm volatile("s_waitcnt vmcnt(0)" ::: "memory");
        } else {
            XB_SPIN(xb_ld(&bar[XB_XGEN(b.x)]) == gen, bar);
            __builtin_amdgcn_fence(__ATOMIC_ACQUIRE, "agent");
            asm volatile("s_waitcnt vmcnt(0)" ::: "memory");
        }
    }
    __syncthreads();
}

struct Frame {
    LAS unsigned char* lds;
    volatile LAS unsigned* MISC;
    gu32* ctl;
    int tid, lane, wave, G, bx;
    float* out; unsigned char* ws;
};
struct Args { const float* in[27]; float* out; unsigned char* ws; int ph_lo, ph_hi, li, pad; };
enum { I_X = 0, I_C, I_WADA, I_BADA, I_N1G, I_WIN, I_CONVW, I_CONVB, I_CLNG, I_CLNB, I_LCW, I_LCB, I_LWA, I_LBA, I_LWX, I_LBX, I_LAM, I_MIXG, I_WOUT, I_N2G, I_WR, I_BR, I_WGU, I_BGU, I_WD, I_BD, I_FNG };

__device__ __forceinline__ float wave_sum(float v) {
#pragma unroll
    for (int o = 1; o < 64; o <<= 1) v += __shfl_xor(v, o);
    return v;
}

__device__ __forceinline__ void p0_transpose_item(const float* W, int K, int N, bf16* WT, int drow0, LAS float* scr, int k0, int n0, int lane) {
#pragma unroll 8
    for (int i = 0; i < 32; ++i) { const int kk = 2 * i + (lane >> 5); scr[kk * 33 + (lane & 31)] = W[(size_t)(k0 + kk) * N + n0 + (lane & 31)]; }
    LDS_WAIT(); asm volatile("" ::: "memory");
    const int c = lane & 7;
#pragma unroll
    for (int j = 0; j < 4; ++j) { const int n = (lane >> 3) + 8 * j; const LAS float* s = scr + (8 * c) * 33 + n;
        v4u o; o.x = pk2(s[0 * 33], s[1 * 33]); o.y = pk2(s[2 * 33], s[3 * 33]); o.z = pk2(s[4 * 33], s[5 * 33]); o.w = pk2(s[6 * 33], s[7 * 33]);
        *(GAS v4u*)(WT + (size_t)(drow0 + n) * K + k0 + 8 * c) = o; }
    LDS_WAIT(); asm volatile("" ::: "memory");
}
__device__ __forceinline__ void p0_transpose_item_fp8(const float* W, int K, int N, unsigned char* WT, int drow0, LAS float* scr, int k0, int n0, int lane) {
#pragma unroll 8
    for (int i = 0; i < 32; ++i) { const int kk = 2 * i + (lane >> 5); scr[kk * 33 + (lane & 31)] = W[(size_t)(k0 + kk) * N + n0 + (lane & 31)]; }
    LDS_WAIT(); asm volatile("" ::: "memory");
    const int c = lane & 7;
#pragma unroll
    for (int j = 0; j < 4; ++j) { const int n = (lane >> 3) + 8 * j; const LAS float* s = scr + (8 * c) * 33 + n;
        v2u o; o.x = __builtin_amdgcn_cvt_pk_fp8_f32(s[2 * 33] * W8_SCALE, s[3 * 33] * W8_SCALE, __builtin_amdgcn_cvt_pk_fp8_f32(s[0 * 33] * W8_SCALE, s[1 * 33] * W8_SCALE, 0, false), true);
        o.y = __builtin_amdgcn_cvt_pk_fp8_f32(s[6 * 33] * W8_SCALE, s[7 * 33] * W8_SCALE, __builtin_amdgcn_cvt_pk_fp8_f32(s[4 * 33] * W8_SCALE, s[5 * 33] * W8_SCALE, 0, false), true);
        *(GAS v2u*)(WT + (size_t)(drow0 + n) * K + k0 + 8 * c) = o; }
    LDS_WAIT(); asm volatile("" ::: "memory");
}
__device__ __forceinline__ void p0_router_item(const float* W, bf16* WH, bf16* WL, LAS float* scr, int k0, int lane) {
#pragma unroll 8
    for (int i = 0; i < 32; ++i) { const int kk = 2 * i + (lane >> 5); scr[kk * 33 + (lane & 31)] = W[(size_t)(k0 + kk) * NE + (lane & 31)]; }
    LDS_WAIT(); asm volatile("" ::: "memory");
    const int c = lane & 7;
#pragma unroll
    for (int j = 0; j < 4; ++j) { const int n = (lane >> 3) + 8 * j; const LAS float* s = scr + (8 * c) * 33 + n;
        float v[8]; unsigned h[8], l[8];
#pragma unroll
        for (int e = 0; e < 8; ++e) { v[e] = s[e * 33]; h[e] = f2bf(v[e]); l[e] = f2bf(v[e] - bf2f(h[e])); }
        v4u oh, ol; oh.x = h[0] | (h[1] << 16); oh.y = h[2] | (h[3] << 16); oh.z = h[4] | (h[5] << 16); oh.w = h[6] | (h[7] << 16);
        ol.x = l[0] | (l[1] << 16); ol.y = l[2] | (l[3] << 16); ol.z = l[4] | (l[5] << 16); ol.w = l[6] | (l[7] << 16);
        *(GAS v4u*)(WH + (size_t)n * D + k0 + 8 * c) = oh; *(GAS v4u*)(WL + (size_t)n * D + k0 + 8 * c) = ol; }
    LDS_WAIT(); asm volatile("" ::: "memory");
}
__device__ __forceinline__ void p0_mod_item(Frame& F, const Args& args, LAS float* scr, int item) {
    const int cg = item % 96, ks = item / 96, col = cg * 64 + F.lane, k0 = ks * 256;
    const float* c = args.in[I_C]; const float* W = args.in[I_WADA];
#pragma unroll 4
    for (int i = 0; i < 32; ++i) { const int idx = i * 64 + F.lane, b = idx >> 8, kk = idx & 255; const float v = c[b * D + k0 + kk]; scr[idx] = v / (1.0f + __expf(-v)); }
    LDS_WAIT(); asm volatile("" ::: "memory");
    float acc[8];
#pragma unroll
    for (int b = 0; b < 8; ++b) acc[b] = 0.f;
#pragma unroll 4
    for (int kk = 0; kk < 256; kk += 4) {
        const float* wp = W + (size_t)(k0 + kk) * NMODW + col;
        const float w0 = wp[0], w1 = wp[NMODW], w2 = wp[2 * NMODW], w3 = wp[3 * NMODW];
#pragma unroll
        for (int b = 0; b < 8; ++b) { const f32x4 cv = *(const LAS f32x4*)(scr + b * 256 + kk); acc[b] += (cv.x * w0 + cv.y * w1) + (cv.z * w2 + cv.w * w3); }
    }
    float* mp = (float*)(F.ws + WS_MODP);
#pragma unroll
    for (int b = 0; b < 8; ++b) mp[(size_t)(ks * 8 + b) * NMODW + col] = acc[b];
    LDS_WAIT(); asm volatile("" ::: "memory");
}
__device__ __forceinline__ void p0_lrufrag_item(const Args& args, unsigned char* ws, int h, int lane) {
    const int j = lane & 15, q = lane >> 4;
#pragma unroll 1
    for (int f = 0; f < 16; ++f) { const int mat = f >> 3, n = (f >> 1) & 3, s = f & 1;
        const float* p = (mat ? args.in[14] : args.in[12]) + (size_t)(h * 64 + 32 * s + 8 * q) * 64 + 16 * n + j;
        v4u o; o.x = pk2(p[0], p[64]); o.y = pk2(p[128], p[192]); o.z = pk2(p[256], p[320]); o.w = pk2(p[384], p[448]);
        *((GAS v4u*)(ws + WS_LRUB) + (size_t)((h * 2 + mat) * 8 + n * 2 + s) * 64 + lane) = o; }
}
__device__ __forceinline__ int glu_row(int n, int half) {
    return n < half ? 256 * (n >> 7) + (n & 127) : 256 * ((n - half) >> 7) + 128 + ((n - half) & 127);
}
__device__ __forceinline__ void p0_prologue(Frame& F, const Args& args) {
    LAS float* scr = (LAS float*)(F.lds + F.wave * 16384);
    const int gw = F.bx * NWAVES + F.wave, NGW = F.G * NWAVES;
    if (gw >= NGW - 8) p0_lrufrag_item(args, F.ws, gw - (NGW - 8), F.lane);
    constexpr int I_MOD = 96 * 4, I_RT = 16, I_IN = 16 * 64, I_OUT = 16 * 32, I_GU = 32 * 16 * 64, I_DN = 32 * 16 * 32;
    constexpr int NITEMS = I_MOD + I_RT + I_IN + I_OUT + I_GU + I_DN;
    for (int it = gw; it < NITEMS; it += NGW) {
        int r = it;
        if (r < I_MOD) { p0_mod_item(F, args, scr, r); continue; } r -= I_MOD;
        if (r < I_RT) { p0_router_item(args.in[I_WR], (bf16*)(F.ws + WS_WRH), (bf16*)(F.ws + WS_WRL), scr, 64 * r, F.lane); continue; } r -= I_RT;
        if (r < I_IN) { const int kb = r >> 6, nb = r & 63, n0 = 32 * nb; const int dr = n0 < 1024 ? glu_row(n0, 512) : n0;
            p0_transpose_item(args.in[I_WIN], D, 2048, (bf16*)(F.ws + WS_WIN), dr, scr, 64 * kb, n0, F.lane); continue; } r -= I_IN;
        if (r < I_OUT) { const int kb = r >> 5, nb = r & 31; p0_transpose_item(args.in[I_WOUT], D, D, (bf16*)(F.ws + WS_WOUT), 32 * nb, scr, 64 * kb, 32 * nb, F.lane); continue; } r -= I_OUT;
        if (r < I_GU) { const int e = r >> 10, q = r & 1023, kb = q >> 6, nb = q & 63, n0 = 32 * nb;
            p0_transpose_item_fp8(args.in[I_WGU] + (size_t)e * D * 2048, D, 2048, F.ws + WS_WGU + (size_t)e * 2048 * D, glu_row(n0, 1024), scr, 64 * kb, n0, F.lane); continue; } r -= I_GU;
        { const int e = r >> 9, q = r & 511, kb = q >> 5, nb = q & 31;
            p0_transpose_item_fp8(args.in[I_WD] + (size_t)e * DE * D, DE, D, F.ws + WS_WD + (size_t)e * D * DE, 32 * nb, scr, 64 * kb, 32 * nb, F.lane); }
    }
}
__device__ __forceinline__ float mod_from_parts(const float* mp, const float* bada, int b, int j) {
    return bada[j] + ((mp[(size_t)(0 * 8 + b) * NMODW + j] + mp[(size_t)(1 * 8 + b) * NMODW + j]) + (mp[(size_t)(2 * 8 + b) * NMODW + j] + mp[(size_t)(3 * 8 + b) * NMODW + j]));
}
__device__ __forceinline__ void p1_norm1(Frame& F, const Args& args) {
    const float* mp = (const float*)(F.ws + WS_MODP); const float* bada = args.in[I_BADA]; float* mf = (float*)(F.ws + WS_MODF);
    for (int idx = F.bx * 512 + F.tid; idx < NB * NMODW; idx += F.G * 512) { const int b = idx / NMODW, j = idx - b * NMODW; mf[idx] = mod_from_parts(mp, bada, b, j); }
    const float* x = args.in[I_X]; const float* g1 = args.in[I_N1G]; bf16* H = (bf16*)(F.ws + WS_H);
    for (int rb = F.bx; rb < T / 128; rb += F.G) {
        const int b = rb >> 5;
        f32x4 A1[4], B1[4];
#pragma unroll
        for (int i = 0; i < 4; ++i)
#pragma unroll
            for (int e = 0; e < 4; ++e) { const int k = 256 * i + 4 * F.lane + e; A1[i][e] = g1[k] * (1.0f + mod_from_parts(mp, bada, b, D + k)); B1[i][e] = mod_from_parts(mp, bada, b, k); }
        for (int r = F.wave; r < 128; r += NWAVES) {
            const size_t row = (size_t)rb * 128 + r;
            const GAS f32x4* xr = (const GAS f32x4*)(x + row * D) + F.lane;
            f32x4 v[4]; float s = 0.f;
#pragma unroll
            for (int i = 0; i < 4; ++i) { v[i] = xr[64 * i]; s += (v[i].x * v[i].x + v[i].y * v[i].y) + (v[i].z * v[i].z + v[i].w * v[i].w); }
            const float rstd = rsqrtf(wave_sum(s) * (1.0f / D) + EPS);
            GAS v2u* o8 = (GAS v2u*)(H + row * D) + F.lane;
#pragma unroll
            for (int i = 0; i < 4; ++i) { const f32x4 h = v[i] * rstd * A1[i] + B1[i]; v2u w; w.x = pk2(h.x, h.y); w.y = pk2(h.z, h.w); o8[64 * i] = w; }
        }
    }
}

template <int N, int OFF> struct TRed {
    template <int M> static __device__ __forceinline__ void run(float (&v)[M], int lane) {
        constexpr int half = N / 2; const bool up = (lane & OFF) != 0;
#pragma unroll
        for (int i = 0; i < half; ++i) { const float send = up ? v[i] : v[i + half]; const float keep = up ? v[i + half] : v[i]; v[i] = keep + __shfl_xor(send, OFF); }
        if constexpr (half > 1) TRed<half, OFF / 2>::run(v, lane);
    }
};
template <int N> __device__ __forceinline__ float treduce(float (&v)[N], int lane) {
    TRed<N, 32>::run(v, lane);
    if (N == 32) v[0] += __shfl_xor(v[0], 1);
    return v[0];
}

__device__ __forceinline__ void conv_unit(Frame& F, const Args& args, int u) {
    const int t0 = 64 * u; const bool first = (t0 & (SEQ - 1)) == 0;
    LAS unsigned char* tile = F.lds;
    LAS float* RED = (LAS float*)(F.lds + 98304);
    LAS f32x2* ST = (LAS f32x2*)(F.lds + 98304 + 2048);
    LAS float* RED2 = (LAS float*)(F.lds + 98304 + 4096);
    LAS float* ST2 = (LAS float*)(F.lds + 98304 + 6144);
    const bf16* V = (const bf16*)(F.ws + WS_V);
    for (int p = F.tid; p < 94 * 64; p += 512) { const int row = p >> 6, c16 = p & 63;
        v4u val = (v4u){0u, 0u, 0u, 0u};
        if (!(first && row < 30)) val = *(const GAS v4u*)(V + (size_t)(t0 - 30 + row) * DC + c16 * 8);
        *(LAS v4u*)(tile + row * 1024 + c16 * 16) = val; }
    __syncthreads();
    int otid = F.tid; asm volatile("" : "+v"(otid));
    const int cp = otid & 255, th = otid >> 8, wq = F.wave & 3;
    float w0[31], w1[31];
    { const float* cw = args.in[I_CONVW] + 2 * cp;
#pragma unroll
      for (int k = 0; k < 31; ++k) { const f32x2 t = *(const f32x2*)(cw + k * DC); w0[k] = t.x; w1[k] = t.y; } }
    const f32x2 cb = *(const f32x2*)(args.in[I_CONVB] + 2 * cp);
    float o0[32], o1[32];
#pragma unroll
    for (int g = 0; g < 4; ++g) {
        float a0[8], a1[8];
#pragma unroll
        for (int j = 0; j < 8; ++j) { a0[j] = cb.x; a1[j] = cb.y; }
        const LAS unsigned char* tp = tile + (32 * th + 8 * g) * 1024 + cp * 4;
#pragma unroll
        for (int i = 0; i < 38; ++i) { const unsigned xw = *(const LAS unsigned*)(tp + i * 1024); const float x0 = bflo(xw), x1 = bfhi(xw);
#pragma unroll
            for (int j = 0; j < 8; ++j) { const int k = i - j; if (k >= 0 && k <= 30) { a0[j] += w0[k] * x0; a1[j] += w1[k] * x1; } } }
#pragma unroll
        for (int j = 0; j < 8; ++j) { o0[8 * g + j] = a0[j]; o1[8 * g + j] = a1[j]; }
    }
    { float vals[64];
#pragma unroll
      for (int t = 0; t < 32; ++t) { vals[t] = o0[t] + o1[t]; vals[32 + t] = o0[t] * o0[t] + o1[t] * o1[t]; }
      const float r = treduce<64>(vals, F.lane);
      RED[(th * 4 + wq) * 64 + F.lane] = r; }
    __syncthreads();
    if (F.tid < 64) { const int hh = F.tid >> 5, tk = F.tid & 31; float s1 = 0.f, s2 = 0.f;
#pragma unroll
        for (int w = 0; w < 4; ++w) { s1 += RED[(hh * 4 + w) * 64 + tk]; s2 += RED[(hh * 4 + w) * 64 + 32 + tk]; }
        const float mean = s1 * (1.0f / DC); const float var = fmaxf(s2 * (1.0f / DC) - mean * mean, 0.f);
        ST[F.tid] = (f32x2){mean, rsqrtf(var + EPS)}; }
    __syncthreads();
    const f32x2 lg = *(const f32x2*)(args.in[I_CLNG] + 2 * cp), lb = *(const f32x2*)(args.in[I_CLNB] + 2 * cp);
    { float vals[32];
#pragma unroll
      for (int t = 0; t < 32; ++t) { const f32x2 st = ST[th * 32 + t];
          const float y0 = (o0[t] - st.x) * st.y * lg.x + lb.x, y1 = (o1[t] - st.x) * st.y * lg.y + lb.y;
          o0[t] = y0 * sigmoidf_(y0); o1[t] = y1 * sigmoidf_(y1); vals[t] = o0[t] * o0[t] + o1[t] * o1[t]; }
      const float r = treduce<32>(vals, F.lane);
      if ((F.lane & 1) == 0) RED2[(th * 4 + wq) * 32 + (F.lane >> 1)] = r; }
    __syncthreads();
    if (F.tid < 64) { const int hh = F.tid >> 5, tk = F.tid & 31; float s = 0.f;
#pragma unroll
        for (int w = 0; w < 4; ++w) s += RED2[(hh * 4 + w) * 32 + tk];
        ST2[F.tid] = rsqrtf(s * (1.0f / DC) + EPS); }
    __syncthreads();
    const f32x2 mg = *(const f32x2*)(args.in[I_MIXG] + 2 * cp);
    bf16* YA = (bf16*)(F.ws + WS_H);
#pragma unroll
    for (int t = 0; t < 32; ++t) { const float rs = ST2[th * 32 + t];
        *(GAS unsigned*)(YA + (size_t)(t0 + 32 * th + t) * D + 2 * cp) = pk2(o0[t] * rs * mg.x, o1[t] * rs * mg.y); }
}

constexpr int LRU_WB = 7680;
template <int PASS>
__device__ __forceinline__ void lru_unit(Frame& F, const Args& args, int ck) {
    int lane = F.lane; asm volatile("" : "+v"(lane));
    const int h = F.wave, j = lane & 15, q = lane >> 4;
    const int b = ck >> 5, cs = ck & 31, t0 = ck * 128;
    LAS unsigned char* wl = F.lds + h * LRU_WB;
    LAS unsigned char* xt = wl + 35 * 144;
    LAS float* SS = (LAS float*)(F.lds + 8 * LRU_WB);
    const bf16* UREC = (const bf16*)(F.ws + WS_UREC); const bf16* GG = (const bf16*)(F.ws + WS_GG); bf16* YA = (bf16*)(F.ws + WS_H);
    float* SUMA = (float*)(F.ws + WS_SUMA); float* SUMH = (float*)(F.ws + WS_SUMH);
    LAS float* cst = (LAS float*)(F.lds + 8 * LRU_WB + 2048) + h * 512;
    { const int c = 64 * h + lane;
#pragma unroll
      for (int k = 0; k < 4; ++k) cst[k * 64 + lane] = args.in[I_LCW][k * 512 + c];
      cst[4 * 64 + lane] = args.in[I_LCB][c]; cst[5 * 64 + lane] = args.in[I_LBA][c]; cst[6 * 64 + lane] = args.in[I_LBX][c];
      const float z = -args.in[I_LAM][c]; cst[7 * 64 + lane] = fmaxf(z, 0.f) + log1pf(__expf(-fabsf(z))); }
    bf16x8 Ba[4][2], Bx[4][2];
    const unsigned l16 = (unsigned)lane * 16u;
#pragma unroll
    for (int n = 0; n < 4; ++n)
#pragma unroll
        for (int s = 0; s < 2; ++s) { const GAS unsigned char* fb = (const GAS unsigned char*)(F.ws + WS_LRUB) + (size_t)h * 16384 + (n * 2 + s) * 1024;
            Ba[n][s] = *(const GAS bf16x8*)(fb + l16); Bx[n][s] = *(const GAS bf16x8*)(fb + 8192 + l16); }
    float hc[4], Pt[4];
#pragma unroll
    for (int n = 0; n < 4; ++n) { hc[n] = 0.f; Pt[n] = 1.f; }
    if (PASS == 2) {
        float hv = 0.f;
        for (int c2 = 0; c2 < cs; ++c2) { const size_t idx = (size_t)(b * 32 + c2) * 512 + 64 * h + lane; hv = SUMA[idx] * hv + SUMH[idx]; }
#pragma unroll
        for (int n = 0; n < 4; ++n) hc[n] = __shfl(hv, 16 * n + j);
    }
    for (int sc = 0; sc < 4; ++sc) {
        const int ts = t0 + 32 * sc;
        v4u ggv[4];
        const unsigned lrow = (unsigned)(lane >> 3) * 1024u + (unsigned)h * 128u + (unsigned)(lane & 7) * 16u;
        if (PASS == 2) {
#pragma unroll
            for (int i = 0; i < 4; ++i) { const GAS unsigned char* gb = (const GAS unsigned char*)GG + (size_t)(ts + 8 * i) * 1024; ggv[i] = *(const GAS v4u*)(gb + lrow); }
        }
#pragma unroll
        for (int i = 0; i < 5; ++i) { const int p = lane + 64 * i;
            if (p < 280) { const int row = p >> 3, c8 = p & 7; v4u val = (v4u){0u, 0u, 0u, 0u};
                if (!(cs == 0 && sc == 0 && row < 3)) { const GAS unsigned char* ub = (const GAS unsigned char*)UREC + (size_t)(ts - 3 + 8 * i) * 1024; val = *(const GAS v4u*)(ub + lrow); }
                *(LAS v4u*)(wl + row * 144 + c8 * 16) = val; } }
#pragma unroll 1
        for (int tile = 0; tile < 2; ++tile) {
            float xr[4][4];
#pragma unroll
            for (int n = 0; n < 4; ++n) { float uu[7];
#pragma unroll
                for (int m = 0; m < 7; ++m) uu[m] = bf2f(*(const LAS unsigned short*)(wl + (16 * tile + 4 * q + m) * 144 + (16 * n + j) * 2));
                const float c0 = cst[16 * n + j], c1 = cst[64 + 16 * n + j], c2 = cst[128 + 16 * n + j], c3 = cst[192 + 16 * n + j], cbn = cst[256 + 16 * n + j];
#pragma unroll
                for (int r = 0; r < 4; ++r) xr[n][r] = cbn + ((c0 * uu[r] + c1 * uu[r + 1]) + (c2 * uu[r + 2] + c3 * uu[r + 3])); }
#pragma unroll
            for (int n = 0; n < 4; ++n)
#pragma unroll
                for (int r = 0; r < 4; ++r) *(LAS unsigned short*)(xt + (4 * q + r) * 144 + (16 * n + j) * 2) = (unsigned short)f2bf(xr[n][r]);
            const bf16x8 a0 = *(const LAS bf16x8*)(xt + j * 144 + 16 * q), a1 = *(const LAS bf16x8*)(xt + j * 144 + 64 + 16 * q);
#pragma unroll
            for (int n = 0; n < 4; ++n) {
                f32x4 za = (f32x4){0.f, 0.f, 0.f, 0.f}, zx = (f32x4){0.f, 0.f, 0.f, 0.f};
                za = __builtin_amdgcn_mfma_f32_16x16x32_bf16(a0, Ba[n][0], za, 0, 0, 0); za = __builtin_amdgcn_mfma_f32_16x16x32_bf16(a1, Ba[n][1], za, 0, 0, 0);
                zx = __builtin_amdgcn_mfma_f32_16x16x32_bf16(a0, Bx[n][0], zx, 0, 0, 0); zx = __builtin_amdgcn_mfma_f32_16x16x32_bf16(a1, Bx[n][1], zx, 0, 0, 0);
                float pp[4], hh[4];
                const float ban = cst[320 + 16 * n + j], bxn = cst[384 + 16 * n + j], spn = cst[448 + 16 * n + j];
#pragma unroll
                for (int r = 0; r < 4; ++r) { const float rg = sigmoidf_(za[r] + ban), ig = sigmoidf_(zx[r] + bxn);
                    const float la = -8.0f * rg * spn; const float a = __expf(la); const float mult = sqrtf(fmaxf(1.0f - a * a, 0.f)); const float inp = mult * (ig * xr[n][r]);
                    if (r == 0) { pp[0] = a; hh[0] = inp; } else { pp[r] = a * pp[r - 1]; hh[r] = a * hh[r - 1] + inp; } }
                float P = pp[3], H = hh[3];
                { const float Pp = __shfl_up(P, 16), Hp = __shfl_up(H, 16); if (q >= 1) { H = P * Hp + H; P = P * Pp; } }
                { const float Pp = __shfl_up(P, 32), Hp = __shfl_up(H, 32); if (q >= 2) { H = P * Hp + H; P = P * Pp; } }
                float Pe = __shfl_up(P, 16), He = __shfl_up(H, 16); if (q == 0) { Pe = 1.f; He = 0.f; }
                const float hq = Pe * hc[n] + He;
                if (PASS == 2) {
#pragma unroll
                    for (int r = 0; r < 4; ++r) *(LAS unsigned short*)(wl + (16 * tile + 4 * q + r) * 144 + (16 * n + j) * 2) = (unsigned short)f2bf(pp[r] * hq + hh[r]);
                }
                const float Pl = __shfl(P, 48 + j), Hl = __shfl(H, 48 + j);
                hc[n] = Pl * hc[n] + Hl; Pt[n] *= Pl;
            }
        }
        if (PASS == 2) {
            LAS float* ssb = SS + (sc & 1) * 256;
#pragma unroll
            for (int i = 0; i < 4; ++i) { const int tk = (lane >> 3) + 8 * i; const v4u hw = *(const LAS v4u*)(wl + tk * 144 + 16 * (lane & 7));
                float y[8];
                y[0] = bflo(ggv[i].x) * bflo(hw.x); y[1] = bfhi(ggv[i].x) * bfhi(hw.x); y[2] = bflo(ggv[i].y) * bflo(hw.y); y[3] = bfhi(ggv[i].y) * bfhi(hw.y);
                y[4] = bflo(ggv[i].z) * bflo(hw.z); y[5] = bfhi(ggv[i].z) * bfhi(hw.z); y[6] = bflo(ggv[i].w) * bflo(hw.w); y[7] = bfhi(ggv[i].w) * bfhi(hw.w);
                float s = 0.f;
#pragma unroll
                for (int e = 0; e < 8; ++e) s += y[e] * y[e];
                s += __shfl_xor(s, 1); s += __shfl_xor(s, 2); s += __shfl_xor(s, 4);
                if ((lane & 7) == 0) ssb[tk * 8 + h] = s; }
            __syncthreads();
            float mg[8];
            { const f32x4 m0 = *(const f32x4*)(args.in[I_MIXG] + 512 + 64 * h + 8 * (lane & 7)), m1 = *(const f32x4*)(args.in[I_MIXG] + 512 + 64 * h + 8 * (lane & 7) + 4);
              mg[0] = m0.x; mg[1] = m0.y; mg[2] = m0.z; mg[3] = m0.w; mg[4] = m1.x; mg[5] = m1.y; mg[6] = m1.z; mg[7] = m1.w; }
#pragma unroll
            for (int i = 0; i < 4; ++i) { const int tk = (lane >> 3) + 8 * i; const f32x4 s0 = *(const LAS f32x4*)(ssb + tk * 8), s1 = *(const LAS f32x4*)(ssb + tk * 8 + 4);
                const float rs = rsqrtf(((s0.x + s0.y) + (s0.z + s0.w) + (s1.x + s1.y) + (s1.z + s1.w)) * (1.0f / 512.0f) + EPS);
                const v4u hw = *(const LAS v4u*)(wl + tk * 144 + 16 * (lane & 7));
                float y[8];
                y[0] = bflo(ggv[i].x) * bflo(hw.x); y[1] = bfhi(ggv[i].x) * bfhi(hw.x); y[2] = bflo(ggv[i].y) * bflo(hw.y); y[3] = bfhi(ggv[i].y) * bfhi(hw.y);
                y[4] = bflo(ggv[i].z) * bflo(hw.z); y[5] = bfhi(ggv[i].z) * bfhi(hw.z); y[6] = bflo(ggv[i].w) * bflo(hw.w); y[7] = bfhi(ggv[i].w) * bfhi(hw.w);
                v4u w; w.x = pk2(y[0] * rs * mg[0], y[1] * rs * mg[1]); w.y = pk2(y[2] * rs * mg[2], y[3] * rs * mg[3]);
                w.z = pk2(y[4] * rs * mg[4], y[5] * rs * mg[5]); w.w = pk2(y[6] * rs * mg[6], y[7] * rs * mg[7]);
                { GAS unsigned char* yb = (GAS unsigned char*)YA + (size_t)(ts + 8 * i) * 2048 + 1024; *(GAS v4u*)(yb + ((unsigned)(lane >> 3) * 2048u + (unsigned)h * 128u + (unsigned)(lane & 7) * 16u)) = w; } }
        }
    }
    if (PASS == 1) {
        const float pv = q == 0 ? Pt[0] : q == 1 ? Pt[1] : q == 2 ? Pt[2] : Pt[3];
        const float hv = q == 0 ? hc[0] : q == 1 ? hc[1] : q == 2 ? hc[2] : hc[3];
        SUMA[(size_t)ck * 512 + 64 * h + lane] = pv; SUMH[(size_t)ck * 512 + 64 * h + lane] = hv;
    }
}

__device__ __forceinline__ void p6_router(Frame& F, const Args& args) {
    constexpr int RS = 2064;
    LAS unsigned char* HI = F.lds; LAS unsigned char* LO = F.lds + 16 * RS;
    LAS float* PLOG = (LAS float*)(F.lds + 32 * RS);
    LAS int* SEL = (LAS int*)(F.lds + 32 * RS + 16384);
    LAS int* CNTW = (LAS int*)(F.lds + 32 * RS + 16384 + 2048);
    const bf16* X1 = (const bf16*)(F.ws + WS_X1); unsigned char* H2 = F.ws + WS_H; const float* mf = (const float*)(F.ws + WS_MODF);
    const bf16* WRH = (const bf16*)(F.ws + WS_WRH); const bf16* WRL = (const bf16*)(F.ws + WS_WRL);
    int* TOPI = (int*)(F.ws + WS_TOPI); float* TOPG = (float*)(F.ws + WS_TOPG); int* LRANK = (int*)(F.ws + WS_LRANK); int* BCNT = (int*)(F.ws + WS_BCNT);
    const int lane = F.lane, w = F.wave, j = lane & 15, q = lane >> 4;
    for (int rb = F.bx; rb < T / 128; rb += F.G) {
        const int b = rb >> 5;
        f32x4 A2[4], B2[4];
#pragma unroll
        for (int i = 0; i < 4; ++i) { const int k = 256 * i + 4 * lane; const f32x4 g = *(const f32x4*)(args.in[I_N2G] + k), sc = *(const f32x4*)(mf + (size_t)b * NMODW + 4 * D + k);
            A2[i] = g * (sc + 1.0f); B2[i] = *(const f32x4*)(mf + (size_t)b * NMODW + 3 * D + k); }
        bf16x8 bh[4][2], bl[4][2];
#pragma unroll
        for (int s = 0; s < 4; ++s)
#pragma unroll
            for (int n = 0; n < 2; ++n) { const size_t o = (size_t)(16 * n + j) * D + 128 * w + 32 * s + 8 * q; bh[s][n] = *(const GAS bf16x8*)(WRH + o); bl[s][n] = *(const GAS bf16x8*)(WRL + o); }
        v2u xb[2][4];
#pragma unroll
        for (int rr = 0; rr < 2; ++rr)
#pragma unroll
            for (int i = 0; i < 4; ++i) xb[rr][i] = *((const GAS v2u*)(X1 + ((size_t)rb * 128 + 2 * w + rr) * D) + lane + 64 * i);
        for (int tile = 0; tile < 8; ++tile) {
#pragma unroll
            for (int rr = 0; rr < 2; ++rr) { const int r = 2 * w + rr; const size_t t = (size_t)rb * 128 + 16 * tile + r;
                float s = 0.f; f32x4 xv[4];
#pragma unroll
                for (int i = 0; i < 4; ++i) { xv[i] = (f32x4){bflo(xb[rr][i].x), bfhi(xb[rr][i].x), bflo(xb[rr][i].y), bfhi(xb[rr][i].y)}; s += (xv[i].x * xv[i].x + xv[i].y * xv[i].y) + (xv[i].z * xv[i].z + xv[i].w * xv[i].w); }
                const float rstd = rsqrtf(wave_sum(s) * (1.0f / D) + EPS);
#pragma unroll
                for (int i = 0; i < 4; ++i) { const f32x4 hv = xv[i] * rstd * A2[i] + B2[i];
                    unsigned hb[4], lb[4];
#pragma unroll
                    for (int e = 0; e < 4; ++e) { hb[e] = f2bf(hv[e]); lb[e] = f2bf(hv[e] - bf2f(hb[e])); }
                    v2u wh, wl2; wh.x = hb[0] | (hb[1] << 16); wh.y = hb[2] | (hb[3] << 16); wl2.x = lb[0] | (lb[1] << 16); wl2.y = lb[2] | (lb[3] << 16);
                    *((GAS unsigned*)(H2 + t * D) + lane + 64 * i) = __builtin_amdgcn_cvt_pk_fp8_f32(hv[2], hv[3], __builtin_amdgcn_cvt_pk_fp8_f32(hv[0], hv[1], 0, false), true);
                    *(LAS v2u*)(HI + r * RS + (4 * lane + 256 * i) * 2) = wh; *(LAS v2u*)(LO + r * RS + (4 * lane + 256 * i) * 2) = wl2; }
            }
            if (tile < 7) {
#pragma unroll
                for (int rr = 0; rr < 2; ++rr)
#pragma unroll
                    for (int i = 0; i < 4; ++i) xb[rr][i] = *((const GAS v2u*)(X1 + ((size_t)rb * 128 + 16 * (tile + 1) + 2 * w + rr) * D) + lane + 64 * i);
            }
            __syncthreads();
            f32x4 acc[2]; acc[0] = (f32x4){0.f, 0.f, 0.f, 0.f}; acc[1] = acc[0];
#pragma unroll
            for (int s = 0; s < 4; ++s) { const int ko = (128 * w + 32 * s + 8 * q) * 2;
                const bf16x8 ah = *(const LAS bf16x8*)(HI + j * RS + ko), al = *(const LAS bf16x8*)(LO + j * RS + ko);
#pragma unroll
                for (int n = 0; n < 2; ++n) { acc[n] = __builtin_amdgcn_mfma_f32_16x16x32_bf16(ah, bh[s][n], acc[n], 0, 0, 0);
                    acc[n] = __builtin_amdgcn_mfma_f32_16x16x32_bf16(ah, bl[s][n], acc[n], 0, 0, 0); acc[n] = __builtin_amdgcn_mfma_f32_16x16x32_bf16(al, bh[s][n], acc[n], 0, 0, 0); } }
#pragma unroll
            for (int n = 0; n < 2; ++n)
#pragma unroll
                for (int r = 0; r < 4; ++r) PLOG[(w * 16 + 4 * q + r) * 32 + 16 * n + j] = acc[n][r];
            __syncthreads();
            { const int tk = F.tid >> 5, e = F.tid & 31;
              float lg = args.in[I_BR][e];
#pragma unroll
              for (int w2 = 0; w2 < 8; ++w2) lg += PLOG[(w2 * 16 + tk) * 32 + e];
              float tv[4]; int ti[4]; float v = lg;
#pragma unroll
              for (int k = 0; k < 4; ++k) { float bv = v; int bi = e;
#pragma unroll
                  for (int off = 1; off < 32; off <<= 1) { const float ov = __shfl_xor(bv, off); const int oi = __shfl_xor(bi, off); if (ov > bv || (ov == bv && oi < bi)) { bv = ov; bi = oi; } }
                  tv[k] = bv; ti[k] = bi; if (e == bi) v = -3.0e38f; }
              const float e1 = __expf(tv[1] - tv[0]), e2 = __expf(tv[2] - tv[0]), e3 = __expf(tv[3] - tv[0]); const float inv = 1.0f / (1.0f + e1 + e2 + e3);
              if (e < 4) { const float gk = (e == 0 ? 1.0f : e == 1 ? e1 : e == 2 ? e2 : e3) * inv; const int ik = e == 0 ? ti[0] : e == 1 ? ti[1] : e == 2 ? ti[2] : ti[3];
                  const size_t t = (size_t)rb * 128 + 16 * tile + tk; TOPI[t * 4 + e] = ik; TOPG[t * 4 + e] = gk; SEL[(16 * tile + tk) * 4 + e] = ik; } }
        }
        __syncthreads();
        { const int myE = SEL[F.tid]; int rk = 0, cm = 0;
#pragma unroll 1
          for (int e = 0; e < 32; ++e) { const unsigned long long m = __ballot(myE == e); if (myE == e) rk = __popcll(m & ((1ull << lane) - 1ull)); if (lane == e) cm = __popcll(m); }
          if (lane < 32) CNTW[w * 32 + lane] = cm;
          __syncthreads();
          int base = 0;
          for (int w2 = 0; w2 < w; ++w2) base += CNTW[w2 * 32 + myE];
          LRANK[(size_t)rb * 512 + F.tid] = base + rk;
          if (F.tid < 32) { int tot = 0;
#pragma unroll
              for (int w2 = 0; w2 < 8; ++w2) tot += CNTW[w2 * 32 + F.tid];
              BCNT[rb * 32 + F.tid] = tot; } }
        __syncthreads();
    }
}
__device__ __forceinline__ void p7_positions(Frame& F) {
    LAS int* PT = (LAS int*)F.lds; LAS int* PB = PT + 512; LAS int* TOT = PB + 512; LAS int* BEF = TOT + 32; LAS int* PS = BEF + 32;
    const int* BCNT = (const int*)(F.ws + WS_BCNT); const int* TOPI = (const int*)(F.ws + WS_TOPI); const int* LRANK = (const int*)(F.ws + WS_LRANK);
    int* POSOF = (int*)(F.ws + WS_POSOF); int* ROWTOK = (int*)(F.ws + WS_ROWTOK); int* META = (int*)(F.ws + WS_META);
    for (int rb = F.bx; rb < T / 128; rb += F.G) {
        { const int e = F.tid & 31, part = F.tid >> 5; int tot = 0, bef = 0;
          for (int c2 = part * 16; c2 < part * 16 + 16; ++c2) { const int v = BCNT[c2 * 32 + e]; tot += v; if (c2 < rb) bef += v; }
          PT[F.tid] = tot; PB[F.tid] = bef; }
        __syncthreads();
        if (F.tid < 32) { int tot = 0, bef = 0;
#pragma unroll
            for (int p = 0; p < 16; ++p) { tot += PT[p * 32 + F.tid]; bef += PB[p * 32 + F.tid]; }
            TOT[F.tid] = tot; BEF[F.tid] = bef; }
        __syncthreads();
        if (F.tid == 0) { int run = 0; for (int e = 0; e < 32; ++e) { PS[e] = run; run += ((TOT[e] + 255) >> 8) << 8; } PS[32] = run; }
        __syncthreads();
        { const size_t pi = (size_t)rb * 512 + F.tid; const int e = TOPI[pi]; const int pos = PS[e] + BEF[e] + LRANK[pi]; ROWTOK[pos] = rb * 128 + (F.tid >> 2); POSOF[pi] = pos; }
        if (rb < 32) { const int e = rb, lim = ((TOT[e] + 255) >> 8) << 8; for (int r = TOT[e] + F.tid; r < lim; r += 512) ROWTOK[PS[e] + r] = 0; }
        if (rb == 0 && F.tid <= 32) META[F.tid] = PS[F.tid] >> 8;
        __syncthreads();
    }
}
__device__ __forceinline__ int moe_tables(Frame& F, LAS int* texp) {
    const int* META = (const int*)(F.ws + WS_META);
    const int MT = META[32];
    for (int pm = F.tid; pm < MT; pm += 512) { int e = 0;
#pragma unroll 1
        for (int k = 1; k < 32; ++k) if (META[k] <= pm) e = k;
        texp[pm] = e; }
    __syncthreads();
    return MT;
}
__device__ __forceinline__ void p10_combine(Frame& F, const Args& args) {
    const bf16* X1 = (const bf16*)(F.ws + WS_X1); const unsigned char* Y = F.ws + WS_Y; const float* mf = (const float*)(F.ws + WS_MODF);
    const int* POSOF = (const int*)(F.ws + WS_POSOF); const float* TOPG = (const float*)(F.ws + WS_TOPG);
    const int lane = F.lane;
    for (int rb = F.bx; rb < T / 128; rb += F.G) {
        const int b = rb >> 5;
        f32x4 g2[4], fg[4];
#pragma unroll
        for (int i = 0; i < 4; ++i) { g2[i] = *(const f32x4*)(mf + (size_t)b * NMODW + 5 * D + 256 * i + 4 * lane); fg[i] = *(const f32x4*)(args.in[I_FNG] + 256 * i + 4 * lane); }
        for (int r = F.wave; r < 128; r += NWAVES) {
            const size_t t = (size_t)rb * 128 + r;
            const int p0 = POSOF[t * 4 + 0], p1 = POSOF[t * 4 + 1], p2 = POSOF[t * 4 + 2], p3 = POSOF[t * 4 + 3];
            const float k0 = TOPG[t * 4 + 0] * Y8_INV, k1 = TOPG[t * 4 + 1] * Y8_INV, k2 = TOPG[t * 4 + 2] * Y8_INV, k3 = TOPG[t * 4 + 3] * Y8_INV;
            f32x4 o[4]; float s = 0.f;
#pragma unroll
            for (int i = 0; i < 4; ++i) {
                const v2u xw = *((const GAS v2u*)(X1 + t * D) + lane + 64 * i);
                const unsigned y0 = *((const GAS unsigned*)(Y + (size_t)p0 * D) + lane + 64 * i), y1 = *((const GAS unsigned*)(Y + (size_t)p1 * D) + lane + 64 * i);
                const unsigned y2 = *((const GAS unsigned*)(Y + (size_t)p2 * D) + lane + 64 * i), y3 = *((const GAS unsigned*)(Y + (size_t)p3 * D) + lane + 64 * i);
                const f32x2 a0 = __builtin_amdgcn_cvt_pk_f32_fp8(y0, false), b0 = __builtin_amdgcn_cvt_pk_f32_fp8(y0, true), a1 = __builtin_amdgcn_cvt_pk_f32_fp8(y1, false), b1 = __builtin_amdgcn_cvt_pk_f32_fp8(y1, true);
                const f32x2 a2 = __builtin_amdgcn_cvt_pk_f32_fp8(y2, false), b2 = __builtin_amdgcn_cvt_pk_f32_fp8(y2, true), a3 = __builtin_amdgcn_cvt_pk_f32_fp8(y3, false), b3 = __builtin_amdgcn_cvt_pk_f32_fp8(y3, true);
                f32x4 m;
                m.x = (k0 * a0.x + k1 * a1.x) + (k2 * a2.x + k3 * a3.x); m.y = (k0 * a0.y + k1 * a1.y) + (k2 * a2.y + k3 * a3.y);
                m.z = (k0 * b0.x + k1 * b1.x) + (k2 * b2.x + k3 * b3.x); m.w = (k0 * b0.y + k1 * b1.y) + (k2 * b2.y + k3 * b3.y);
                const f32x4 xv = (f32x4){bflo(xw.x), bfhi(xw.x), bflo(xw.y), bfhi(xw.y)};
                o[i] = xv + g2[i] * m; s += (o[i].x * o[i].x + o[i].y * o[i].y) + (o[i].z * o[i].z + o[i].w * o[i].w); }
            const float rstd = rsqrtf(wave_sum(s) * (1.0f / D) + EPS);
#pragma unroll
            for (int i = 0; i < 4; ++i) *((GAS f32x4*)(F.out + t * D) + lane + 64 * i) = o[i] * rstd * fg[i];
        }
    }
}

__global__ void __launch_bounds__(NWAVES * 64, 2) hymba_fwd(Args args) {
    extern __shared__ __attribute__((aligned(16))) unsigned char lds[];
    Frame F;
    F.lds = (LAS unsigned char*)lds;
    F.MISC = (volatile LAS unsigned*)(F.lds + MISC_OFF);
    F.tid = threadIdx.x; F.lane = F.tid & 63; F.wave = __builtin_amdgcn_readfirstlane(F.tid >> 6);
    F.G = gridDim.x; F.bx = blockIdx.x;
    F.out = args.out; F.ws = args.ws; F.ctl = (gu32*)(args.ws + WS_CTL);
    for (int u = F.tid; u < (LDS_BYTES - LDSCTL_OFF) / 4; u += NWAVES * 64) ((LAS unsigned*)(F.lds + LDSCTL_OFF))[u] = 0u;
    __syncthreads();
    XcdBarrier bar; bar.bar = (unsigned*)(F.ctl + CW_BAR); bar.x = 0; bar.st = nullptr;
    if (N_LAUNCHES != PER_PHASE) bar = xcd_barrier_post((unsigned*)(F.ctl + CW_BAR) + args.li * XCD_BAR_WORDS, F.MISC + 8);
#define GRID_BAR() do { if (N_LAUNCHES != PER_PHASE) xcd_barrier(bar); } while (0)
    const int lo = args.ph_lo, hi = args.ph_hi;
#define IN(k) (lo <= (k) && (k) < hi)
#define BOTH(k) (IN(k) && IN((k) + 1))
    const PG8_LAS unsigned* gtab = (const PG8_LAS unsigned*)(F.lds + AUX_OFF);
    LAS int* texp = (LAS int*)(F.lds + AUX_OFF + AUX_TEXP);

    if (IN(0)) { p0_prologue(F, args); if (BOTH(0)) GRID_BAR(); }
    if (IN(1)) { p1_norm1(F, args); if (BOTH(1)) GRID_BAR(); }
    if (IN(2)) {
        pg8::Order S; S.init(T / 256, 2048 / 256, F.G, F.bx, F.ws + WS_H, F.ws + WS_WIN, D, 0, nullptr, false);
        pg8::EpiInProj E{(bf16*)(F.ws + WS_V), (bf16*)(F.ws + WS_GG), (bf16*)(F.ws + WS_UREC)};
        pg8::gemm_phase<pg8::EpiInProj, pg8::Order, false, true, true, false>(F.lds, D, S, E, gtab);
        if (BOTH(2)) GRID_BAR();
    }
    if (IN(3)) {
        for (int ck = F.bx; ck < T / 128; ck += F.G) { lru_unit<1>(F, args, ck); __syncthreads(); }
        for (int u = F.bx; u < T / 64; u += F.G) { conv_unit(F, args, u); __syncthreads(); }
        if (BOTH(3)) GRID_BAR();
    }
    if (IN(4)) {
        for (int ck = F.bx; ck < T / 128; ck += F.G) { lru_unit<2>(F, args, ck); __syncthreads(); }
        if (BOTH(4)) GRID_BAR();
    }
    if (IN(5)) {
        pg8::Order S; S.init(T / 256, D / 256, F.G, F.bx, F.ws + WS_H, F.ws + WS_WOUT, D, 0, nullptr, false);
        pg8::EpiOutProj E{args.in[I_X], (bf16*)(F.ws + WS_X1), (const float*)(F.ws + WS_MODF)};
        pg8::gemm_phase<pg8::EpiOutProj, pg8::Order, false, true, true, false>(F.lds, D, S, E, gtab);
        if (BOTH(5)) GRID_BAR();
    }
    if (IN(6)) { p6_router(F, args); if (BOTH(6)) GRID_BAR(); }
    if (IN(7)) { p7_positions(F); if (BOTH(7)) GRID_BAR(); }
    if (IN(8)) {
        const int MT = moe_tables(F, texp);
        pg8::Order S; S.init(MT, 2048 / 256, F.G, F.bx, F.ws + WS_H, F.ws + WS_WGU, D / 2, (size_t)2048 * D, texp, true);
        { const int* ROWTOK = (const int*)(F.ws + WS_ROWTOK); pg8::Unit u; LAS unsigned* gt = (LAS unsigned*)(F.lds + AUX_OFF);
          for (int i = 0; i < 18 && S.next(i, u); ++i) if (F.tid < 256) gt[i * 256 + F.tid] = (unsigned)ROWTOK[u.pm * 256 + F.tid] * (unsigned)D; }
        __syncthreads();
        pg8::EpiSwiglu E{F.ws + WS_ACT, args.in[I_BGU]};
        pg8::gemm_phase<pg8::EpiSwiglu, pg8::Order, true, true, true, true>(F.lds, D / 2, S, E, gtab);
        if (BOTH(8)) GRID_BAR();
    }
    if (IN(9)) {
        const int MT = moe_tables(F, texp);
        pg8::Order S; S.init(MT, D / 256, F.G, F.bx, F.ws + WS_ACT, F.ws + WS_WD, DE / 2, (size_t)D * DE, texp, false);
        pg8::EpiDown E{F.ws + WS_Y, args.in[I_BD]};
        pg8::gemm_phase<pg8::EpiDown, pg8::Order, false, true, true, true>(F.lds, DE / 2, S, E, gtab);
        if (BOTH(9)) GRID_BAR();
    }
    if (IN(10)) { p10_combine(F, args); }
#undef IN
#undef BOTH
}

extern "C" void kernel_launch(void* const* d_in, const int* in_sizes, int n_in, void* d_out, int out_size, void* d_ws, size_t ws_size, hipStream_t stream) {
    static int grid = 0;
    if (grid == 0) {
        if (n_in != 27 || in_sizes[0] != T * D || out_size != T * D || ws_size < WS_END) { fprintf(stderr, "kernel_launch: unexpected shapes (n_in %d, in0 %d, out %d, ws %zu); nothing launched\n", n_in, n_in > 0 ? in_sizes[0] : -1, out_size, ws_size); grid = -1; return; }
        int dev = 0, cus = 0, per_cu = 0;
        if (hipGetDevice(&dev) != hipSuccess || hipDeviceGetAttribute(&cus, hipDeviceAttributeMultiprocessorCount, dev) != hipSuccess) { grid = -1; return; }
        if (hipFuncSetAttribute((const void*)hymba_fwd, hipFuncAttributeMaxDynamicSharedMemorySize, LDS_BYTES) != hipSuccess) { fprintf(stderr, "kernel_launch: hipFuncSetAttribute failed\n"); grid = -1; return; }
        if (hipOccupancyMaxActiveBlocksPerMultiprocessor(&per_cu, (const void*)hymba_fwd, NWAVES * 64, LDS_BYTES) != hipSuccess || per_cu < 1)
            fprintf(stderr, "kernel_launch: note: occupancy query reports %d workgroups per CU\n", per_cu);
        (void)hipGetLastError();
        grid = cus;
    }
    if (grid < 0) return;
    if (hipMemsetAsync((char*)d_ws + WS_CTL, 0, CTL_ZERO_BYTES, stream) != hipSuccess) return;
    Args a{};
    for (int i = 0; i < 27; ++i) a.in[i] = (const float*)d_in[i];
    a.out = (float*)d_out; a.ws = (unsigned char*)d_ws;
    if (N_LAUNCHES == 1) { a.ph_lo = 0; a.ph_hi = PER_PHASE; a.li = 0; hipLaunchKernelGGL(hymba_fwd, dim3(grid), dim3(NWAVES * 64), LDS_BYTES, stream, a); }
    else { for (int li = 0; li < PER_PHASE; ++li) { a.ph_lo = li; a.ph_hi = li + 1; a.li = 0; hipLaunchKernelGGL(hymba_fwd, dim3(grid), dim3(NWAVES * 64), LDS_BYTES, stream, a); } }
    const hipError_t le = hipPeekAtLastError();
    if (le != hipSuccess) fprintf(stderr, "kernel_launch: launch failed: %s\n", hipGetErrorName(le));
}
```

```cpp
#include <hip/hip_runtime.h>
#include <cstdio>
#include <cstdint>

#define GAS __attribute__((address_space(1)))
#define LAS __attribute__((address_space(3)))
typedef unsigned short bf16;
typedef unsigned v4u __attribute__((ext_vector_type(4)));
typedef unsigned v2u __attribute__((ext_vector_type(2)));
typedef float f32x4 __attribute__((ext_vector_type(4)));
typedef float f32x2 __attribute__((ext_vector_type(2)));
typedef short bf16x8 __attribute__((ext_vector_type(8)));
typedef GAS unsigned gu32;
#define RLX_AGENT __ATOMIC_RELAXED, __HIP_MEMORY_SCOPE_AGENT
#define LDS_WAIT() asm volatile("s_waitcnt lgkmcnt(0)" ::: "memory")
#define VM_WAIT() asm volatile("s_waitcnt vmcnt(0)" ::: "memory")

constexpr int NB = 8, SEQ = 4096, T = NB * SEQ, D = 1024, DC = 512, NE = 32, TOPK = 4, DE = 1024, NMODW = 6 * D;
constexpr int NPAIR = T * TOPK, MAXROWS = NPAIR + NE * 256, MAXMT = MAXROWS / 256;
constexpr float EPS = 1e-6f;
constexpr int NWAVES = 8;
#ifndef MK_N_LAUNCHES
#define MK_N_LAUNCHES 1
#endif
constexpr int N_LAUNCHES = MK_N_LAUNCHES;
constexpr int PER_PHASE = 11;

constexpr size_t MiB = 1u << 20, KiB = 1024;
constexpr size_t WS_CTL = 0, CTL_ZERO_BYTES = 1 * MiB;
constexpr size_t WS_MODP = 1 * MiB;
constexpr size_t WS_MODF = 2 * MiB;
constexpr size_t WS_WRH = 2 * MiB + 256 * KiB, WS_WRL = WS_WRH + 64 * KiB;
constexpr size_t WS_SUMA = 2 * MiB + 512 * KiB, WS_SUMH = 3 * MiB;
constexpr size_t WS_TOPI = 3 * MiB + 512 * KiB, WS_TOPG = 4 * MiB, WS_LRANK = 4 * MiB + 512 * KiB, WS_POSOF = 5 * MiB;
constexpr size_t WS_BCNT = 5 * MiB + 512 * KiB, WS_META = WS_BCNT + 64 * KiB;
constexpr size_t WS_ROWTOK = 6 * MiB;
constexpr size_t WS_LRUB = 7 * MiB;
constexpr size_t WS_WIN = 16 * MiB, WS_WOUT = 20 * MiB;
constexpr size_t WS_WD = 24 * MiB;
constexpr size_t WS_WGU = 56 * MiB;
constexpr size_t WS_H = 120 * MiB;
constexpr size_t WS_V = 184 * MiB, WS_GG = 216 * MiB, WS_UREC = 248 * MiB;
constexpr size_t WS_X1 = 280 * MiB;
constexpr size_t WS_ACT = 408 * MiB;
constexpr size_t WS_Y = 544 * MiB;
constexpr size_t WS_HLOC = 816 * MiB, WS_PCUM = 848 * MiB;
constexpr size_t WS_END = 880 * MiB;
static_assert(WS_ACT + (size_t)MAXROWS * DE <= WS_Y && WS_Y + (size_t)MAXROWS * D <= WS_END, "ws map");
constexpr float Y8_SCALE = 16.0f, Y8_INV = 1.0f / 16.0f;
constexpr float W8_SCALE = 64.0f, W8_INV = 1.0f / 64.0f;
constexpr int CW_BAR = 4096;

constexpr int RING_BYTES = 131072, AUX_OFF = 131072, AUX_BYTES = 30208, LDSCTL_OFF = AUX_OFF + AUX_BYTES, MISC_OFF = LDSCTL_OFF + 320, LDS_BYTES = LDSCTL_OFF + 1024;
constexpr int MAXU = 18;
constexpr int AUX_TEXP = 18432;
constexpr int AUX_BIAS = AUX_TEXP + 2304;
constexpr int AUX_UTAB = AUX_BIAS + MAXU * 512;
static_assert(AUX_TEXP + MAXMT * 4 <= AUX_BIAS && AUX_UTAB + (MAXU + 1) * 4 <= AUX_BYTES && LDS_BYTES <= 163840, "aux");

typedef __bf16 hwbf16x2 __attribute__((ext_vector_type(2)));
__device__ __forceinline__ unsigned pk2(float lo, float hi) { const f32x2 v = {lo, hi}; return __builtin_bit_cast(unsigned, __builtin_convertvector(v, hwbf16x2)); }
__device__ __forceinline__ unsigned f2bf(float f) { return pk2(f, 0.f) & 0xffffu; }
__device__ __forceinline__ float bf2f(unsigned b) { return __builtin_bit_cast(float, b << 16); }
__device__ __forceinline__ float bflo(unsigned w) { return __builtin_bit_cast(float, w << 16); }
__device__ __forceinline__ float bfhi(unsigned w) { return __builtin_bit_cast(float, w & 0xffff0000u); }
__device__ __forceinline__ float sigmoidf_(float z) { return __builtin_amdgcn_rcpf(1.0f + __expf(-z)); }

namespace pg8 {
#define PG8_LAS __attribute__((address_space(3)))
typedef unsigned short bf16_t;
typedef unsigned u32x4 __attribute__((ext_vector_type(4)));
constexpr int BM = 256, BK = 64, HALF = 128, HTB = HALF * BK * 2, STAGE_BYTES = 8 * HTB, NXCD = 8, WGM = 8;
__host__ __device__ __forceinline__ int lds_byte(int r, int c) { const int st = (r >> 4) * 2 + (c >> 5), rr = r & 15, cc = c & 31, ob = rr * 64 + cc * 2; return st * 1024 + (ob ^ (((ob >> 9) & 1) << 5)); }
__host__ __device__ __forceinline__ void stage_rc(int b, int& R, int& C) { const int st = b / 1024, sb = b % 1024, swz = sb ^ (((sb >> 9) & 1) << 5); R = (st >> 1) * 16 + swz / 64; C = (st & 1) * 32 + (swz % 64) / 2; }
__host__ __device__ __forceinline__ int perm32(int rho) { const int n = rho >> 4, i = rho & 15; return 8 * (i >> 2) + 4 * n + (i & 3); }
__device__ __forceinline__ unsigned cvt_pk_bf16(float lo, float hi) { unsigned r; asm volatile("v_cvt_pk_bf16_f32 %0, %1, %2" : "=v"(r) : "v"(lo), "v"(hi)); return r; }

typedef int v8i __attribute__((ext_vector_type(8)));
typedef int v4i __attribute__((ext_vector_type(4)));
__device__ __forceinline__ v8i cat8(bf16x8 lo, bf16x8 hi) { const v4i a = __builtin_bit_cast(v4i, lo), b = __builtin_bit_cast(v4i, hi); return __builtin_shufflevector(a, b, 0, 1, 2, 3, 4, 5, 6, 7); }
struct Unit { int pm, pn, e, slot; };

struct Order {
    int nM, nN, nwg, G, c; const char* A; const char* Bt; size_t tstep, estep; const PG8_LAS int* texp; bool gather; const PG8_LAS int* utab;
    __device__ __forceinline__ void init(int nM_, int nN_, int G_, int c_, const void* A_, const void* Bt_, int K, size_t estep_, const PG8_LAS int* texp_, bool gather_) {
        nM = nM_; nN = nN_; nwg = nM * nN; G = G_; c = c_; A = (const char*)A_; Bt = (const char*)Bt_; tstep = (size_t)BM * K * 2; estep = estep_; texp = texp_; gather = gather_; utab = (const PG8_LAS int*)~0u; }
    __device__ __forceinline__ bool next(int i, Unit& u) const {
        if (utab != (const PG8_LAS int*)~0u) { const int d = __builtin_amdgcn_readfirstlane(utab[i]); if (d < 0) return false; u.pm = d & 0xfff; u.pn = (d >> 12) & 0xf; u.e = d >> 16; u.slot = i; return true; }
        return compute(i, u); }
    __device__ __forceinline__ bool compute(int i, Unit& u) const {
        u.slot = i;
        const long L = (long)i * G + c; if (L >= nwg) return false;
        int wgid = (int)L; { const int q = nwg / NXCD, r = nwg % NXCD, xcd = wgid % NXCD, off = wgid / NXCD; wgid = (xcd < r ? xcd * (q + 1) : r * (q + 1) + (xcd - r) * q) + off; }
        const int nig = WGM * nN, gid = wgid / nig, fm = gid * WGM, gsz = (nM - fm) < WGM ? (nM - fm) : WGM;
        u.pm = fm + ((wgid % nig) % gsz); u.pn = (wgid % nig) / gsz; u.e = texp ? __builtin_amdgcn_readfirstlane(texp[u.pm]) : 0; return true;
    }
    __device__ __forceinline__ unsigned a_off(const Unit& u) const { return gather ? 0u : (unsigned)u.pm * (unsigned)tstep; }
    __device__ __forceinline__ unsigned b_off(const Unit& u) const { return (unsigned)u.e * (unsigned)estep + (unsigned)u.pn * (unsigned)tstep; }
};

template <class Epi, class Sched, bool GATHER, bool ALIGN_EPI, bool SP2, bool FP8>
__device__ __forceinline__ void gemm_phase(PG8_LAS unsigned char* lds, const int K, const Sched& S, const Epi& E, const PG8_LAS unsigned* gtab) {
    const int tid = threadIdx.x, wid = __builtin_amdgcn_readfirstlane(tid >> 6), lane = tid & 63, wr = wid >> 2, wc = wid & 3, fr = lane & 15, fq = lane >> 4;
    const int nt = K / BK;
    const __amdgpu_buffer_rsrc_t rsA = __builtin_amdgcn_make_buffer_rsrc((void*)S.A, 0, -1, 0x00020000);
    const __amdgpu_buffer_rsrc_t rsB = __builtin_amdgcn_make_buffer_rsrc((void*)S.Bt, 0, -1, 0x00020000);
    unsigned voffA[2], voffB[2]; unsigned offA[2][2];
#pragma unroll
    for (int i = 0; i < 2; ++i) { int R, C; stage_rc(tid * 16 + i * 8192, R, C); const int Rb = Epi::PERM ? ((R & ~31) + perm32(R & 31)) : R;
        voffA[i] = (unsigned)(R * K + C) * 2u; voffB[i] = (unsigned)(Rb * K + C) * 2u; offA[0][i] = 0; offA[1][i] = 0; }
    const unsigned kstep = (unsigned)(BK * 2);
    const unsigned hstep = (unsigned)HALF * K * 2;
    const unsigned ldsw = (unsigned)wid * 1024u;
    const int aoff = lds_byte(wr * 64 + fr, fq * 8), boff = lds_byte(wc * 32 + fr, fq * 8);
#define PG8_SA(b, h) (((b) * 2 + (h)) * HTB)
#define PG8_SB(b, h) ((4 + (b) * 2 + (h)) * HTB)
#define PG8_STAGE(rs, bufoff, soff, voff) do { _Pragma("unroll") for (int _i = 0; _i < 2; ++_i) \
        __builtin_amdgcn_raw_ptr_buffer_load_lds(rs, (PG8_LAS void*)(lds + (bufoff) + ldsw + _i * 8192), 16, (int)(voff)[_i], (int)(soff), 0, 0); } while (0)
#define PG8_STAGE_A(b, h, kbase) do { if constexpr (GATHER) { PG8_STAGE(rsA, PG8_SA(b, h), (kbase), offA[h]); } else { PG8_STAGE(rsA, PG8_SA(b, h), (kbase) + (h) * hstep, voffA); } } while (0)
#define PG8_STAGE_B(b, h, kbase) PG8_STAGE(rsB, PG8_SB(b, h), (kbase) + (h) * hstep, voffB)
#define PG8_LOAD_OFFS(slot) do { _Pragma("unroll") for (int _i = 0; _i < 2; ++_i) { int _R, _C; stage_rc(tid * 16 + _i * 8192, _R, _C); \
        _Pragma("unroll") for (int _h = 0; _h < 2; ++_h) offA[_h][_i] = gtab[(slot) * 256 + _h * 128 + _R] + (unsigned)_C * 2u; } } while (0)
#define PG8_LDA(dst, b, h) do { _Pragma("unroll") for (int m = 0; m < 4; ++m) _Pragma("unroll") for (int k = 0; k < 2; ++k) dst[m][k] = *(const PG8_LAS bf16x8*)(lds + PG8_SA(b, h) + aoff + m * 2048 + k * 1024); } while (0)
#define PG8_LDB(dst, b, h) do { _Pragma("unroll") for (int n = 0; n < 2; ++n) _Pragma("unroll") for (int k = 0; k < 2; ++k) dst[n][k] = *(const PG8_LAS bf16x8*)(lds + PG8_SB(b, h) + boff + n * 2048 + k * 1024); } while (0)
#define PG8_MMA(ai, bj, At, Bt) do { __builtin_amdgcn_s_setprio(1); _Pragma("unroll") for (int m = 0; m < 4; ++m) _Pragma("unroll") for (int n = 0; n < 2; ++n) { \
        if constexpr (FP8) { acc[ai][bj][m][n] = __builtin_amdgcn_mfma_scale_f32_16x16x128_f8f6f4(cat8(Bt[n][0], Bt[n][1]), cat8(At[m][0], At[m][1]), acc[ai][bj][m][n], 0, 0, 0, 0, 0, 0); } \
        else { _Pragma("unroll") for (int k = 0; k < 2; ++k) acc[ai][bj][m][n] = __builtin_amdgcn_mfma_f32_16x16x32_bf16(Bt[n][k], At[m][k], acc[ai][bj][m][n], 0, 0, 0); } } __builtin_amdgcn_s_setprio(0); } while (0)
#define PG8_WAIT_V(n) asm volatile("s_waitcnt vmcnt(" #n ")" ::: "memory")
#define PG8_WAIT_L(n) asm volatile("s_waitcnt lgkmcnt(" #n ")" ::: "memory")
#define PG8_BAR __builtin_amdgcn_s_barrier()
#define PG8_SCHED __builtin_amdgcn_sched_barrier(0)
    Unit cur, nxt; int ui = 0;
    if (!S.next(0, cur)) return;
    f32x4 acc[2][2][4][2];
#pragma unroll
    for (int a = 0; a < 2; ++a)
#pragma unroll
        for (int b = 0; b < 2; ++b)
#pragma unroll
            for (int m = 0; m < 4; ++m)
#pragma unroll
                for (int n = 0; n < 2; ++n) acc[a][b][m][n] = (f32x4){0.f, 0.f, 0.f, 0.f};
    bf16x8 At[4][2], B0[2][2], B1[2][2];
    unsigned cA = S.a_off(cur), cB = S.b_off(cur);
    if constexpr (GATHER) { PG8_LOAD_OFFS(0); }
    if constexpr (SP2) {
        PG8_STAGE_B(0, 0, cB); PG8_STAGE_B(0, 1, cB); PG8_STAGE_A(0, 0, cA); PG8_STAGE_A(0, 1, cA);
        if (wr == 1) PG8_BAR;
        PG8_WAIT_V(2); PG8_BAR;
        PG8_STAGE_B(1, 0, cB + kstep); PG8_STAGE_A(1, 0, cA + kstep); PG8_STAGE_B(1, 1, cB + kstep);
        PG8_WAIT_V(6); PG8_BAR;
    } else {
        PG8_STAGE_B(0, 0, cB); PG8_STAGE_A(0, 0, cA); PG8_STAGE_B(0, 1, cB); PG8_STAGE_A(0, 1, cA);
        if (wr == 1) PG8_BAR;
        PG8_WAIT_V(4); PG8_BAR;
        PG8_STAGE_B(1, 0, cB + kstep); PG8_STAGE_A(1, 0, cA + kstep); PG8_STAGE_B(1, 1, cB + kstep);
        PG8_WAIT_V(6); PG8_BAR;
    }
    for (;;) {
        const bool has_next = S.next(ui + 1, nxt);
        const unsigned nA = has_next ? S.a_off(nxt) : cA, nB = has_next ? S.b_off(nxt) : cB;
#pragma unroll 1
        for (int t = 0; t < nt; t += 2) {
            const bool last = (t == nt - 2);
            const unsigned a1 = cA + (unsigned)(t + 1) * kstep;
            const unsigned a2 = last ? nA : cA + (unsigned)(t + 2) * kstep, b2 = last ? nB : cB + (unsigned)(t + 2) * kstep;
            const unsigned a3 = a2 + kstep, b3 = b2 + kstep;
            if constexpr (SP2) {
            PG8_LDB(B0, 0, 0); PG8_LDB(B1, 0, 1); PG8_SCHED; PG8_LDA(At, 0, 0); PG8_STAGE_A(1, 1, a1);
            PG8_WAIT_V(8); PG8_WAIT_L(0); PG8_BAR; PG8_MMA(0, 0, At, B0); PG8_MMA(0, 1, At, B1); PG8_BAR; PG8_SCHED;
            if constexpr (GATHER) { if (last && has_next) { PG8_LOAD_OFFS(ui + 1); } }
            PG8_LDA(At, 0, 1); PG8_STAGE_B(0, 0, b2); PG8_STAGE_B(0, 1, b2); PG8_STAGE_A(0, 0, a2);
            PG8_WAIT_V(8); PG8_WAIT_L(0); PG8_BAR; PG8_MMA(1, 0, At, B0); PG8_MMA(1, 1, At, B1); PG8_BAR; PG8_SCHED;
            PG8_LDB(B0, 1, 0); PG8_LDB(B1, 1, 1); PG8_SCHED; PG8_LDA(At, 1, 0); PG8_STAGE_A(0, 1, a2);
            PG8_WAIT_V(8); PG8_WAIT_L(0); PG8_BAR; PG8_MMA(0, 0, At, B0); PG8_MMA(0, 1, At, B1); PG8_BAR; PG8_SCHED;
            PG8_LDA(At, 1, 1); PG8_STAGE_B(1, 0, b3); PG8_STAGE_B(1, 1, b3); PG8_STAGE_A(1, 0, a3);
            PG8_WAIT_V(8); PG8_WAIT_L(0); PG8_BAR; PG8_MMA(1, 0, At, B0); PG8_MMA(1, 1, At, B1); PG8_BAR; PG8_SCHED;
            } else {
            PG8_LDB(B0, 0, 0); PG8_SCHED; PG8_LDA(At, 0, 0); PG8_STAGE_A(1, 1, a1);
            PG8_WAIT_L(8); PG8_BAR; PG8_WAIT_L(0); PG8_MMA(0, 0, At, B0); PG8_BAR; PG8_SCHED;
            if constexpr (GATHER) { if (last && has_next) { PG8_LOAD_OFFS(ui + 1); } }
            PG8_LDB(B1, 0, 1); PG8_STAGE_B(0, 0, b2);
            PG8_BAR; PG8_WAIT_L(0); PG8_MMA(0, 1, At, B1); PG8_BAR;
            PG8_LDA(At, 0, 1); PG8_STAGE_A(0, 0, a2);
            PG8_BAR; PG8_WAIT_L(0); PG8_MMA(1, 0, At, B0); PG8_BAR; PG8_SCHED;
            PG8_STAGE_B(0, 1, b2);
            PG8_WAIT_V(6); PG8_BAR; PG8_MMA(1, 1, At, B1); PG8_BAR;
            PG8_LDB(B0, 1, 0); PG8_SCHED; PG8_LDA(At, 1, 0); PG8_STAGE_A(0, 1, a2);
            PG8_WAIT_L(8); PG8_BAR; PG8_WAIT_L(0); PG8_MMA(0, 0, At, B0); PG8_BAR; PG8_SCHED;
            PG8_LDB(B1, 1, 1); PG8_STAGE_B(1, 0, b3);
            PG8_BAR; PG8_WAIT_L(0); PG8_MMA(0, 1, At, B1); PG8_BAR;
            PG8_LDA(At, 1, 1); PG8_STAGE_A(1, 0, a3);
            PG8_BAR; PG8_WAIT_L(0); PG8_MMA(1, 0, At, B0); PG8_BAR; PG8_SCHED;
            PG8_STAGE_B(1, 1, b3);
            PG8_WAIT_V(6); PG8_BAR; PG8_MMA(1, 1, At, B1); PG8_BAR;
            }
        }
        if constexpr (ALIGN_EPI) { if (wr == 0) PG8_BAR; }
        E(acc, cur, wr, wc, fr, fq);
        if (!has_next) break;
#pragma unroll
        for (int a = 0; a < 2; ++a)
#pragma unroll
            for (int b = 0; b < 2; ++b)
#pragma unroll
                for (int m = 0; m < 4; ++m)
#pragma unroll
                    for (int n = 0; n < 2; ++n) acc[a][b][m][n] = (f32x4){0.f, 0.f, 0.f, 0.f};
        cur = nxt; cA = nA; cB = nB; ++ui;
        if constexpr (ALIGN_EPI) { if (wr == 1) PG8_BAR; }
    }
    PG8_WAIT_V(0);
    if constexpr (!ALIGN_EPI) { if (wr == 0) PG8_BAR; }
    PG8_BAR;
#undef PG8_SA
#undef PG8_SB
#undef PG8_STAGE
#undef PG8_STAGE_A
#undef PG8_STAGE_B
#undef PG8_LOAD_OFFS
#undef PG8_LDA
#undef PG8_LDB
#undef PG8_MMA
#undef PG8_WAIT_V
#undef PG8_WAIT_L
#undef PG8_BAR
#undef PG8_SCHED
}

struct EpiInProj {
    static constexpr bool PERM = true;
    bf16_t* V; bf16_t* GG; bf16_t* UR;
    __device__ __forceinline__ void operator()(const f32x4 (&acc)[2][2][4][2], const Unit& u, int wr, int wc, int fr, int fq) const {
        const int row0 = u.pm * BM + wr * 64 + fr, cl = wc * 32 + 8 * fq;
        if (u.pn < 4) {
#pragma unroll
            for (int ai = 0; ai < 2; ++ai)
#pragma unroll
                for (int m = 0; m < 4; ++m) { float o[8];
#pragma unroll
                    for (int n = 0; n < 2; ++n)
#pragma unroll
                        for (int j = 0; j < 4; ++j) o[4 * n + j] = acc[ai][0][m][n][j] * sigmoidf_(acc[ai][1][m][n][j]);
                    u32x4 w; w.x = cvt_pk_bf16(o[0], o[1]); w.y = cvt_pk_bf16(o[2], o[3]); w.z = cvt_pk_bf16(o[4], o[5]); w.w = cvt_pk_bf16(o[6], o[7]);
                    *(u32x4*)(V + (size_t)(row0 + ai * HALF + m * 16) * 512 + u.pn * 128 + cl) = w; }
        } else {
            const bool gel = u.pn < 6; bf16_t* base = gel ? GG : UR; const int c0 = (gel ? u.pn - 4 : u.pn - 6) * 256 + cl;
#pragma unroll
            for (int ai = 0; ai < 2; ++ai)
#pragma unroll
                for (int m = 0; m < 4; ++m)
#pragma unroll
                    for (int bj = 0; bj < 2; ++bj) { float o[8];
#pragma unroll
                        for (int n = 0; n < 2; ++n)
#pragma unroll
                            for (int j = 0; j < 4; ++j) { const float x = acc[ai][bj][m][n][j];
                                o[4 * n + j] = gel ? x * sigmoidf_(1.5957691216f * (x + 0.044715f * x * x * x)) : x; }
                        u32x4 w; w.x = cvt_pk_bf16(o[0], o[1]); w.y = cvt_pk_bf16(o[2], o[3]); w.z = cvt_pk_bf16(o[4], o[5]); w.w = cvt_pk_bf16(o[6], o[7]);
                        *(u32x4*)(base + (size_t)(row0 + ai * HALF + m * 16) * 512 + c0 + bj * HALF) = w; }
        }
    }
};
struct EpiOutProj {
    static constexpr bool PERM = true;
    const float* X; bf16_t* X1; const float* modf;
    __device__ __forceinline__ void operator()(const f32x4 (&acc)[2][2][4][2], const Unit& u, int wr, int wc, int fr, int fq) const {
        const int row0 = u.pm * BM + wr * 64 + fr, col0 = u.pn * BM + wc * 32 + 8 * fq; const int b = (u.pm * BM) / SEQ;
        f32x4 gv[2][2];
#pragma unroll
        for (int bj = 0; bj < 2; ++bj)
#pragma unroll
            for (int n = 0; n < 2; ++n) gv[bj][n] = *(const f32x4*)(modf + (size_t)b * NMODW + 2 * D + col0 + bj * HALF + n * 4);
#pragma unroll
        for (int ai = 0; ai < 2; ++ai) {
            f32x4 xv[4][2][2];
#pragma unroll
            for (int m = 0; m < 4; ++m)
#pragma unroll
                for (int bj = 0; bj < 2; ++bj) { const float* xp = X + (size_t)(row0 + ai * HALF + m * 16) * D + col0 + bj * HALF; xv[m][bj][0] = *(const f32x4*)(xp); xv[m][bj][1] = *(const f32x4*)(xp + 4); }
#pragma unroll
            for (int m = 0; m < 4; ++m)
#pragma unroll
                for (int bj = 0; bj < 2; ++bj) { const f32x4 v0 = xv[m][bj][0] + gv[bj][0] * acc[ai][bj][m][0], v1 = xv[m][bj][1] + gv[bj][1] * acc[ai][bj][m][1];
                    u32x4 w; w.x = cvt_pk_bf16(v0[0], v0[1]); w.y = cvt_pk_bf16(v0[2], v0[3]); w.z = cvt_pk_bf16(v1[0], v1[1]); w.w = cvt_pk_bf16(v1[2], v1[3]);
                    *(u32x4*)(X1 + (size_t)(row0 + ai * HALF + m * 16) * D + col0 + bj * HALF) = w; }
            asm volatile("" ::: "memory"); }
    }
};
struct EpiSwiglu {
    static constexpr bool PERM = true;
    unsigned char* ACT; const PG8_LAS unsigned char* btab;
    __device__ __forceinline__ void operator()(const f32x4 (&acc)[2][2][4][2], const Unit& u, int wr, int wc, int fr, int fq) const {
        const int row0 = u.pm * BM + wr * 64 + fr, col0 = u.pn * 128 + wc * 32 + 8 * fq;
        const u32x4 bgw = *(const PG8_LAS u32x4*)(btab + u.slot * 512 + (wc * 32 + 8 * fq) * 2), buw = *(const PG8_LAS u32x4*)(btab + u.slot * 512 + 256 + (wc * 32 + 8 * fq) * 2);
        float bg[8], bu[8];
#pragma unroll
        for (int k = 0; k < 4; ++k) { bg[2 * k] = __builtin_bit_cast(float, bgw[k] << 16); bg[2 * k + 1] = __builtin_bit_cast(float, bgw[k] & 0xffff0000u); bu[2 * k] = __builtin_bit_cast(float, buw[k] << 16); bu[2 * k + 1] = __builtin_bit_cast(float, buw[k] & 0xffff0000u); }
#pragma unroll
        for (int ai = 0; ai < 2; ++ai)
#pragma unroll
            for (int m = 0; m < 4; ++m) { float o[8];
#pragma unroll
                for (int n = 0; n < 2; ++n)
#pragma unroll
                    for (int j = 0; j < 4; ++j) { float g = acc[ai][0][m][n][j] * W8_INV + bg[4 * n + j], uu = acc[ai][1][m][n][j] * W8_INV + bu[4 * n + j];
                        g = fminf(g, 7.0f); uu = fminf(fmaxf(uu, -7.0f), 7.0f); o[4 * n + j] = (uu + 1.0f) * (g * sigmoidf_(1.702f * g)); }
                v2u w; w.x = __builtin_amdgcn_cvt_pk_fp8_f32(o[2], o[3], __builtin_amdgcn_cvt_pk_fp8_f32(o[0], o[1], 0, false), true);
                w.y = __builtin_amdgcn_cvt_pk_fp8_f32(o[6], o[7], __builtin_amdgcn_cvt_pk_fp8_f32(o[4], o[5], 0, false), true);
                *(v2u*)(ACT + (size_t)(row0 + ai * HALF + m * 16) * DE + col0) = w; }
    }
};
struct EpiDown {
    static constexpr bool PERM = true;
    unsigned char* Y; const PG8_LAS unsigned char* btab;
    __device__ __forceinline__ void operator()(const f32x4 (&acc)[2][2][4][2], const Unit& u, int wr, int wc, int fr, int fq) const {
        const int row0 = u.pm * BM + wr * 64 + fr, col0 = u.pn * BM + wc * 32 + 8 * fq;
#pragma unroll
        for (int bj = 0; bj < 2; ++bj) { const u32x4 bw = *(const PG8_LAS u32x4*)(btab + u.slot * 512 + bj * 256 + (wc * 32 + 8 * fq) * 2);
            const f32x4 b0 = {__builtin_bit_cast(float, bw[0] << 16), __builtin_bit_cast(float, bw[0] & 0xffff0000u), __builtin_bit_cast(float, bw[1] << 16), __builtin_bit_cast(float, bw[1] & 0xffff0000u)};
            const f32x4 b1 = {__builtin_bit_cast(float, bw[2] << 16), __builtin_bit_cast(float, bw[2] & 0xffff0000u), __builtin_bit_cast(float, bw[3] << 16), __builtin_bit_cast(float, bw[3] & 0xffff0000u)};
#pragma unroll
            for (int ai = 0; ai < 2; ++ai)
#pragma unroll
                for (int m = 0; m < 4; ++m) { const f32x4 v0 = (acc[ai][bj][m][0] * W8_INV + b0) * Y8_SCALE, v1 = (acc[ai][bj][m][1] * W8_INV + b1) * Y8_SCALE;
                    v2u w; w.x = __builtin_amdgcn_cvt_pk_fp8_f32(v0[2], v0[3], __builtin_amdgcn_cvt_pk_fp8_f32(v0[0], v0[1], 0, false), true);
                    w.y = __builtin_amdgcn_cvt_pk_fp8_f32(v1[2], v1[3], __builtin_amdgcn_cvt_pk_fp8_f32(v1[0], v1[1], 0, false), true);
                    *(v2u*)(Y + (size_t)(row0 + ai * HALF + m * 16) * D + col0 + bj * HALF) = w; } }
    }
};
}

#define XB_TMO      128
#define XB_XCNT(j)  (256  + 64 * (j))
#define XB_XSUB(j)  (1280 + 64 * (j))
#define XB_XGEN(j)  (2304 + 64 * (j))
#define XB_TOP      3328
#define XB_TOPGEN   3392
#define XCD_BAR_WORDS 3456
#define XB_SPIN_CAP (1u << 18)
__device__ __forceinline__ unsigned xb_ld(unsigned* p)              { return __hip_atomic_load(p, __ATOMIC_RELAXED, __HIP_MEMORY_SCOPE_AGENT); }
__device__ __forceinline__ unsigned xb_add(unsigned* p, unsigned v) { return __hip_atomic_fetch_add(p, v, __ATOMIC_RELAXED, __HIP_MEMORY_SCOPE_AGENT); }
__device__ __forceinline__ unsigned xb_xcc_id() { return (unsigned)__builtin_amdgcn_s_getreg((3 << 11) | 20) & 0xFu; }
#define XB_SPIN(cond, bar) do { unsigned _sp = 0; while (cond) { __builtin_amdgcn_s_sleep(1); \
    if ((++_sp & 255u) == 0u) { if (xb_ld(&(bar)[XB_TMO])) break; if (_sp > XB_SPIN_CAP) { atomicAdd(&(bar)[XB_TMO], 1u); break; } } } } while (0)
struct XcdBarrier { unsigned* bar; unsigned x; volatile LAS unsigned* st; };
__device__ __forceinline__ XcdBarrier xcd_barrier_post(unsigned* bar, volatile LAS unsigned* st) {
    XcdBarrier b; b.bar = bar; b.x = xb_xcc_id(); b.st = st;
    if (threadIdx.x == 0) (void)xb_add(&bar[XB_XCNT(b.x)], 1u);
    return b;
}
__device__ __forceinline__ void xcd_barrier_complete(unsigned* bar, unsigned x, unsigned& nloc, unsigned& nx) {
    const unsigned G = gridDim.x * gridDim.y * gridDim.z;
    unsigned sum, cnt, mine, sp = 0u;
    for (;;) {
        sum = 0u; cnt = 0u; mine = 0u;
#pragma unroll
        for (unsigned j = 0; j < 16; ++j) { const unsigned c = xb_ld(&bar[XB_XCNT(j)]); sum += c; cnt += (c > 0u) ? 1u : 0u; mine = (j == x) ? c : mine; }
        if (sum == G) break;
        __builtin_amdgcn_s_sleep(1);
        if ((++sp & 255u) == 0u) { if (xb_ld(&bar[XB_TMO])) break; if (sp > XB_SPIN_CAP) { atomicAdd(&bar[XB_TMO], 1u); break; } }
    }
    nloc = mine > 0u ? mine : 1u; nx = cnt > 0u ? cnt : 1u;
}
__device__ __forceinline__ void xcd_barrier(const XcdBarrier& b) {
    asm volatile("s_waitcnt vmcnt(0)" ::: "memory");
    __syncthreads();
    if (threadIdx.x == 0) {
        unsigned* bar = b.bar;
        __builtin_amdgcn_s_waitcnt(0);
        unsigned nloc = b.st[0], nx = b.st[1];
        if (nloc == 0u) { xcd_barrier_complete(bar, b.x, nloc, nx); b.st[0] = nloc; b.st[1] = nx; }
        const unsigned old = xb_add(&bar[XB_XSUB(b.x)], 1u);
        const unsigned gen = old / nloc;
        if (old + 1u == (gen + 1u) * nloc) {
            __builtin_amdgcn_fence(__ATOMIC_RELEASE, "agent");
            asm volatile("s_waitcnt vmcnt(0)" ::: "memory");
            const unsigned og = xb_add(&bar[XB_TOP], 1u);
            const unsigned tg = og / nx;
            if (og + 1u == (tg + 1u) * nx) xb_add(&bar[XB_TOPGEN], 1u);
            else XB_SPIN(xb_ld(&bar[XB_TOPGEN]) == tg, bar);
            __builtin_amdgcn_fence(__ATOMIC_ACQUIRE, "agent");
            xb_add(&bar[XB_XGEN(b.x)], 1u);
            asm volatile("s_waitcnt vmcnt(0)" ::: "memory");
        } else {
            XB_SPIN(xb_ld(&bar[XB_XGEN(b.x)]) == gen, bar);
            __builtin_amdgcn_fence(__ATOMIC_ACQUIRE, "agent");
            asm volatile("s_waitcnt vmcnt(0)" ::: "memory");
        }
    }
    __syncthreads();
}

struct Frame {
    LAS unsigned char* lds;
    volatile LAS unsigned* MISC;
    gu32* ctl;
    int tid, lane, wave, G, bx;
    float* out; unsigned char* ws;
};
struct Args { const float* in[27]; float* out; unsigned char* ws; int ph_lo, ph_hi, li, pad; };
enum { I_X = 0, I_C, I_WADA, I_BADA, I_N1G, I_WIN, I_CONVW, I_CONVB, I_CLNG, I_CLNB, I_LCW, I_LCB, I_LWA, I_LBA, I_LWX, I_LBX, I_LAM, I_MIXG, I_WOUT, I_N2G, I_WR, I_BR, I_WGU, I_BGU, I_WD, I_BD, I_FNG };

__device__ __forceinline__ float wave_sum(float v) {
#pragma unroll
    for (int o = 1; o < 64; o <<= 1) v += __shfl_xor(v, o);
    return v;
}

__device__ __forceinline__ void p0_transpose_item(const float* W, int K, int N, bf16* WT, int drow0, LAS float* scr, int k0, int n0, int lane) {
#pragma unroll 8
    for (int i = 0; i < 32; ++i) { const int kk = 2 * i + (lane >> 5); scr[kk * 33 + (lane & 31)] = W[(size_t)(k0 + kk) * N + n0 + (lane & 31)]; }
    LDS_WAIT(); asm volatile("" ::: "memory");
    const int c = lane & 7;
#pragma unroll
    for (int j = 0; j < 4; ++j) { const int n = (lane >> 3) + 8 * j; const LAS float* s = scr + (8 * c) * 33 + n;
        v4u o; o.x = pk2(s[0 * 33], s[1 * 33]); o.y = pk2(s[2 * 33], s[3 * 33]); o.z = pk2(s[4 * 33], s[5 * 33]); o.w = pk2(s[6 * 33], s[7 * 33]);
        *(GAS v4u*)(WT + (size_t)(drow0 + n) * K + k0 + 8 * c) = o; }
    LDS_WAIT(); asm volatile("" ::: "memory");
}
__device__ __forceinline__ void p0_transpose_item_fp8(const float* W, int K, int N, unsigned char* WT, int drow0, LAS float* scr, int k0, int n0, int lane) {
#pragma unroll 8
    for (int i = 0; i < 32; ++i) { const int kk = 2 * i + (lane >> 5); scr[kk * 33 + (lane & 31)] = W[(size_t)(k0 + kk) * N + n0 + (lane & 31)]; }
    LDS_WAIT(); asm volatile("" ::: "memory");
    const int c = lane & 7;
#pragma unroll
    for (int j = 0; j < 4; ++j) { const int n = (lane >> 3) + 8 * j; const LAS float* s = scr + (8 * c) * 33 + n;
        v2u o; o.x = __builtin_amdgcn_cvt_pk_fp8_f32(s[2 * 33] * W8_SCALE, s[3 * 33] * W8_SCALE, __builtin_amdgcn_cvt_pk_fp8_f32(s[0 * 33] * W8_SCALE, s[1 * 33] * W8_SCALE, 0, false), true);
        o.y = __builtin_amdgcn_cvt_pk_fp8_f32(s[6 * 33] * W8_SCALE, s[7 * 33] * W8_SCALE, __builtin_amdgcn_cvt_pk_fp8_f32(s[4 * 33] * W8_SCALE, s[5 * 33] * W8_SCALE, 0, false), true);
        *(GAS v2u*)(WT + (size_t)(drow0 + n) * K + k0 + 8 * c) = o; }
    LDS_WAIT(); asm volatile("" ::: "memory");
}
__device__ __forceinline__ void p0_router_item(const float* W, bf16* WH, bf16* WL, LAS float* scr, int k0, int lane) {
#pragma unroll 8
    for (int i = 0; i < 32; ++i) { const int kk = 2 * i + (lane >> 5); scr[kk * 33 + (lane & 31)] = W[(size_t)(k0 + kk) * NE + (lane & 31)]; }
    LDS_WAIT(); asm volatile("" ::: "memory");
    const int c = lane & 7;
#pragma unroll
    for (int j = 0; j < 4; ++j) { const int n = (lane >> 3) + 8 * j; const LAS float* s = scr + (8 * c) * 33 + n;
        float v[8]; unsigned h[8], l[8];
#pragma unroll
        for (int e = 0; e < 8; ++e) { v[e] = s[e * 33]; h[e] = f2bf(v[e]); l[e] = f2bf(v[e] - bf2f(h[e])); }
        v4u oh, ol; oh.x = h[0] | (h[1] << 16); oh.y = h[2] | (h[3] << 16); oh.z = h[4] | (h[5] << 16); oh.w = h[6] | (h[7] << 16);
        ol.x = l[0] | (l[1] << 16); ol.y = l[2] | (l[3] << 16); ol.z = l[4] | (l[5] << 16); ol.w = l[6] | (l[7] << 16);
        *(GAS v4u*)(WH + (size_t)n * D + k0 + 8 * c) = oh; *(GAS v4u*)(WL + (size_t)n * D + k0 + 8 * c) = ol; }
    LDS_WAIT(); asm volatile("" ::: "memory");
}
__device__ __forceinline__ void p0_mod_item(Frame& F, const Args& args, LAS float* scr, int item) {
    const int cg = item % 96, ks = item / 96, col = cg * 64 + F.lane, k0 = ks * 256;
    const float* c = args.in[I_C]; const float* W = args.in[I_WADA];
#pragma unroll 4
    for (int i = 0; i < 32; ++i) { const int idx = i * 64 + F.lane, b = idx >> 8, kk = idx & 255; const float v = c[b * D + k0 + kk]; scr[idx] = v / (1.0f + __expf(-v)); }
    LDS_WAIT(); asm volatile("" ::: "memory");
    float acc[8];
#pragma unroll
    for (int b = 0; b < 8; ++b) acc[b] = 0.f;
#pragma unroll 4
    for (int kk = 0; kk < 256; kk += 4) {
        const float* wp = W + (size_t)(k0 + kk) * NMODW + col;
        const float w0 = wp[0], w1 = wp[NMODW], w2 = wp[2 * NMODW], w3 = wp[3 * NMODW];
#pragma unroll
        for (int b = 0; b < 8; ++b) { const f32x4 cv = *(const LAS f32x4*)(scr + b * 256 + kk); acc[b] += (cv.x * w0 + cv.y * w1) + (cv.z * w2 + cv.w * w3); }
    }
    float* mp = (float*)(F.ws + WS_MODP);
#pragma unroll
    for (int b = 0; b < 8; ++b) mp[(size_t)(ks * 8 + b) * NMODW + col] = acc[b];
    LDS_WAIT(); asm volatile("" ::: "memory");
}
__device__ __forceinline__ void p0_lrufrag_item(const Args& args, unsigned char* ws, int h, int lane) {
    const int j = lane & 15, q = lane >> 4;
#pragma unroll 1
    for (int f = 0; f < 16; ++f) { const int mat = f >> 3, n = (f >> 1) & 3, s = f & 1;
        const float* p = (mat ? args.in[14] : args.in[12]) + (size_t)(h * 64 + 32 * s + 8 * q) * 64 + 16 * n + j;
        v4u o; o.x = pk2(p[0], p[64]); o.y = pk2(p[128], p[192]); o.z = pk2(p[256], p[320]); o.w = pk2(p[384], p[448]);
        *((GAS v4u*)(ws + WS_LRUB) + (size_t)((h * 2 + mat) * 8 + n * 2 + s) * 64 + lane) = o; }
}
__device__ __forceinline__ int glu_row(int n, int half) {
    return n < half ? 256 * (n >> 7) + (n & 127) : 256 * ((n - half) >> 7) + 128 + ((n - half) & 127);
}
__device__ __forceinline__ void p0_prologue(Frame& F, const Args& args) {
    LAS float* scr = (LAS float*)(F.lds + F.wave * 16384);
    const int gw = F.bx * NWAVES + F.wave, NGW = F.G * NWAVES;
    if (gw >= NGW - 8) p0_lrufrag_item(args, F.ws, gw - (NGW - 8), F.lane);
    constexpr int I_MOD = 96 * 4, I_RT = 16, I_IN = 16 * 64, I_OUT = 16 * 32, I_GU = 32 * 16 * 64, I_DN = 32 * 16 * 32;
    constexpr int NITEMS = I_MOD + I_RT + I_IN + I_OUT + I_GU + I_DN;
    for (int it = gw; it < NITEMS; it += NGW) {
        int r = it;
        if (r < I_MOD) { p0_mod_item(F, args, scr, r); continue; } r -= I_MOD;
        if (r < I_RT) { p0_router_item(args.in[I_WR], (bf16*)(F.ws + WS_WRH), (bf16*)(F.ws + WS_WRL), scr, 64 * r, F.lane); continue; } r -= I_RT;
        if (r < I_IN) { const int kb = r >> 6, nb = r & 63, n0 = 32 * nb; const int dr = n0 < 1024 ? glu_row(n0, 512) : n0;
            p0_transpose_item(args.in[I_WIN], D, 2048, (bf16*)(F.ws + WS_WIN), dr, scr, 64 * kb, n0, F.lane); continue; } r -= I_IN;
        if (r < I_OUT) { const int kb = r >> 5, nb = r & 31; p0_transpose_item(args.in[I_WOUT], D, D, (bf16*)(F.ws + WS_WOUT), 32 * nb, scr, 64 * kb, 32 * nb, F.lane); continue; } r -= I_OUT;
        if (r < I_GU) { const int e = r >> 10, q = r & 1023, kb = q >> 6, nb = q & 63, n0 = 32 * nb;
            p0_transpose_item_fp8(args.in[I_WGU] + (size_t)e * D * 2048, D, 2048, F.ws + WS_WGU + (size_t)e * 2048 * D, glu_row(n0, 1024), scr, 64 * kb, n0, F.lane); continue; } r -= I_GU;
        { const int e = r >> 9, q = r & 511, kb = q >> 5, nb = q & 31;
            p0_transpose_item_fp8(args.in[I_WD] + (size_t)e * DE * D, DE, D, F.ws + WS_WD + (size_t)e * D * DE, 32 * nb, scr, 64 * kb, 32 * nb, F.lane); }
    }
}
__device__ __forceinline__ float mod_from_parts(const float* mp, const float* bada, int b, int j) {
    return bada[j] + ((mp[(size_t)(0 * 8 + b) * NMODW + j] + mp[(size_t)(1 * 8 + b) * NMODW + j]) + (mp[(size_t)(2 * 8 + b) * NMODW + j] + mp[(size_t)(3 * 8 + b) * NMODW + j]));
}
__device__ __forceinline__ void p1_norm1(Frame& F, const Args& args) {
    const float* mp = (const float*)(F.ws + WS_MODP); const float* bada = args.in[I_BADA]; float* mf = (float*)(F.ws + WS_MODF);
    for (int idx = F.bx * 512 + F.tid; idx < NB * NMODW; idx += F.G * 512) { const int b = idx / NMODW, j = idx - b * NMODW; mf[idx] = mod_from_parts(mp, bada, b, j); }
    const float* x = args.in[I_X]; const float* g1 = args.in[I_N1G]; bf16* H = (bf16*)(F.ws + WS_H);
    for (int rb = F.bx; rb < T / 128; rb += F.G) {
        const int b = rb >> 5;
        f32x4 A1[4], B1[4];
#pragma unroll
        for (int i = 0; i < 4; ++i)
#pragma unroll
            for (int e = 0; e < 4; ++e) { const int k = 256 * i + 4 * F.lane + e; A1[i][e] = g1[k] * (1.0f + mod_from_parts(mp, bada, b, D + k)); B1[i][e] = mod_from_parts(mp, bada, b, k); }
        for (int r = F.wave; r < 128; r += NWAVES) {
            const size_t row = (size_t)rb * 128 + r;
            const GAS f32x4* xr = (const GAS f32x4*)(x + row * D) + F.lane;
            f32x4 v[4]; float s = 0.f;
#pragma unroll
            for (int i = 0; i < 4; ++i) { v[i] = xr[64 * i]; s += (v[i].x * v[i].x + v[i].y * v[i].y) + (v[i].z * v[i].z + v[i].w * v[i].w); }
            const float rstd = rsqrtf(wave_sum(s) * (1.0f / D) + EPS);
            GAS v2u* o8 = (GAS v2u*)(H + row * D) + F.lane;
#pragma unroll
            for (int i = 0; i < 4; ++i) { const f32x4 h = v[i] * rstd * A1[i] + B1[i]; v2u w; w.x = pk2(h.x, h.y); w.y = pk2(h.z, h.w); o8[64 * i] = w; }
        }
    }
}

template <int N, int OFF> struct TRed {
    template <int M> static __device__ __forceinline__ void run(float (&v)[M], int lane) {
        constexpr int half = N / 2; const bool up = (lane & OFF) != 0;
#pragma unroll
        for (int i = 0; i < half; ++i) { const float send = up ? v[i] : v[i + half]; const float keep = up ? v[i + half] : v[i]; v[i] = keep + __shfl_xor(send, OFF); }
        if constexpr (half > 1) TRed<half, OFF / 2>::run(v, lane);
    }
};
template <int N> __device__ __forceinline__ float treduce(float (&v)[N], int lane) {
    TRed<N, 32>::run(v, lane);
    if (N == 32) v[0] += __shfl_xor(v[0], 1);
    return v[0];
}

__device__ __forceinline__ void conv_unit(Frame& F, const Args& args, int u) {
    const int t0 = 64 * u; const bool first = (t0 & (SEQ - 1)) == 0;
    LAS unsigned char* tile = F.lds;
    LAS float* RED = (LAS float*)(F.lds + 98304);
    LAS f32x2* ST = (LAS f32x2*)(F.lds + 98304 + 2048);
    LAS float* RED2 = (LAS float*)(F.lds + 98304 + 4096);
    LAS float* ST2 = (LAS float*)(F.lds + 98304 + 6144);
    const bf16* V = (const bf16*)(F.ws + WS_V);
    for (int p = F.tid; p < 94 * 64; p += 512) { const int row = p >> 6, c16 = p & 63;
        v4u val = (v4u){0u, 0u, 0u, 0u};
        if (!(first && row < 30)) val = *(const GAS v4u*)(V + (size_t)(t0 - 30 + row) * DC + c16 * 8);
        *(LAS v4u*)(tile + row * 1024 + c16 * 16) = val; }
    __syncthreads();
    int otid = F.tid; asm volatile("" : "+v"(otid));
    const int cp = otid & 255, th = otid >> 8, wq = F.wave & 3;
    f32x2 wv[31];
    { const float* cw = args.in[I_CONVW] + 2 * cp;
#pragma unroll
      for (int k = 0; k < 31; ++k) wv[k] = *(const f32x2*)(cw + k * DC); }
    const f32x2 cb = *(const f32x2*)(args.in[I_CONVB] + 2 * cp);
    float o0[32], o1[32];
#pragma unroll
    for (int g = 0; g < 4; ++g) {
        f32x2 av[8];
#pragma unroll
        for (int j = 0; j < 8; ++j) av[j] = cb;
        const LAS unsigned char* tp = tile + (32 * th + 8 * g) * 1024 + cp * 4;
#pragma unroll
        for (int i = 0; i < 38; ++i) { const unsigned xw = *(const LAS unsigned*)(tp + i * 1024); const f32x2 xx = {bflo(xw), bfhi(xw)};
#pragma unroll
            for (int j = 0; j < 8; ++j) { const int k = i - j; if (k >= 0 && k <= 30) av[j] = __builtin_elementwise_fma(wv[k], xx, av[j]); } }
#pragma unroll
        for (int j = 0; j < 8; ++j) { o0[8 * g + j] = av[j].x; o1[8 * g + j] = av[j].y; }
    }
    { float vals[64];
#pragma unroll
      for (int t = 0; t < 32; ++t) { vals[t] = o0[t] + o1[t]; vals[32 + t] = o0[t] * o0[t] + o1[t] * o1[t]; }
      const float r = treduce<64>(vals, F.lane);
      RED[(th * 4 + wq) * 64 + F.lane] = r; }
    __syncthreads();
    if (F.tid < 64) { const int hh = F.tid >> 5, tk = F.tid & 31; float s1 = 0.f, s2 = 0.f;
#pragma unroll
        for (int w = 0; w < 4; ++w) { s1 += RED[(hh * 4 + w) * 64 + tk]; s2 += RED[(hh * 4 + w) * 64 + 32 + tk]; }
        const float mean = s1 * (1.0f / DC); const float var = fmaxf(s2 * (1.0f / DC) - mean * mean, 0.f);
        ST[F.tid] = (f32x2){mean, rsqrtf(var + EPS)}; }
    __syncthreads();
    const f32x2 lg = *(const f32x2*)(args.in[I_CLNG] + 2 * cp), lb = *(const f32x2*)(args.in[I_CLNB] + 2 * cp);
    { float vals[32];
#pragma unroll
      for (int t = 0; t < 32; ++t) { const f32x2 st = ST[th * 32 + t];
          const float y0 = (o0[t] - st.x) * st.y * lg.x + lb.x, y1 = (o1[t] - st.x) * st.y * lg.y + lb.y;
          o0[t] = y0 * sigmoidf_(y0); o1[t] = y1 * sigmoidf_(y1); vals[t] = o0[t] * o0[t] + o1[t] * o1[t]; }
      const float r = treduce<32>(vals, F.lane);
      if ((F.lane & 1) == 0) RED2[(th * 4 + wq) * 32 + (F.lane >> 1)] = r; }
    __syncthreads();
    if (F.tid < 64) { const int hh = F.tid >> 5, tk = F.tid & 31; float s = 0.f;
#pragma unroll
        for (int w = 0; w < 4; ++w) s += RED2[(hh * 4 + w) * 32 + tk];
        ST2[F.tid] = rsqrtf(s * (1.0f / DC) + EPS); }
    __syncthreads();
    const f32x2 mg = *(const f32x2*)(args.in[I_MIXG] + 2 * cp);
    bf16* YA = (bf16*)(F.ws + WS_H);
#pragma unroll
    for (int t = 0; t < 32; ++t) { const float rs = ST2[th * 32 + t];
        *(GAS unsigned*)(YA + (size_t)(t0 + 32 * th + t) * D + 2 * cp) = pk2(o0[t] * rs * mg.x, o1[t] * rs * mg.y); }
}

constexpr int LRU_WB = 12032;
__device__ __forceinline__ void lru_unit(Frame& F, const Args& args, int ck) {
    int lane = F.lane; asm volatile("" : "+v"(lane));
    const int h = F.wave, j = lane & 15, q = lane >> 4;
    const int cs = ck & 31, t0 = ck * 128;
    LAS unsigned char* wl = F.lds + h * LRU_WB;
    LAS unsigned char* xt = wl + 35 * 144;
    LAS unsigned char* pr = xt + 16 * 144;
    const bf16* UREC = (const bf16*)(F.ws + WS_UREC);
    float* SUMA = (float*)(F.ws + WS_SUMA); float* SUMH = (float*)(F.ws + WS_SUMH);
    LAS float* cst = (LAS float*)(F.lds + 8 * LRU_WB) + h * 512;
    { const int c = 64 * h + lane;
#pragma unroll
      for (int k = 0; k < 4; ++k) cst[k * 64 + lane] = args.in[I_LCW][k * 512 + c];
      cst[4 * 64 + lane] = args.in[I_LCB][c]; cst[5 * 64 + lane] = args.in[I_LBA][c]; cst[6 * 64 + lane] = args.in[I_LBX][c];
      const float z = -args.in[I_LAM][c]; cst[7 * 64 + lane] = fmaxf(z, 0.f) + log1pf(__expf(-fabsf(z))); }
    bf16x8 Ba[4][2], Bx[4][2];
    const unsigned l16 = (unsigned)lane * 16u;
#pragma unroll
    for (int n = 0; n < 4; ++n)
#pragma unroll
        for (int s = 0; s < 2; ++s) { const GAS unsigned char* fb = (const GAS unsigned char*)(F.ws + WS_LRUB) + (size_t)h * 16384 + (n * 2 + s) * 1024;
            Ba[n][s] = *(const GAS bf16x8*)(fb + l16); Bx[n][s] = *(const GAS bf16x8*)(fb + 8192 + l16); }
    float hc[4], Pt[4];
#pragma unroll
    for (int n = 0; n < 4; ++n) { hc[n] = 0.f; Pt[n] = 1.f; }
    const bool qodd = (q & 1) != 0, qhi = q >= 2;
    for (int sc = 0; sc < 4; ++sc) {
        const int ts = t0 + 32 * sc;
        const unsigned lrow = (unsigned)(lane >> 3) * 1024u + (unsigned)h * 128u + (unsigned)(lane & 7) * 16u;
#pragma unroll
        for (int i = 0; i < 5; ++i) { const int p = lane + 64 * i;
            if (p < 280) { const int row = p >> 3, c8 = p & 7; v4u val = (v4u){0u, 0u, 0u, 0u};
                if (!(cs == 0 && sc == 0 && row < 3)) { const GAS unsigned char* ub = (const GAS unsigned char*)UREC + (size_t)(ts - 3 + 8 * i) * 1024; val = *(const GAS v4u*)(ub + lrow); }
                *(LAS v4u*)(wl + row * 144 + c8 * 16) = val; } }
#pragma unroll 1
        for (int tile = 0; tile < 2; ++tile) {
            float xr[4][4];
#pragma unroll
            for (int n = 0; n < 4; ++n) { float uu[7];
#pragma unroll
                for (int m = 0; m < 7; ++m) uu[m] = bf2f(*(const LAS unsigned short*)(wl + (16 * tile + 4 * q + m) * 144 + (16 * n + j) * 2));
                const float c0 = cst[16 * n + j], c1 = cst[64 + 16 * n + j], c2 = cst[128 + 16 * n + j], c3 = cst[192 + 16 * n + j], cbn = cst[256 + 16 * n + j];
#pragma unroll
                for (int r = 0; r < 4; ++r) xr[n][r] = cbn + ((c0 * uu[r] + c1 * uu[r + 1]) + (c2 * uu[r + 2] + c3 * uu[r + 3])); }
#pragma unroll
            for (int n = 0; n < 4; ++n)
#pragma unroll
                for (int r = 0; r < 4; ++r) *(LAS unsigned short*)(xt + (4 * q + r) * 144 + (16 * n + j) * 2) = (unsigned short)f2bf(xr[n][r]);
            const bf16x8 a0 = *(const LAS bf16x8*)(xt + j * 144 + 16 * q), a1 = *(const LAS bf16x8*)(xt + j * 144 + 64 + 16 * q);
            f32x4 za[4], zx[4];
#pragma unroll
            for (int n = 0; n < 4; ++n) {
                za[n] = (f32x4){0.f, 0.f, 0.f, 0.f}; zx[n] = (f32x4){0.f, 0.f, 0.f, 0.f};
                za[n] = __builtin_amdgcn_mfma_f32_16x16x32_bf16(a0, Ba[n][0], za[n], 0, 0, 0); za[n] = __builtin_amdgcn_mfma_f32_16x16x32_bf16(a1, Ba[n][1], za[n], 0, 0, 0);
                zx[n] = __builtin_amdgcn_mfma_f32_16x16x32_bf16(a0, Bx[n][0], zx[n], 0, 0, 0); zx[n] = __builtin_amdgcn_mfma_f32_16x16x32_bf16(a1, Bx[n][1], zx[n], 0, 0, 0); }
#pragma unroll
            for (int n = 0; n < 4; ++n) {
                float pp[4], hh[4];
                const float ban = cst[320 + 16 * n + j], bxn = cst[384 + 16 * n + j], spn = cst[448 + 16 * n + j];
#pragma unroll
                for (int r = 0; r < 4; ++r) { const float rg = sigmoidf_(za[n][r] + ban), ig = sigmoidf_(zx[n][r] + bxn);
                    const float la = -8.0f * rg * spn; const float a = __expf(la); const float mult = __builtin_amdgcn_sqrtf(fmaxf(1.0f - a * a, 0.f)); const float inp = mult * (ig * xr[n][r]);
                    if (r == 0) { pp[0] = a; hh[0] = inp; } else { pp[r] = a * pp[r - 1]; hh[r] = a * hh[r - 1] + inp; } }
                const float P = pp[3], H = hh[3];
                float Pn, Hn;
                { const auto rp = __builtin_amdgcn_permlane16_swap(__builtin_bit_cast(unsigned, P), __builtin_bit_cast(unsigned, P), false, false);
                  const auto rh = __builtin_amdgcn_permlane16_swap(__builtin_bit_cast(unsigned, H), __builtin_bit_cast(unsigned, H), false, false);
                  Pn = __builtin_bit_cast(float, qodd ? rp[0] : rp[1]); Hn = __builtin_bit_cast(float, qodd ? rh[0] : rh[1]); }
                const float Ptp = P * Pn, Htp = qodd ? (P * Hn + H) : (Pn * H + Hn);
                float Po, Ho;
                { const auto rp = __builtin_amdgcn_permlane32_swap(__builtin_bit_cast(unsigned, Ptp), __builtin_bit_cast(unsigned, Ptp), false, false);
                  const auto rh = __builtin_amdgcn_permlane32_swap(__builtin_bit_cast(unsigned, Htp), __builtin_bit_cast(unsigned, Htp), false, false);
                  Po = __builtin_bit_cast(float, qhi ? rp[0] : rp[1]); Ho = __builtin_bit_cast(float, qhi ? rh[0] : rh[1]); }
                float Pe = qodd ? Pn : 1.0f, He = qodd ? Hn : 0.0f;
                if (qhi) { He = Pe * Ho + He; Pe = Pe * Po; }
                const float Ptl = Ptp * Po, Htl = qhi ? (Ptp * Ho + Htp) : (Po * Htp + Ho);
                const float hq = Pe * hc[n] + He, pq = Pt[n] * Pe;
#pragma unroll
                for (int r = 0; r < 4; ++r) { *(LAS unsigned short*)(wl + (16 * tile + 4 * q + r) * 144 + (16 * n + j) * 2) = (unsigned short)f2bf(pp[r] * hq + hh[r]);
                    *(LAS unsigned short*)(pr + (16 * tile + 4 * q + r) * 144 + (16 * n + j) * 2) = (unsigned short)f2bf(pq * pp[r]); }
                hc[n] = Ptl * hc[n] + Htl; Pt[n] *= Ptl;
            }
        }
#pragma unroll
        for (int i = 0; i < 4; ++i) { const int tk = (lane >> 3) + 8 * i; const v4u hw = *(const LAS v4u*)(wl + tk * 144 + 16 * (lane & 7)), pw = *(const LAS v4u*)(pr + tk * 144 + 16 * (lane & 7));
            GAS unsigned char* hb = (GAS unsigned char*)(F.ws + WS_HLOC) + (size_t)(ts + 8 * i) * 1024; GAS unsigned char* pb = (GAS unsigned char*)(F.ws + WS_PCUM) + (size_t)(ts + 8 * i) * 1024;
            *(GAS v4u*)(hb + lrow) = hw; *(GAS v4u*)(pb + lrow) = pw; }
    }
    { const float pv = q == 0 ? Pt[0] : q == 1 ? Pt[1] : q == 2 ? Pt[2] : Pt[3];
      const float hv = q == 0 ? hc[0] : q == 1 ? hc[1] : q == 2 ? hc[2] : hc[3];
      SUMA[(size_t)ck * 512 + 64 * h + lane] = pv; SUMH[(size_t)ck * 512 + 64 * h + lane] = hv; }
}
__device__ __forceinline__ void p4_lru_apply(Frame& F, const Args& args) {
    const int lane = F.lane;
    const float* SUMA = (const float*)(F.ws + WS_SUMA); const float* SUMH = (const float*)(F.ws + WS_SUMH);
    bf16* YA = (bf16*)(F.ws + WS_H);
    for (int ck = F.bx; ck < T / 128; ck += F.G) {
        const int b = ck >> 5, cs = ck & 31;
        float hin[8], mg[8];
#pragma unroll
        for (int e = 0; e < 8; ++e) hin[e] = 0.f;
        for (int c2 = 0; c2 < cs; ++c2) { const size_t o = (size_t)(b * 32 + c2) * 512 + 8 * lane;
            const f32x4 a0 = *(const f32x4*)(SUMA + o), a1 = *(const f32x4*)(SUMA + o + 4), h0 = *(const f32x4*)(SUMH + o), h1 = *(const f32x4*)(SUMH + o + 4);
#pragma unroll
            for (int e = 0; e < 4; ++e) { hin[e] = a0[e] * hin[e] + h0[e]; hin[4 + e] = a1[e] * hin[4 + e] + h1[e]; } }
        { const f32x4 m0 = *(const f32x4*)(args.in[I_MIXG] + 512 + 8 * lane), m1 = *(const f32x4*)(args.in[I_MIXG] + 512 + 8 * lane + 4);
#pragma unroll
          for (int e = 0; e < 4; ++e) { mg[e] = m0[e]; mg[4 + e] = m1[e]; } }
        for (int r = F.wave; r < 128; r += NWAVES) {
            const size_t t = (size_t)ck * 128 + r;
            const v4u hw = *((const GAS v4u*)(F.ws + WS_HLOC + t * 1024) + lane), pw = *((const GAS v4u*)(F.ws + WS_PCUM + t * 1024) + lane), gw = *((const GAS v4u*)(F.ws + WS_GG + t * 1024) + lane);
            float y[8];
            y[0] = bflo(gw.x) * (bflo(hw.x) + bflo(pw.x) * hin[0]); y[1] = bfhi(gw.x) * (bfhi(hw.x) + bfhi(pw.x) * hin[1]);
            y[2] = bflo(gw.y) * (bflo(hw.y) + bflo(pw.y) * hin[2]); y[3] = bfhi(gw.y) * (bfhi(hw.y) + bfhi(pw.y) * hin[3]);
            y[4] = bflo(gw.z) * (bflo(hw.z) + bflo(pw.z) * hin[4]); y[5] = bfhi(gw.z) * (bfhi(hw.z) + bfhi(pw.z) * hin[5]);
            y[6] = bflo(gw.w) * (bflo(hw.w) + bflo(pw.w) * hin[6]); y[7] = bfhi(gw.w) * (bfhi(hw.w) + bfhi(pw.w) * hin[7]);
            float s = 0.f;
#pragma unroll
            for (int e = 0; e < 8; ++e) s += y[e] * y[e];
            const float rs = rsqrtf(wave_sum(s) * (1.0f / 512.0f) + EPS);
            v4u w; w.x = pk2(y[0] * rs * mg[0], y[1] * rs * mg[1]); w.y = pk2(y[2] * rs * mg[2], y[3] * rs * mg[3]);
            w.z = pk2(y[4] * rs * mg[4], y[5] * rs * mg[5]); w.w = pk2(y[6] * rs * mg[6], y[7] * rs * mg[7]);
            *((GAS v4u*)(YA + t * D + 512) + lane) = w;
        }
    }
}

__device__ __forceinline__ void p6_router(Frame& F, const Args& args) {
    constexpr int RS = 2064;
    LAS unsigned char* HI = F.lds; LAS unsigned char* LO = F.lds + 16 * RS;
    LAS float* PLOG = (LAS float*)(F.lds + 32 * RS);
    LAS int* SEL = (LAS int*)(F.lds + 32 * RS + 16384);
    LAS int* CNTW = (LAS int*)(F.lds + 32 * RS + 16384 + 2048);
    const bf16* X1 = (const bf16*)(F.ws + WS_X1); unsigned char* H2 = F.ws + WS_H; const float* mf = (const float*)(F.ws + WS_MODF);
    const bf16* WRH = (const bf16*)(F.ws + WS_WRH); const bf16* WRL = (const bf16*)(F.ws + WS_WRL);
    int* TOPI = (int*)(F.ws + WS_TOPI); float* TOPG = (float*)(F.ws + WS_TOPG); int* LRANK = (int*)(F.ws + WS_LRANK); int* BCNT = (int*)(F.ws + WS_BCNT);
    const int lane = F.lane, w = F.wave, j = lane & 15, q = lane >> 4;
    for (int rb = F.bx; rb < T / 128; rb += F.G) {
        const int b = rb >> 5;
        f32x4 A2[4], B2[4];
#pragma unroll
        for (int i = 0; i < 4; ++i) { const int k = 256 * i + 4 * lane; const f32x4 g = *(const f32x4*)(args.in[I_N2G] + k), sc = *(const f32x4*)(mf + (size_t)b * NMODW + 4 * D + k);
            A2[i] = g * (sc + 1.0f); B2[i] = *(const f32x4*)(mf + (size_t)b * NMODW + 3 * D + k); }
        bf16x8 bh[4][2], bl[4][2];
#pragma unroll
        for (int s = 0; s < 4; ++s)
#pragma unroll
            for (int n = 0; n < 2; ++n) { const size_t o = (size_t)(16 * n + j) * D + 128 * w + 32 * s + 8 * q; bh[s][n] = *(const GAS bf16x8*)(WRH + o); bl[s][n] = *(const GAS bf16x8*)(WRL + o); }
        v2u xb[2][4];
#pragma unroll
        for (int rr = 0; rr < 2; ++rr)
#pragma unroll
            for (int i = 0; i < 4; ++i) xb[rr][i] = *((const GAS v2u*)(X1 + ((size_t)rb * 128 + 2 * w + rr) * D) + lane + 64 * i);
        for (int tile = 0; tile < 8; ++tile) {
#pragma unroll
            for (int rr = 0; rr < 2; ++rr) { const int r = 2 * w + rr; const size_t t = (size_t)rb * 128 + 16 * tile + r;
                float s = 0.f; f32x4 xv[4];
#pragma unroll
                for (int i = 0; i < 4; ++i) { xv[i] = (f32x4){bflo(xb[rr][i].x), bfhi(xb[rr][i].x), bflo(xb[rr][i].y), bfhi(xb[rr][i].y)}; s += (xv[i].x * xv[i].x + xv[i].y * xv[i].y) + (xv[i].z * xv[i].z + xv[i].w * xv[i].w); }
                const float rstd = rsqrtf(wave_sum(s) * (1.0f / D) + EPS);
#pragma unroll
                for (int i = 0; i < 4; ++i) { const f32x4 hv = xv[i] * rstd * A2[i] + B2[i];
                    unsigned hb[4], lb[4];
#pragma unroll
                    for (int e = 0; e < 4; ++e) { hb[e] = f2bf(hv[e]); lb[e] = f2bf(hv[e] - bf2f(hb[e])); }
                    v2u wh, wl2; wh.x = hb[0] | (hb[1] << 16); wh.y = hb[2] | (hb[3] << 16); wl2.x = lb[0] | (lb[1] << 16); wl2.y = lb[2] | (lb[3] << 16);
                    *((GAS unsigned*)(H2 + t * D) + lane + 64 * i) = __builtin_amdgcn_cvt_pk_fp8_f32(hv[2], hv[3], __builtin_amdgcn_cvt_pk_fp8_f32(hv[0], hv[1], 0, false), true);
                    *(LAS v2u*)(HI + r * RS + (4 * lane + 256 * i) * 2) = wh; *(LAS v2u*)(LO + r * RS + (4 * lane + 256 * i) * 2) = wl2; }
            }
            if (tile < 7) {
#pragma unroll
                for (int rr = 0; rr < 2; ++rr)
#pragma unroll
                    for (int i = 0; i < 4; ++i) xb[rr][i] = *((const GAS v2u*)(X1 + ((size_t)rb * 128 + 16 * (tile + 1) + 2 * w + rr) * D) + lane + 64 * i);
            }
            __syncthreads();
            f32x4 acc[2]; acc[0] = (f32x4){0.f, 0.f, 0.f, 0.f}; acc[1] = acc[0];
#pragma unroll
            for (int s = 0; s < 4; ++s) { const int ko = (128 * w + 32 * s + 8 * q) * 2;
                const bf16x8 ah = *(const LAS bf16x8*)(HI + j * RS + ko), al = *(const LAS bf16x8*)(LO + j * RS + ko);
#pragma unroll
                for (int n = 0; n < 2; ++n) { acc[n] = __builtin_amdgcn_mfma_f32_16x16x32_bf16(ah, bh[s][n], acc[n], 0, 0, 0);
                    acc[n] = __builtin_amdgcn_mfma_f32_16x16x32_bf16(ah, bl[s][n], acc[n], 0, 0, 0); acc[n] = __builtin_amdgcn_mfma_f32_16x16x32_bf16(al, bh[s][n], acc[n], 0, 0, 0); } }
#pragma unroll
            for (int n = 0; n < 2; ++n)
#pragma unroll
                for (int r = 0; r < 4; ++r) PLOG[(w * 16 + 4 * q + r) * 32 + 16 * n + j] = acc[n][r];
            __syncthreads();
            { const int tk = F.tid >> 5, e = F.tid & 31;
              float lg = args.in[I_BR][e];
#pragma unroll
              for (int w2 = 0; w2 < 8; ++w2) lg += PLOG[(w2 * 16 + tk) * 32 + e];
              float tv[4]; int ti[4]; float v = lg;
#pragma unroll
              for (int k = 0; k < 4; ++k) { float bv = v; int bi = e;
#pragma unroll
                  for (int off = 1; off < 32; off <<= 1) { const float ov = __shfl_xor(bv, off); const int oi = __shfl_xor(bi, off); if (ov > bv || (ov == bv && oi < bi)) { bv = ov; bi = oi; } }
                  tv[k] = bv; ti[k] = bi; if (e == bi) v = -3.0e38f; }
              const float e1 = __expf(tv[1] - tv[0]), e2 = __expf(tv[2] - tv[0]), e3 = __expf(tv[3] - tv[0]); const float inv = 1.0f / (1.0f + e1 + e2 + e3);
              if (e < 4) { const float gk = (e == 0 ? 1.0f : e == 1 ? e1 : e == 2 ? e2 : e3) * inv; const int ik = e == 0 ? ti[0] : e == 1 ? ti[1] : e == 2 ? ti[2] : ti[3];
                  const size_t t = (size_t)rb * 128 + 16 * tile + tk; TOPI[t * 4 + e] = ik; TOPG[t * 4 + e] = gk; SEL[(16 * tile + tk) * 4 + e] = ik; } }
        }
        __syncthreads();
        { const int myE = SEL[F.tid]; int rk = 0, cm = 0;
#pragma unroll 1
          for (int e = 0; e < 32; ++e) { const unsigned long long m = __ballot(myE == e); if (myE == e) rk = __popcll(m & ((1ull << lane) - 1ull)); if (lane == e) cm = __popcll(m); }
          if (lane < 32) CNTW[w * 32 + lane] = cm;
          __syncthreads();
          int base = 0;
          for (int w2 = 0; w2 < w; ++w2) base += CNTW[w2 * 32 + myE];
          LRANK[(size_t)rb * 512 + F.tid] = base + rk;
          if (F.tid < 32) { int tot = 0;
#pragma unroll
              for (int w2 = 0; w2 < 8; ++w2) tot += CNTW[w2 * 32 + F.tid];
              BCNT[rb * 32 + F.tid] = tot; } }
        __syncthreads();
    }
}
__device__ __forceinline__ void p7_positions(Frame& F) {
    LAS int* PT = (LAS int*)F.lds; LAS int* PB = PT + 512; LAS int* TOT = PB + 512; LAS int* BEF = TOT + 32; LAS int* PS = BEF + 32;
    const int* BCNT = (const int*)(F.ws + WS_BCNT); const int* TOPI = (const int*)(F.ws + WS_TOPI); const int* LRANK = (const int*)(F.ws + WS_LRANK);
    int* POSOF = (int*)(F.ws + WS_POSOF); int* ROWTOK = (int*)(F.ws + WS_ROWTOK); int* META = (int*)(F.ws + WS_META);
    for (int rb = F.bx; rb < T / 128; rb += F.G) {
        { const int e = F.tid & 31, part = F.tid >> 5; int tot = 0, bef = 0;
          for (int c2 = part * 16; c2 < part * 16 + 16; ++c2) { const int v = BCNT[c2 * 32 + e]; tot += v; if (c2 < rb) bef += v; }
          PT[F.tid] = tot; PB[F.tid] = bef; }
        __syncthreads();
        if (F.tid < 32) { int tot = 0, bef = 0;
#pragma unroll
            for (int p = 0; p < 16; ++p) { tot += PT[p * 32 + F.tid]; bef += PB[p * 32 + F.tid]; }
            TOT[F.tid] = tot; BEF[F.tid] = bef; }
        __syncthreads();
        if (F.tid == 0) { int run = 0; for (int e = 0; e < 32; ++e) { PS[e] = run; run += ((TOT[e] + 255) >> 8) << 8; } PS[32] = run; }
        __syncthreads();
        { const size_t pi = (size_t)rb * 512 + F.tid; const int e = TOPI[pi]; const int pos = PS[e] + BEF[e] + LRANK[pi]; ROWTOK[pos] = rb * 128 + (F.tid >> 2); POSOF[pi] = pos; }
        if (rb < 32) { const int e = rb, lim = ((TOT[e] + 255) >> 8) << 8; for (int r = TOT[e] + F.tid; r < lim; r += 512) ROWTOK[PS[e] + r] = 0; }
        if (rb == 0 && F.tid <= 32) META[F.tid] = PS[F.tid] >> 8;
        __syncthreads();
    }
}
__device__ __forceinline__ int moe_tables(Frame& F, LAS int* texp) {
    const int* META = (const int*)(F.ws + WS_META);
    const int MT = META[32];
    for (int pm = F.tid; pm < MT; pm += 512) { int e = 0;
#pragma unroll 1
        for (int k = 1; k < 32; ++k) if (META[k] <= pm) e = k;
        texp[pm] = e; }
    __syncthreads();
    return MT;
}
__device__ __forceinline__ void p10_combine(Frame& F, const Args& args) {
    const bf16* X1 = (const bf16*)(F.ws + WS_X1); const unsigned char* Y = F.ws + WS_Y; const float* mf = (const float*)(F.ws + WS_MODF);
    const int* POSOF = (const int*)(F.ws + WS_POSOF); const float* TOPG = (const float*)(F.ws + WS_TOPG);
    const int lane = F.lane;
    for (int rb = F.bx; rb < T / 128; rb += F.G) {
        const int b = rb >> 5;
        f32x4 g2[4], fg[4];
#pragma unroll
        for (int i = 0; i < 4; ++i) { g2[i] = *(const f32x4*)(mf + (size_t)b * NMODW + 5 * D + 256 * i + 4 * lane); fg[i] = *(const f32x4*)(args.in[I_FNG] + 256 * i + 4 * lane); }
        for (int r = F.wave; r < 128; r += NWAVES) {
            const size_t t = (size_t)rb * 128 + r;
            const int p0 = POSOF[t * 4 + 0], p1 = POSOF[t * 4 + 1], p2 = POSOF[t * 4 + 2], p3 = POSOF[t * 4 + 3];
            const float k0 = TOPG[t * 4 + 0] * Y8_INV, k1 = TOPG[t * 4 + 1] * Y8_INV, k2 = TOPG[t * 4 + 2] * Y8_INV, k3 = TOPG[t * 4 + 3] * Y8_INV;
            f32x4 o[4]; float s = 0.f;
#pragma unroll
            for (int i = 0; i < 4; ++i) {
                const v2u xw = *((const GAS v2u*)(X1 + t * D) + lane + 64 * i);
                const unsigned y0 = *((const GAS unsigned*)(Y + (size_t)p0 * D) + lane + 64 * i), y1 = *((const GAS unsigned*)(Y + (size_t)p1 * D) + lane + 64 * i);
                const unsigned y2 = *((const GAS unsigned*)(Y + (size_t)p2 * D) + lane + 64 * i), y3 = *((const GAS unsigned*)(Y + (size_t)p3 * D) + lane + 64 * i);
                const f32x2 a0 = __builtin_amdgcn_cvt_pk_f32_fp8(y0, false), b0 = __builtin_amdgcn_cvt_pk_f32_fp8(y0, true), a1 = __builtin_amdgcn_cvt_pk_f32_fp8(y1, false), b1 = __builtin_amdgcn_cvt_pk_f32_fp8(y1, true);
                const f32x2 a2 = __builtin_amdgcn_cvt_pk_f32_fp8(y2, false), b2 = __builtin_amdgcn_cvt_pk_f32_fp8(y2, true), a3 = __builtin_amdgcn_cvt_pk_f32_fp8(y3, false), b3 = __builtin_amdgcn_cvt_pk_f32_fp8(y3, true);
                f32x4 m;
                m.x = (k0 * a0.x + k1 * a1.x) + (k2 * a2.x + k3 * a3.x); m.y = (k0 * a0.y + k1 * a1.y) + (k2 * a2.y + k3 * a3.y);
                m.z = (k0 * b0.x + k1 * b1.x) + (k2 * b2.x + k3 * b3.x); m.w = (k0 * b0.y + k1 * b1.y) + (k2 * b2.y + k3 * b3.y);
                const f32x4 xv = (f32x4){bflo(xw.x), bfhi(xw.x), bflo(xw.y), bfhi(xw.y)};
                o[i] = xv + g2[i] * m; s += (o[i].x * o[i].x + o[i].y * o[i].y) + (o[i].z * o[i].z + o[i].w * o[i].w); }
            const float rstd = rsqrtf(wave_sum(s) * (1.0f / D) + EPS);
#pragma unroll
            for (int i = 0; i < 4; ++i) *((GAS f32x4*)(F.out + t * D) + lane + 64 * i) = o[i] * rstd * fg[i];
        }
    }
}

__global__ void __launch_bounds__(NWAVES * 64, 2) hymba_fwd(Args args) {
    extern __shared__ __attribute__((aligned(16))) unsigned char lds[];
    Frame F;
    F.lds = (LAS unsigned char*)lds;
    F.MISC = (volatile LAS unsigned*)(F.lds + MISC_OFF);
    F.tid = threadIdx.x; F.lane = F.tid & 63; F.wave = __builtin_amdgcn_readfirstlane(F.tid >> 6);
    F.G = gridDim.x; F.bx = blockIdx.x;
    F.out = args.out; F.ws = args.ws; F.ctl = (gu32*)(args.ws + WS_CTL);
    for (int u = F.tid; u < (LDS_BYTES - LDSCTL_OFF) / 4; u += NWAVES * 64) ((LAS unsigned*)(F.lds + LDSCTL_OFF))[u] = 0u;
    __syncthreads();
    XcdBarrier bar; bar.bar = (unsigned*)(F.ctl + CW_BAR); bar.x = 0; bar.st = nullptr;
    if (N_LAUNCHES != PER_PHASE) bar = xcd_barrier_post((unsigned*)(F.ctl + CW_BAR) + args.li * XCD_BAR_WORDS, F.MISC + 8);
#define GRID_BAR() do { if (N_LAUNCHES != PER_PHASE) xcd_barrier(bar); } while (0)
    const int lo = args.ph_lo, hi = args.ph_hi;
#define IN(k) (lo <= (k) && (k) < hi)
#define BOTH(k) (IN(k) && IN((k) + 1))
    const PG8_LAS unsigned* gtab = (const PG8_LAS unsigned*)(F.lds + AUX_OFF);
    LAS int* texp = (LAS int*)(F.lds + AUX_OFF + AUX_TEXP);

    if (IN(0)) { p0_prologue(F, args); if (BOTH(0)) GRID_BAR(); }
    if (IN(1)) { p1_norm1(F, args); if (BOTH(1)) GRID_BAR(); }
    if (IN(2)) {
        pg8::Order S; S.init(T / 256, 2048 / 256, F.G, F.bx, F.ws + WS_H, F.ws + WS_WIN, D, 0, nullptr, false);
        pg8::EpiInProj E{(bf16*)(F.ws + WS_V), (bf16*)(F.ws + WS_GG), (bf16*)(F.ws + WS_UREC)};
        pg8::gemm_phase<pg8::EpiInProj, pg8::Order, false, true, true, false>(F.lds, D, S, E, gtab);
        if (BOTH(2)) GRID_BAR();
    }
    if (IN(3)) {
        for (int ck = F.bx; ck < T / 128; ck += F.G) { lru_unit(F, args, ck); __syncthreads(); }
        for (int u = F.bx; u < T / 64; u += F.G) { conv_unit(F, args, u); __syncthreads(); }
        if (BOTH(3)) GRID_BAR();
    }
    if (IN(4)) { p4_lru_apply(F, args); if (BOTH(4)) GRID_BAR(); }
    if (IN(5)) {
        pg8::Order S; S.init(T / 256, D / 256, F.G, F.bx, F.ws + WS_H, F.ws + WS_WOUT, D, 0, nullptr, false);
        pg8::EpiOutProj E{args.in[I_X], (bf16*)(F.ws + WS_X1), (const float*)(F.ws + WS_MODF)};
        pg8::gemm_phase<pg8::EpiOutProj, pg8::Order, false, true, true, false>(F.lds, D, S, E, gtab);
        if (BOTH(5)) GRID_BAR();
    }
    if (IN(6)) { p6_router(F, args); if (BOTH(6)) GRID_BAR(); }
    if (IN(7)) { p7_positions(F); if (BOTH(7)) GRID_BAR(); }
    if (IN(8)) {
        const int MT = moe_tables(F, texp);
        pg8::Order S; S.init(MT, 2048 / 256, F.G, F.bx, F.ws + WS_H, F.ws + WS_WGU, D / 2, (size_t)2048 * D, texp, true);
        LAS int* ut = (LAS int*)(F.lds + AUX_OFF + AUX_UTAB); LAS unsigned short* bt = (LAS unsigned short*)(F.lds + AUX_OFF + AUX_BIAS);
        { const int* ROWTOK = (const int*)(F.ws + WS_ROWTOK); pg8::Unit u; LAS unsigned* gt = (LAS unsigned*)(F.lds + AUX_OFF);
          for (int i = 0; i <= MAXU; ++i) { const bool ok = i < MAXU && S.compute(i, u); if (F.tid == 0) ut[i] = ok ? (u.pm | (u.pn << 12) | (u.e << 16)) : -1; if (!ok) break;
              if (F.tid < 256) { gt[i * 256 + F.tid] = (unsigned)ROWTOK[u.pm * 256 + F.tid] * (unsigned)D;
                  bt[i * 256 + F.tid] = (unsigned short)f2bf(args.in[I_BGU][(size_t)u.e * 2 * DE + (F.tid < 128 ? 0 : DE - 128) + u.pn * 128 + F.tid]); } } }
        __syncthreads();
        S.utab = ut;
        pg8::EpiSwiglu E{F.ws + WS_ACT, (const PG8_LAS unsigned char*)bt};
        pg8::gemm_phase<pg8::EpiSwiglu, pg8::Order, true, true, true, true>(F.lds, D / 2, S, E, gtab);
        if (BOTH(8)) GRID_BAR();
    }
    if (IN(9)) {
        const int MT = moe_tables(F, texp);
        pg8::Order S; S.init(MT, D / 256, F.G, F.bx, F.ws + WS_ACT, F.ws + WS_WD, DE / 2, (size_t)D * DE, texp, false);
        LAS int* ut = (LAS int*)(F.lds + AUX_OFF + AUX_UTAB); LAS unsigned short* bt = (LAS unsigned short*)(F.lds + AUX_OFF + AUX_BIAS);
        { pg8::Unit u;
          for (int i = 0; i <= MAXU; ++i) { const bool ok = i < MAXU && S.compute(i, u); if (F.tid == 0) ut[i] = ok ? (u.pm | (u.pn << 12) | (u.e << 16)) : -1; if (!ok) break;
              if (F.tid < 256) bt[i * 256 + F.tid] = (unsigned short)f2bf(args.in[I_BD][(size_t)u.e * D + u.pn * 256 + F.tid]); } }
        __syncthreads();
        S.utab = ut;
        pg8::EpiDown E{F.ws + WS_Y, (const PG8_LAS unsigned char*)bt};
        pg8::gemm_phase<pg8::EpiDown, pg8::Order, false, true, true, true>(F.lds, DE / 2, S, E, gtab);
        if (BOTH(9)) GRID_BAR();
    }
    if (IN(10)) { p10_combine(F, args); }
#undef IN
#undef BOTH
}

extern "C" void kernel_launch(void* const* d_in, const int* in_sizes, int n_in, void* d_out, int out_size, void* d_ws, size_t ws_size, hipStream_t stream) {
    static int grid = 0;
    if (grid == 0) {
        if (n_in != 27 || in_sizes[0] != T * D || out_size != T * D || ws_size < WS_END) { fprintf(stderr, "kernel_launch: unexpected shapes (n_in %d, in0 %d, out %d, ws %zu); nothing launched\n", n_in, n_in > 0 ? in_sizes[0] : -1, out_size, ws_size); grid = -1; return; }
        int dev = 0, cus = 0, per_cu = 0;
        if (hipGetDevice(&dev) != hipSuccess || hipDeviceGetAttribute(&cus, hipDeviceAttributeMultiprocessorCount, dev) != hipSuccess) { grid = -1; return; }
        if (hipFuncSetAttribute((const void*)hymba_fwd, hipFuncAttributeMaxDynamicSharedMemorySize, LDS_BYTES) != hipSuccess) { fprintf(stderr, "kernel_launch: hipFuncSetAttribute failed\n"); grid = -1; return; }
        if (hipOccupancyMaxActiveBlocksPerMultiprocessor(&per_cu, (const void*)hymba_fwd, NWAVES * 64, LDS_BYTES) != hipSuccess || per_cu < 1)
            fprintf(stderr, "kernel_launch: note: occupancy query reports %d workgroups per CU\n", per_cu);
        (void)hipGetLastError();
        grid = cus;
    }
    if (grid < 0) return;
    if (hipMemsetAsync((char*)d_ws + WS_CTL, 0, CTL_ZERO_BYTES, stream) != hipSuccess) return;
    Args a{};
    for (int i = 0; i < 27; ++i) a.in[i] = (const float*)d_in[i];
    a.out = (float*)d_out; a.ws = (unsigned char*)d_ws;
    if (N_LAUNCHES == 1) { a.ph_lo = 0; a.ph_hi = PER_PHASE; a.li = 0; hipLaunchKernelGGL(hymba_fwd, dim3(grid), dim3(NWAVES * 64), LDS_BYTES, stream, a); }
    else { for (int li = 0; li < PER_PHASE; ++li) { a.ph_lo = li; a.ph_hi = li + 1; a.li = 0; hipLaunchKernelGGL(hymba_fwd, dim3(grid), dim3(NWAVES * 64), LDS_BYTES, stream, a); } }
    const hipError_t le = hipPeekAtLastError();
    if (le != hipSuccess) fprintf(stderr, "kernel_launch: launch failed: %s\n", hipGetErrorName(le));
}
```

```cpp
#include <hip/hip_runtime.h>
#include <cstdio>
#include <cstdint>

#define GAS __attribute__((address_space(1)))
#define LAS __attribute__((address_space(3)))
typedef unsigned short bf16;
typedef unsigned v4u __attribute__((ext_vector_type(4)));
typedef unsigned v2u __attribute__((ext_vector_type(2)));
typedef float f32x4 __attribute__((ext_vector_type(4)));
typedef float f32x2 __attribute__((ext_vector_type(2)));
typedef short bf16x8 __attribute__((ext_vector_type(8)));
typedef GAS unsigned gu32;
#define RLX_AGENT __ATOMIC_RELAXED, __HIP_MEMORY_SCOPE_AGENT
#define LDS_WAIT() asm volatile("s_waitcnt lgkmcnt(0)" ::: "memory")
#define VM_WAIT() asm volatile("s_waitcnt vmcnt(0)" ::: "memory")

constexpr int NB = 8, SEQ = 4096, T = NB * SEQ, D = 1024, DC = 512, NE = 32, TOPK = 4, DE = 1024, NMODW = 6 * D;
constexpr int NPAIR = T * TOPK, MAXROWS = NPAIR + NE * 256, MAXMT = MAXROWS / 256;
constexpr float EPS = 1e-6f;
constexpr int NWAVES = 8;
#ifndef MK_N_LAUNCHES
#define MK_N_LAUNCHES 1
#endif
constexpr int N_LAUNCHES = MK_N_LAUNCHES;
constexpr int PER_PHASE = 11;

constexpr size_t MiB = 1u << 20, KiB = 1024;
constexpr size_t WS_CTL = 0, CTL_ZERO_BYTES = 1 * MiB;
constexpr size_t WS_MODP = 1 * MiB;
constexpr size_t WS_MODF = 2 * MiB;
constexpr size_t WS_WRH = 2 * MiB + 256 * KiB, WS_WRL = WS_WRH + 64 * KiB;
constexpr size_t WS_SUMA = 2 * MiB + 512 * KiB, WS_SUMH = 3 * MiB;
constexpr size_t WS_TOPI = 3 * MiB + 512 * KiB, WS_TOPG = 4 * MiB, WS_LRANK = 4 * MiB + 512 * KiB, WS_POSOF = 5 * MiB;
constexpr size_t WS_BCNT = 5 * MiB + 512 * KiB, WS_META = WS_BCNT + 64 * KiB;
constexpr size_t WS_ROWTOK = 8 * MiB;
constexpr size_t WS_LRUB = 7 * MiB;
constexpr size_t WS_WIN = 16 * MiB, WS_WOUT = 20 * MiB;
constexpr size_t WS_WD = 24 * MiB;
constexpr size_t WS_WGU = 56 * MiB;
constexpr size_t WS_H = 120 * MiB;
constexpr size_t WS_V = 184 * MiB, WS_GG = 216 * MiB, WS_UREC = 248 * MiB;
constexpr size_t WS_X1 = 280 * MiB;
constexpr size_t WS_ACT = 408 * MiB;
constexpr size_t WS_Y = 544 * MiB;
constexpr size_t WS_HLOC = 816 * MiB, WS_PCUM = 848 * MiB;
constexpr size_t WS_END = 880 * MiB;
static_assert(WS_ACT + (size_t)MAXROWS * DE <= WS_Y && WS_Y + (size_t)MAXROWS * D <= WS_END, "ws map");
constexpr float Y8_SCALE = 16.0f, Y8_INV = 1.0f / 16.0f;
constexpr float W8_SCALE = 64.0f, W8_INV = 1.0f / 64.0f;
constexpr int CW_BAR = 4096;
constexpr int CW_CURSOR = 32768;

constexpr int RING_BYTES = 131072, AUX_OFF = 131072, AUX_BYTES = 30464, LDSCTL_OFF = AUX_OFF + AUX_BYTES, MISC_OFF = LDSCTL_OFF + 320, LDS_BYTES = LDSCTL_OFF + 1024;
constexpr int MAXU = 18;
constexpr int AUX_TEXP = 18432;
constexpr int AUX_BIAS = AUX_TEXP + 2304;
constexpr int AUX_UTAB = AUX_BIAS + MAXU * 512;
static_assert(AUX_TEXP + MAXMT * 4 <= AUX_BIAS && AUX_UTAB + 128 + 40 * 4 + 32 * 4 <= AUX_BYTES && LDS_BYTES <= 163840, "aux");

typedef __bf16 hwbf16x2 __attribute__((ext_vector_type(2)));
__device__ __forceinline__ unsigned pk2(float lo, float hi) { const f32x2 v = {lo, hi}; return __builtin_bit_cast(unsigned, __builtin_convertvector(v, hwbf16x2)); }
__device__ __forceinline__ unsigned f2bf(float f) { return pk2(f, 0.f) & 0xffffu; }
__device__ __forceinline__ float bf2f(unsigned b) { return __builtin_bit_cast(float, b << 16); }
__device__ __forceinline__ float bflo(unsigned w) { return __builtin_bit_cast(float, w << 16); }
__device__ __forceinline__ float bfhi(unsigned w) { return __builtin_bit_cast(float, w & 0xffff0000u); }
__device__ __forceinline__ float sigmoidf_(float z) { return __builtin_amdgcn_rcpf(1.0f + __expf(-z)); }

namespace pg8 {
#define PG8_LAS __attribute__((address_space(3)))
typedef unsigned short bf16_t;
typedef unsigned u32x4 __attribute__((ext_vector_type(4)));
constexpr int BM = 256, BK = 64, HALF = 128, HTB = HALF * BK * 2, STAGE_BYTES = 8 * HTB, NXCD = 8, WGM = 8;
__host__ __device__ __forceinline__ int lds_byte(int r, int c) { const int st = (r >> 4) * 2 + (c >> 5), rr = r & 15, cc = c & 31, ob = rr * 64 + cc * 2; return st * 1024 + (ob ^ (((ob >> 9) & 1) << 5)); }
__host__ __device__ __forceinline__ void stage_rc(int b, int& R, int& C) { const int st = b / 1024, sb = b % 1024, swz = sb ^ (((sb >> 9) & 1) << 5); R = (st >> 1) * 16 + swz / 64; C = (st & 1) * 32 + (swz % 64) / 2; }
__host__ __device__ __forceinline__ int perm32(int rho) { const int n = rho >> 4, i = rho & 15; return 8 * (i >> 2) + 4 * n + (i & 3); }
__device__ __forceinline__ unsigned cvt_pk_bf16(float lo, float hi) { unsigned r; asm volatile("v_cvt_pk_bf16_f32 %0, %1, %2" : "=v"(r) : "v"(lo), "v"(hi)); return r; }

typedef int v8i __attribute__((ext_vector_type(8)));
typedef int v4i __attribute__((ext_vector_type(4)));
__device__ __forceinline__ v8i cat8(bf16x8 lo, bf16x8 hi) { const v4i a = __builtin_bit_cast(v4i, lo), b = __builtin_bit_cast(v4i, hi); return __builtin_shufflevector(a, b, 0, 1, 2, 3, 4, 5, 6, 7); }
struct Unit { int pm, pn, e, slot; };

struct Order {
    int nM, nN, nwg, G, c; const char* A; const char* Bt; size_t tstep, estep; const PG8_LAS int* texp; bool gather; const PG8_LAS int* utab;
    __device__ __forceinline__ void init(int nM_, int nN_, int G_, int c_, const void* A_, const void* Bt_, int K, size_t estep_, const PG8_LAS int* texp_, bool gather_) {
        nM = nM_; nN = nN_; nwg = nM * nN; G = G_; c = c_; A = (const char*)A_; Bt = (const char*)Bt_; tstep = (size_t)BM * K * 2; estep = estep_; texp = texp_; gather = gather_; utab = (const PG8_LAS int*)~0u; }
    __device__ __forceinline__ bool next(int i, Unit& u) const {
        if (utab != (const PG8_LAS int*)~0u) { const int d = __builtin_amdgcn_readfirstlane(utab[i]); if (d < 0) return false; u.pm = d & 0xfff; u.pn = (d >> 12) & 0xf; u.e = d >> 16; u.slot = i; return true; }
        return compute(i, u); }
    __device__ __forceinline__ bool compute(int i, Unit& u) const {
        u.slot = i;
        const long L = (long)i * G + c; if (L >= nwg) return false;
        int wgid = (int)L; { const int q = nwg / NXCD, r = nwg % NXCD, xcd = wgid % NXCD, off = wgid / NXCD; wgid = (xcd < r ? xcd * (q + 1) : r * (q + 1) + (xcd - r) * q) + off; }
        const int nig = WGM * nN, gid = wgid / nig, fm = gid * WGM, gsz = (nM - fm) < WGM ? (nM - fm) : WGM;
        u.pm = fm + ((wgid % nig) % gsz); u.pn = (wgid % nig) / gsz; u.e = texp ? __builtin_amdgcn_readfirstlane(texp[u.pm]) : 0; return true;
    }
    __device__ __forceinline__ unsigned a_off(const Unit& u) const { return gather ? 0u : (unsigned)u.pm * (unsigned)tstep; }
    __device__ __forceinline__ unsigned b_off(const Unit& u) const { return (unsigned)u.e * (unsigned)estep + (unsigned)u.pn * (unsigned)tstep; }
};

template <class Epi, class Sched, bool GATHER, bool ALIGN_EPI, bool SP2, bool FP8>
__device__ __forceinline__ void gemm_phase(PG8_LAS unsigned char* lds, const int K, const Sched& S, const Epi& E, const PG8_LAS unsigned* gtab) {
    const int tid = threadIdx.x, wid = __builtin_amdgcn_readfirstlane(tid >> 6), lane = tid & 63, wr = wid >> 2, wc = wid & 3, fr = lane & 15, fq = lane >> 4;
    const int nt = K / BK;
    const __amdgpu_buffer_rsrc_t rsA = __builtin_amdgcn_make_buffer_rsrc((void*)S.A, 0, -1, 0x00020000);
    const __amdgpu_buffer_rsrc_t rsB = __builtin_amdgcn_make_buffer_rsrc((void*)S.Bt, 0, -1, 0x00020000);
    unsigned voffA[2], voffB[2]; unsigned offA[2][2];
#pragma unroll
    for (int i = 0; i < 2; ++i) { int R, C; stage_rc(tid * 16 + i * 8192, R, C); const int Rb = Epi::PERM ? ((R & ~31) + perm32(R & 31)) : R;
        voffA[i] = (unsigned)(R * K + C) * 2u; voffB[i] = (unsigned)(Rb * K + C) * 2u; offA[0][i] = 0; offA[1][i] = 0; }
    const unsigned kstep = (unsigned)(BK * 2);
    const unsigned hstep = (unsigned)HALF * K * 2;
    const unsigned ldsw = (unsigned)wid * 1024u;
    const int aoff = lds_byte(wr * 64 + fr, fq * 8), boff = lds_byte(wc * 32 + fr, fq * 8);
#define PG8_SA(b, h) (((b) * 2 + (h)) * HTB)
#define PG8_SB(b, h) ((4 + (b) * 2 + (h)) * HTB)
#define PG8_STAGE(rs, bufoff, soff, voff) do { _Pragma("unroll") for (int _i = 0; _i < 2; ++_i) \
        __builtin_amdgcn_raw_ptr_buffer_load_lds(rs, (PG8_LAS void*)(lds + (bufoff) + ldsw + _i * 8192), 16, (int)(voff)[_i], (int)(soff), 0, 0); } while (0)
#define PG8_STAGE_A(b, h, kbase) do { if constexpr (GATHER) { PG8_STAGE(rsA, PG8_SA(b, h), (kbase), offA[h]); } else { PG8_STAGE(rsA, PG8_SA(b, h), (kbase) + (h) * hstep, voffA); } } while (0)
#define PG8_STAGE_B(b, h, kbase) PG8_STAGE(rsB, PG8_SB(b, h), (kbase) + (h) * hstep, voffB)
#define PG8_LOAD_OFFS(slot) do { _Pragma("unroll") for (int _i = 0; _i < 2; ++_i) { int _R, _C; stage_rc(tid * 16 + _i * 8192, _R, _C); \
        _Pragma("unroll") for (int _h = 0; _h < 2; ++_h) offA[_h][_i] = gtab[(slot) * 256 + _h * 128 + _R] + (unsigned)_C * 2u; } } while (0)
#define PG8_LDA(dst, b, h) do { _Pragma("unroll") for (int m = 0; m < 4; ++m) _Pragma("unroll") for (int k = 0; k < 2; ++k) dst[m][k] = *(const PG8_LAS bf16x8*)(lds + PG8_SA(b, h) + aoff + m * 2048 + k * 1024); } while (0)
#define PG8_LDB(dst, b, h) do { _Pragma("unroll") for (int n = 0; n < 2; ++n) _Pragma("unroll") for (int k = 0; k < 2; ++k) dst[n][k] = *(const PG8_LAS bf16x8*)(lds + PG8_SB(b, h) + boff + n * 2048 + k * 1024); } while (0)
#define PG8_MMA(ai, bj, At, Bt) do { __builtin_amdgcn_s_setprio(1); _Pragma("unroll") for (int m = 0; m < 4; ++m) _Pragma("unroll") for (int n = 0; n < 2; ++n) { \
        if constexpr (FP8) { acc[ai][bj][m][n] = __builtin_amdgcn_mfma_scale_f32_16x16x128_f8f6f4(cat8(Bt[n][0], Bt[n][1]), cat8(At[m][0], At[m][1]), acc[ai][bj][m][n], 0, 0, 0, 0, 0, 0); } \
        else { _Pragma("unroll") for (int k = 0; k < 2; ++k) acc[ai][bj][m][n] = __builtin_amdgcn_mfma_f32_16x16x32_bf16(Bt[n][k], At[m][k], acc[ai][bj][m][n], 0, 0, 0); } } __builtin_amdgcn_s_setprio(0); } while (0)
#define PG8_WAIT_V(n) asm volatile("s_waitcnt vmcnt(" #n ")" ::: "memory")
#define PG8_WAIT_VX asm volatile("s_waitcnt vmcnt(%0)" :: "n"(8 + Epi::NSTORE) : "memory")
#define PG8_WAIT_L(n) asm volatile("s_waitcnt lgkmcnt(" #n ")" ::: "memory")
#define PG8_BAR __builtin_amdgcn_s_barrier()
#define PG8_SCHED __builtin_amdgcn_sched_barrier(0)
    Unit cur, nxt; int ui = 0;
    if (!S.next(0, cur)) return;
    f32x4 acc[2][2][4][2];
    E.init(acc, cur, wc, fq);
    bf16x8 At[4][2], B0[2][2], B1[2][2];
    unsigned cA = S.a_off(cur), cB = S.b_off(cur);
    if constexpr (GATHER) { PG8_LOAD_OFFS(0); }
    if constexpr (SP2) {
        PG8_STAGE_B(0, 0, cB); PG8_STAGE_B(0, 1, cB); PG8_STAGE_A(0, 0, cA); PG8_STAGE_A(0, 1, cA);
        if (wr == 1) PG8_BAR;
        PG8_WAIT_V(2); PG8_BAR;
        PG8_STAGE_B(1, 0, cB + kstep); PG8_STAGE_A(1, 0, cA + kstep); PG8_STAGE_B(1, 1, cB + kstep);
        PG8_WAIT_V(6); PG8_BAR;
    } else {
        PG8_STAGE_B(0, 0, cB); PG8_STAGE_A(0, 0, cA); PG8_STAGE_B(0, 1, cB); PG8_STAGE_A(0, 1, cA);
        if (wr == 1) PG8_BAR;
        PG8_WAIT_V(4); PG8_BAR;
        PG8_STAGE_B(1, 0, cB + kstep); PG8_STAGE_A(1, 0, cA + kstep); PG8_STAGE_B(1, 1, cB + kstep);
        PG8_WAIT_V(6); PG8_BAR;
    }
    for (;;) {
        const bool has_next = S.next(ui + 1, nxt);
        const unsigned nA = has_next ? S.a_off(nxt) : cA, nB = has_next ? S.b_off(nxt) : cB;
#pragma unroll 1
        for (int t = 0; t < nt; t += 2) {
            const bool last = (t == nt - 2);
            const unsigned a1 = cA + (unsigned)(t + 1) * kstep;
            const unsigned a2 = last ? nA : cA + (unsigned)(t + 2) * kstep, b2 = last ? nB : cB + (unsigned)(t + 2) * kstep;
            const unsigned a3 = a2 + kstep, b3 = b2 + kstep;
            if constexpr (SP2) {
            const bool post = (ui > 0) && (t == 0);
            PG8_LDB(B0, 0, 0); PG8_LDB(B1, 0, 1); PG8_SCHED; PG8_LDA(At, 0, 0); if (!post) { PG8_STAGE_A(1, 1, a1); }
            if (post) { PG8_WAIT_VX; } else { PG8_WAIT_V(8); } PG8_WAIT_L(0); PG8_BAR; PG8_MMA(0, 0, At, B0); PG8_MMA(0, 1, At, B1); PG8_BAR; PG8_SCHED;
            if constexpr (GATHER) { if (last && has_next) { PG8_LOAD_OFFS(ui + 1); } }
            PG8_LDA(At, 0, 1); PG8_STAGE_B(0, 0, b2); PG8_STAGE_B(0, 1, b2); PG8_STAGE_A(0, 0, a2);
            if (post) { PG8_WAIT_VX; } else { PG8_WAIT_V(8); } PG8_WAIT_L(0); PG8_BAR; PG8_MMA(1, 0, At, B0); PG8_MMA(1, 1, At, B1); PG8_BAR; PG8_SCHED;
            PG8_LDB(B0, 1, 0); PG8_LDB(B1, 1, 1); PG8_SCHED; PG8_LDA(At, 1, 0); PG8_STAGE_A(0, 1, a2);
            if (post) { PG8_WAIT_VX; } else { PG8_WAIT_V(8); } PG8_WAIT_L(0); PG8_BAR; PG8_MMA(0, 0, At, B0); PG8_MMA(0, 1, At, B1); PG8_BAR; PG8_SCHED;
            PG8_LDA(At, 1, 1); PG8_STAGE_B(1, 0, b3); PG8_STAGE_B(1, 1, b3); PG8_STAGE_A(1, 0, a3);
            PG8_WAIT_V(8); PG8_WAIT_L(0); PG8_BAR; PG8_MMA(1, 0, At, B0); PG8_MMA(1, 1, At, B1); PG8_BAR; PG8_SCHED;
            if (last) { PG8_STAGE_A(1, 1, a3); asm volatile("" ::: "memory"); PG8_SCHED; }
            } else {
            PG8_LDB(B0, 0, 0); PG8_SCHED; PG8_LDA(At, 0, 0); PG8_STAGE_A(1, 1, a1);
            PG8_WAIT_L(8); PG8_BAR; PG8_WAIT_L(0); PG8_MMA(0, 0, At, B0); PG8_BAR; PG8_SCHED;
            if constexpr (GATHER) { if (last && has_next) { PG8_LOAD_OFFS(ui + 1); } }
            PG8_LDB(B1, 0, 1); PG8_STAGE_B(0, 0, b2);
            PG8_BAR; PG8_WAIT_L(0); PG8_MMA(0, 1, At, B1); PG8_BAR;
            PG8_LDA(At, 0, 1); PG8_STAGE_A(0, 0, a2);
            PG8_BAR; PG8_WAIT_L(0); PG8_MMA(1, 0, At, B0); PG8_BAR; PG8_SCHED;
            PG8_STAGE_B(0, 1, b2);
            PG8_WAIT_V(6); PG8_BAR; PG8_MMA(1, 1, At, B1); PG8_BAR;
            PG8_LDB(B0, 1, 0); PG8_SCHED; PG8_LDA(At, 1, 0); PG8_STAGE_A(0, 1, a2);
            PG8_WAIT_L(8); PG8_BAR; PG8_WAIT_L(0); PG8_MMA(0, 0, At, B0); PG8_BAR; PG8_SCHED;
            PG8_LDB(B1, 1, 1); PG8_STAGE_B(1, 0, b3);
            PG8_BAR; PG8_WAIT_L(0); PG8_MMA(0, 1, At, B1); PG8_BAR;
            PG8_LDA(At, 1, 1); PG8_STAGE_A(1, 0, a3);
            PG8_BAR; PG8_WAIT_L(0); PG8_MMA(1, 0, At, B0); PG8_BAR; PG8_SCHED;
            PG8_STAGE_B(1, 1, b3);
            PG8_WAIT_V(6); PG8_BAR; PG8_MMA(1, 1, At, B1); PG8_BAR;
            }
        }
        if constexpr (ALIGN_EPI) { if (wr == 0) PG8_BAR; }
        E(acc, cur, wr, wc, fr, fq);
        if (!has_next) break;
        cur = nxt; cA = nA; cB = nB; ++ui;
        E.init(acc, cur, wc, fq);
        if constexpr (ALIGN_EPI) { if (wr == 1) PG8_BAR; }
    }
    PG8_WAIT_V(0);
    if constexpr (!ALIGN_EPI) { if (wr == 0) PG8_BAR; }
    PG8_BAR;
#undef PG8_SA
#undef PG8_SB
#undef PG8_STAGE
#undef PG8_STAGE_A
#undef PG8_STAGE_B
#undef PG8_LOAD_OFFS
#undef PG8_LDA
#undef PG8_LDB
#undef PG8_MMA
#undef PG8_WAIT_V
#undef PG8_WAIT_VX
#undef PG8_WAIT_L
#undef PG8_BAR
#undef PG8_SCHED
}

struct EpiInProj {
    static constexpr bool PERM = true; static constexpr int NSTORE = 8;
    bf16_t* V; bf16_t* GG; bf16_t* UR;
    __device__ __forceinline__ void init(f32x4 (&acc)[2][2][4][2], const Unit&, int, int) const {
#pragma unroll
        for (int a = 0; a < 2; ++a)
#pragma unroll
            for (int b = 0; b < 2; ++b)
#pragma unroll
                for (int m = 0; m < 4; ++m)
#pragma unroll
                    for (int n = 0; n < 2; ++n) acc[a][b][m][n] = (f32x4){0.f, 0.f, 0.f, 0.f};
    }
    __device__ __forceinline__ void operator()(const f32x4 (&acc)[2][2][4][2], const Unit& u, int wr, int wc, int fr, int fq) const {
        const int row0 = u.pm * BM + wr * 64 + fr, cl = wc * 32 + 8 * fq;
        if (u.pn < 4) {
#pragma unroll
            for (int ai = 0; ai < 2; ++ai)
#pragma unroll
                for (int m = 0; m < 4; ++m) { float o[8];
#pragma unroll
                    for (int n = 0; n < 2; ++n)
#pragma unroll
                        for (int j = 0; j < 4; ++j) o[4 * n + j] = acc[ai][0][m][n][j] * sigmoidf_(acc[ai][1][m][n][j]);
                    u32x4 w; w.x = cvt_pk_bf16(o[0], o[1]); w.y = cvt_pk_bf16(o[2], o[3]); w.z = cvt_pk_bf16(o[4], o[5]); w.w = cvt_pk_bf16(o[6], o[7]);
                    *(u32x4*)(V + (size_t)(row0 + ai * HALF + m * 16) * 512 + u.pn * 128 + cl) = w; }
        } else {
            const bool gel = u.pn < 6; bf16_t* base = gel ? GG : UR; const int c0 = (gel ? u.pn - 4 : u.pn - 6) * 256 + cl;
#pragma unroll
            for (int ai = 0; ai < 2; ++ai)
#pragma unroll
                for (int m = 0; m < 4; ++m)
#pragma unroll
                    for (int bj = 0; bj < 2; ++bj) { float o[8];
#pragma unroll
                        for (int n = 0; n < 2; ++n)
#pragma unroll
                            for (int j = 0; j < 4; ++j) { const float x = acc[ai][bj][m][n][j];
                                o[4 * n + j] = gel ? x * sigmoidf_(1.5957691216f * (x + 0.044715f * x * x * x)) : x; }
                        u32x4 w; w.x = cvt_pk_bf16(o[0], o[1]); w.y = cvt_pk_bf16(o[2], o[3]); w.z = cvt_pk_bf16(o[4], o[5]); w.w = cvt_pk_bf16(o[6], o[7]);
                        *(u32x4*)(base + (size_t)(row0 + ai * HALF + m * 16) * 512 + c0 + bj * HALF) = w; }
        }
    }
};
struct EpiOutProj {
    static constexpr bool PERM = true; static constexpr int NSTORE = 16;
    const float* X; bf16_t* X1; const float* modf;
    __device__ __forceinline__ void init(f32x4 (&acc)[2][2][4][2], const Unit&, int, int) const {
#pragma unroll
        for (int a = 0; a < 2; ++a)
#pragma unroll
            for (int b = 0; b < 2; ++b)
#pragma unroll
                for (int m = 0; m < 4; ++m)
#pragma unroll
                    for (int n = 0; n < 2; ++n) acc[a][b][m][n] = (f32x4){0.f, 0.f, 0.f, 0.f};
    }
    __device__ __forceinline__ void operator()(const f32x4 (&acc)[2][2][4][2], const Unit& u, int wr, int wc, int fr, int fq) const {
        const int row0 = u.pm * BM + wr * 64 + fr, col0 = u.pn * BM + wc * 32 + 8 * fq; const int b = (u.pm * BM) / SEQ;
        f32x4 gv[2][2];
#pragma unroll
        for (int bj = 0; bj < 2; ++bj)
#pragma unroll
            for (int n = 0; n < 2; ++n) gv[bj][n] = *(const f32x4*)(modf + (size_t)b * NMODW + 2 * D + col0 + bj * HALF + n * 4);
#pragma unroll
        for (int ai = 0; ai < 2; ++ai) {
            f32x4 xv[4][2][2];
#pragma unroll
            for (int m = 0; m < 4; ++m)
#pragma unroll
                for (int bj = 0; bj < 2; ++bj) { const float* xp = X + (size_t)(row0 + ai * HALF + m * 16) * D + col0 + bj * HALF; xv[m][bj][0] = *(const f32x4*)(xp); xv[m][bj][1] = *(const f32x4*)(xp + 4); }
#pragma unroll
            for (int m = 0; m < 4; ++m)
#pragma unroll
                for (int bj = 0; bj < 2; ++bj) { const f32x4 v0 = xv[m][bj][0] + gv[bj][0] * acc[ai][bj][m][0], v1 = xv[m][bj][1] + gv[bj][1] * acc[ai][bj][m][1];
                    u32x4 w; w.x = cvt_pk_bf16(v0[0], v0[1]); w.y = cvt_pk_bf16(v0[2], v0[3]); w.z = cvt_pk_bf16(v1[0], v1[1]); w.w = cvt_pk_bf16(v1[2], v1[3]);
                    *(u32x4*)(X1 + (size_t)(row0 + ai * HALF + m * 16) * D + col0 + bj * HALF) = w; }
            asm volatile("" ::: "memory"); }
    }
};
typedef short v2s16 __attribute__((ext_vector_type(2)));
__device__ __forceinline__ unsigned pk4_fp8_scaled(float a, float b, float c, float d, float scale) {
    v2s16 lo = {0, 0}, hi = {0, 0};
    lo = __builtin_amdgcn_cvt_scalef32_pk_fp8_f32(lo, a, b, scale, false); hi = __builtin_amdgcn_cvt_scalef32_pk_fp8_f32(hi, c, d, scale, false);
    return (__builtin_bit_cast(unsigned, lo) & 0xffffu) | (__builtin_bit_cast(unsigned, hi) << 16);
}
struct EpiSwiglu {
    static constexpr bool PERM = true; static constexpr int NSTORE = 8;
    unsigned char* ACT; const PG8_LAS unsigned char* btab;
    __device__ __forceinline__ void init(f32x4 (&acc)[2][2][4][2], const Unit& u, int wc, int fq) const {
        const u32x4 bgw = *(const PG8_LAS u32x4*)(btab + u.slot * 512 + (wc * 32 + 8 * fq) * 2), buw = *(const PG8_LAS u32x4*)(btab + u.slot * 512 + 256 + (wc * 32 + 8 * fq) * 2);
        f32x4 g0, g1, u0, u1;
#pragma unroll
        for (int k = 0; k < 2; ++k) { g0[2 * k] = __builtin_bit_cast(float, bgw[k] << 16) * W8_SCALE; g0[2 * k + 1] = __builtin_bit_cast(float, bgw[k] & 0xffff0000u) * W8_SCALE;
            g1[2 * k] = __builtin_bit_cast(float, bgw[2 + k] << 16) * W8_SCALE; g1[2 * k + 1] = __builtin_bit_cast(float, bgw[2 + k] & 0xffff0000u) * W8_SCALE;
            u0[2 * k] = (__builtin_bit_cast(float, buw[k] << 16) + 1.0f) * W8_SCALE; u0[2 * k + 1] = (__builtin_bit_cast(float, buw[k] & 0xffff0000u) + 1.0f) * W8_SCALE;
            u1[2 * k] = (__builtin_bit_cast(float, buw[2 + k] << 16) + 1.0f) * W8_SCALE; u1[2 * k + 1] = (__builtin_bit_cast(float, buw[2 + k] & 0xffff0000u) + 1.0f) * W8_SCALE; }
#pragma unroll
        for (int a = 0; a < 2; ++a)
#pragma unroll
            for (int m = 0; m < 4; ++m) { acc[a][0][m][0] = g0; acc[a][0][m][1] = g1; acc[a][1][m][0] = u0; acc[a][1][m][1] = u1; }
    }
    __device__ __forceinline__ void operator()(const f32x4 (&acc)[2][2][4][2], const Unit& u, int wr, int wc, int fr, int fq) const {
        const int row0 = u.pm * BM + wr * 64 + fr, col0 = u.pn * 128 + wc * 32 + 8 * fq;
#pragma unroll
        for (int ai = 0; ai < 2; ++ai)
#pragma unroll
            for (int m = 0; m < 4; ++m) { float o[8];
#pragma unroll
                for (int n = 0; n < 2; ++n)
#pragma unroll
                    for (int j = 0; j < 4; ++j) { const float G = fminf(acc[ai][0][m][n][j], 7.0f * W8_SCALE);
                        const float U = fminf(fmaxf(acc[ai][1][m][n][j], -6.0f * W8_SCALE), 8.0f * W8_SCALE);
                        const float s = __builtin_amdgcn_rcpf(1.0f + __builtin_amdgcn_exp2f(G * (-1.702f * 1.44269504f / W8_SCALE)));
                        o[4 * n + j] = U * (G * s); }
                v2u w; w.x = pk4_fp8_scaled(o[0], o[1], o[2], o[3], W8_SCALE * W8_SCALE); w.y = pk4_fp8_scaled(o[4], o[5], o[6], o[7], W8_SCALE * W8_SCALE);
                *(v2u*)(ACT + (size_t)(row0 + ai * HALF + m * 16) * DE + col0) = w; }
    }
};
struct EpiDown {
    static constexpr bool PERM = true; static constexpr int NSTORE = 16;
    unsigned char* Y; const PG8_LAS unsigned char* btab;
    __device__ __forceinline__ void init(f32x4 (&acc)[2][2][4][2], const Unit& u, int wc, int fq) const {
#pragma unroll
        for (int bj = 0; bj < 2; ++bj) { const u32x4 bw = *(const PG8_LAS u32x4*)(btab + u.slot * 512 + bj * 256 + (wc * 32 + 8 * fq) * 2);
            const f32x4 b0 = {__builtin_bit_cast(float, bw[0] << 16) * W8_SCALE, __builtin_bit_cast(float, bw[0] & 0xffff0000u) * W8_SCALE, __builtin_bit_cast(float, bw[1] << 16) * W8_SCALE, __builtin_bit_cast(float, bw[1] & 0xffff0000u) * W8_SCALE};
            const f32x4 b1 = {__builtin_bit_cast(float, bw[2] << 16) * W8_SCALE, __builtin_bit_cast(float, bw[2] & 0xffff0000u) * W8_SCALE, __builtin_bit_cast(float, bw[3] << 16) * W8_SCALE, __builtin_bit_cast(float, bw[3] & 0xffff0000u) * W8_SCALE};
#pragma unroll
            for (int a = 0; a < 2; ++a)
#pragma unroll
                for (int m = 0; m < 4; ++m) { acc[a][bj][m][0] = b0; acc[a][bj][m][1] = b1; } }
    }
    __device__ __forceinline__ void operator()(const f32x4 (&acc)[2][2][4][2], const Unit& u, int wr, int wc, int fr, int fq) const {
        const int row0 = u.pm * BM + wr * 64 + fr, col0 = u.pn * BM + wc * 32 + 8 * fq;
#pragma unroll
        for (int bj = 0; bj < 2; ++bj)
#pragma unroll
            for (int ai = 0; ai < 2; ++ai)
#pragma unroll
                for (int m = 0; m < 4; ++m) { const f32x4 v0 = acc[ai][bj][m][0], v1 = acc[ai][bj][m][1];
                    v2u w; w.x = pk4_fp8_scaled(v0[0], v0[1], v0[2], v0[3], W8_SCALE / Y8_SCALE); w.y = pk4_fp8_scaled(v1[0], v1[1], v1[2], v1[3], W8_SCALE / Y8_SCALE);
                    *(v2u*)(Y + (size_t)(row0 + ai * HALF + m * 16) * D + col0 + bj * HALF) = w; }
    }
};
}

#define XB_TMO      128
#define XB_XCNT(j)  (256  + 64 * (j))
#define XB_XSUB(j)  (1280 + 64 * (j))
#define XB_XGEN(j)  (2304 + 64 * (j))
#define XB_TOP      3328
#define XB_TOPGEN   3392
#define XCD_BAR_WORDS 3456
#define XB_SPIN_CAP (1u << 18)
__device__ __forceinline__ unsigned xb_ld(unsigned* p)              { return __hip_atomic_load(p, __ATOMIC_RELAXED, __HIP_MEMORY_SCOPE_AGENT); }
__device__ __forceinline__ unsigned xb_add(unsigned* p, unsigned v) { return __hip_atomic_fetch_add(p, v, __ATOMIC_RELAXED, __HIP_MEMORY_SCOPE_AGENT); }
__device__ __forceinline__ unsigned xb_xcc_id() { return (unsigned)__builtin_amdgcn_s_getreg((3 << 11) | 20) & 0xFu; }
#define XB_SPIN(cond, bar) do { unsigned _sp = 0; while (cond) { __builtin_amdgcn_s_sleep(1); \
    if ((++_sp & 255u) == 0u) { if (xb_ld(&(bar)[XB_TMO])) break; if (_sp > XB_SPIN_CAP) { atomicAdd(&(bar)[XB_TMO], 1u); break; } } } } while (0)
struct XcdBarrier { unsigned* bar; unsigned x; volatile LAS unsigned* st; };
__device__ __forceinline__ XcdBarrier xcd_barrier_post(unsigned* bar, volatile LAS unsigned* st) {
    XcdBarrier b; b.bar = bar; b.x = xb_xcc_id(); b.st = st;
    if (threadIdx.x == 0) (void)xb_add(&bar[XB_XCNT(b.x)], 1u);
    return b;
}
__device__ __forceinline__ void xcd_barrier_complete(unsigned* bar, unsigned x, unsigned& nloc, unsigned& nx) {
    const unsigned G = gridDim.x * gridDim.y * gridDim.z;
    unsigned sum, cnt, mine, sp = 0u;
    for (;;) {
        sum = 0u; cnt = 0u; mine = 0u;
#pragma unroll
        for (unsigned j = 0; j < 16; ++j) { const unsigned c = xb_ld(&bar[XB_XCNT(j)]); sum += c; cnt += (c > 0u) ? 1u : 0u; mine = (j == x) ? c : mine; }
        if (sum == G) break;
        __builtin_amdgcn_s_sleep(1);
        if ((++sp & 255u) == 0u) { if (xb_ld(&bar[XB_TMO])) break; if (sp > XB_SPIN_CAP) { atomicAdd(&bar[XB_TMO], 1u); break; } }
    }
    nloc = mine > 0u ? mine : 1u; nx = cnt > 0u ? cnt : 1u;
}
__device__ __forceinline__ void xcd_barrier(const XcdBarrier& b) {
    asm volatile("s_waitcnt vmcnt(0)" ::: "memory");
    __syncthreads();
    if (threadIdx.x == 0) {
        unsigned* bar = b.bar;
        __builtin_amdgcn_s_waitcnt(0);
        unsigned nloc = b.st[0], nx = b.st[1];
        if (nloc == 0u) { xcd_barrier_complete(bar, b.x, nloc, nx); b.st[0] = nloc; b.st[1] = nx; }
        const unsigned old = xb_add(&bar[XB_XSUB(b.x)], 1u);
        const unsigned gen = old / nloc;
        if (old + 1u == (gen + 1u) * nloc) {
            __builtin_amdgcn_fence(__ATOMIC_RELEASE, "agent");
            asm volatile("s_waitcnt vmcnt(0)" ::: "memory");
            const unsigned og = xb_add(&bar[XB_TOP], 1u);
            const unsigned tg = og / nx;
            if (og + 1u == (tg + 1u) * nx) xb_add(&bar[XB_TOPGEN], 1u);
            else XB_SPIN(xb_ld(&bar[XB_TOPGEN]) == tg, bar);
            __builtin_amdgcn_fence(__ATOMIC_ACQUIRE, "agent");
            xb_add(&bar[XB_XGEN(b.x)], 1u);
            asm volatile("s_waitcnt vmcnt(0)" ::: "memory");
        } else {
            XB_SPIN(xb_ld(&bar[XB_XGEN(b.x)]) == gen, bar);
            __builtin_amdgcn_fence(__ATOMIC_ACQUIRE, "agent");
            asm volatile("s_waitcnt vmcnt(0)" ::: "memory");
        }
    }
    __syncthreads();
}

struct Frame {
    LAS unsigned char* lds;
    volatile LAS unsigned* MISC;
    gu32* ctl;
    int tid, lane, wave, G, bx;
    float* out; unsigned char* ws;
};
struct Args { const float* in[27]; float* out; unsigned char* ws; int ph_lo, ph_hi, li, pad; };
enum { I_X = 0, I_C, I_WADA, I_BADA, I_N1G, I_WIN, I_CONVW, I_CONVB, I_CLNG, I_CLNB, I_LCW, I_LCB, I_LWA, I_LBA, I_LWX, I_LBX, I_LAM, I_MIXG, I_WOUT, I_N2G, I_WR, I_BR, I_WGU, I_BGU, I_WD, I_BD, I_FNG };

__device__ __forceinline__ float wave_sum(float v) {
#pragma unroll
    for (int o = 1; o < 64; o <<= 1) v += __shfl_xor(v, o);
    return v;
}

__device__ __forceinline__ void p0_transpose_item(const float* W, int K, int N, bf16* WT, int drow0, LAS float* scr, int k0, int n0, int lane) {
#pragma unroll 8
    for (int i = 0; i < 32; ++i) { const int kk = 2 * i + (lane >> 5); scr[kk * 33 + (lane & 31)] = W[(size_t)(k0 + kk) * N + n0 + (lane & 31)]; }
    LDS_WAIT(); asm volatile("" ::: "memory");
    const int c = lane & 7;
#pragma unroll
    for (int j = 0; j < 4; ++j) { const int n = (lane >> 3) + 8 * j; const LAS float* s = scr + (8 * c) * 33 + n;
        v4u o; o.x = pk2(s[0 * 33], s[1 * 33]); o.y = pk2(s[2 * 33], s[3 * 33]); o.z = pk2(s[4 * 33], s[5 * 33]); o.w = pk2(s[6 * 33], s[7 * 33]);
        *(GAS v4u*)(WT + (size_t)(drow0 + n) * K + k0 + 8 * c) = o; }
    LDS_WAIT(); asm volatile("" ::: "memory");
}
struct P0Item { const float* src; unsigned char* dst; int N; };
__device__ __forceinline__ void p0_fp8_load(const P0Item& it, f32x4 (&v)[16]) {
#pragma unroll
    for (int i = 0; i < 16; ++i) v[i] = *(const GAS f32x4*)(it.src + (size_t)(8 * i) * it.N);
}
__device__ __forceinline__ void p0_fp8_finish(const P0Item& it, const f32x4 (&v)[16], LAS float* scr, int lane) {
#pragma unroll
    for (int i = 0; i < 16; ++i) { LAS float* d = scr + (8 * i + (lane >> 3)) * 33 + 4 * (lane & 7); d[0] = v[i].x; d[1] = v[i].y; d[2] = v[i].z; d[3] = v[i].w; }
    LDS_WAIT(); asm volatile("" ::: "memory");
    const int kc = lane & 7;
#pragma unroll
    for (int j = 0; j < 4; ++j) { const int n = (lane >> 3) + 8 * j; const LAS float* s = scr + (16 * kc) * 33 + n;
        v4u o;
        o.x = __builtin_amdgcn_cvt_pk_fp8_f32(s[2 * 33] * W8_SCALE, s[3 * 33] * W8_SCALE, __builtin_amdgcn_cvt_pk_fp8_f32(s[0 * 33] * W8_SCALE, s[1 * 33] * W8_SCALE, 0, false), true);
        o.y = __builtin_amdgcn_cvt_pk_fp8_f32(s[6 * 33] * W8_SCALE, s[7 * 33] * W8_SCALE, __builtin_amdgcn_cvt_pk_fp8_f32(s[4 * 33] * W8_SCALE, s[5 * 33] * W8_SCALE, 0, false), true);
        o.z = __builtin_amdgcn_cvt_pk_fp8_f32(s[10 * 33] * W8_SCALE, s[11 * 33] * W8_SCALE, __builtin_amdgcn_cvt_pk_fp8_f32(s[8 * 33] * W8_SCALE, s[9 * 33] * W8_SCALE, 0, false), true);
        o.w = __builtin_amdgcn_cvt_pk_fp8_f32(s[14 * 33] * W8_SCALE, s[15 * 33] * W8_SCALE, __builtin_amdgcn_cvt_pk_fp8_f32(s[12 * 33] * W8_SCALE, s[13 * 33] * W8_SCALE, 0, false), true);
        *(GAS v4u*)(it.dst + (size_t)(8 * j) * 1024) = o; }
    LDS_WAIT(); asm volatile("" ::: "memory");
}
__device__ __forceinline__ void p0_router_item(const float* W, bf16* WH, bf16* WL, LAS float* scr, int k0, int lane) {
#pragma unroll 8
    for (int i = 0; i < 32; ++i) { const int kk = 2 * i + (lane >> 5); scr[kk * 33 + (lane & 31)] = W[(size_t)(k0 + kk) * NE + (lane & 31)]; }
    LDS_WAIT(); asm volatile("" ::: "memory");
    const int c = lane & 7;
#pragma unroll
    for (int j = 0; j < 4; ++j) { const int n = (lane >> 3) + 8 * j; const LAS float* s = scr + (8 * c) * 33 + n;
        float v[8]; unsigned h[8], l[8];
#pragma unroll
        for (int e = 0; e < 8; ++e) { v[e] = s[e * 33]; h[e] = f2bf(v[e]); l[e] = f2bf(v[e] - bf2f(h[e])); }
        v4u oh, ol; oh.x = h[0] | (h[1] << 16); oh.y = h[2] | (h[3] << 16); oh.z = h[4] | (h[5] << 16); oh.w = h[6] | (h[7] << 16);
        ol.x = l[0] | (l[1] << 16); ol.y = l[2] | (l[3] << 16); ol.z = l[4] | (l[5] << 16); ol.w = l[6] | (l[7] << 16);
        *(GAS v4u*)(WH + (size_t)n * D + k0 + 8 * c) = oh; *(GAS v4u*)(WL + (size_t)n * D + k0 + 8 * c) = ol; }
    LDS_WAIT(); asm volatile("" ::: "memory");
}
__device__ __forceinline__ void p0_mod_item(Frame& F, const Args& args, LAS float* scr, int item) {
    const int cg = item % 96, ks = item / 96, col = cg * 64 + F.lane, k0 = ks * 256;
    const float* c = args.in[I_C]; const float* W = args.in[I_WADA];
#pragma unroll 4
    for (int i = 0; i < 32; ++i) { const int idx = i * 64 + F.lane, b = idx >> 8, kk = idx & 255; const float v = c[b * D + k0 + kk]; scr[idx] = v / (1.0f + __expf(-v)); }
    LDS_WAIT(); asm volatile("" ::: "memory");
    float acc[8];
#pragma unroll
    for (int b = 0; b < 8; ++b) acc[b] = 0.f;
#pragma unroll 4
    for (int kk = 0; kk < 256; kk += 4) {
        const float* wp = W + (size_t)(k0 + kk) * NMODW + col;
        const float w0 = wp[0], w1 = wp[NMODW], w2 = wp[2 * NMODW], w3 = wp[3 * NMODW];
#pragma unroll
        for (int b = 0; b < 8; ++b) { const f32x4 cv = *(const LAS f32x4*)(scr + b * 256 + kk); acc[b] += (cv.x * w0 + cv.y * w1) + (cv.z * w2 + cv.w * w3); }
    }
    float* mp = (float*)(F.ws + WS_MODP);
#pragma unroll
    for (int b = 0; b < 8; ++b) mp[(size_t)(ks * 8 + b) * NMODW + col] = acc[b];
    LDS_WAIT(); asm volatile("" ::: "memory");
}
__device__ __forceinline__ void p0_lrufrag_item(const Args& args, unsigned char* ws, int h, int lane) {
    const int j = lane & 15, q = lane >> 4;
#pragma unroll 1
    for (int f = 0; f < 16; ++f) { const int mat = f >> 3, n = (f >> 1) & 3, s = f & 1;
        const float* p = (mat ? args.in[14] : args.in[12]) + (size_t)(h * 64 + 32 * s + 8 * q) * 64 + 16 * n + j;
        v4u o; o.x = pk2(p[0], p[64]); o.y = pk2(p[128], p[192]); o.z = pk2(p[256], p[320]); o.w = pk2(p[384], p[448]);
        *((GAS v4u*)(ws + WS_LRUB) + (size_t)((h * 2 + mat) * 8 + n * 2 + s) * 64 + lane) = o; }
}
__device__ __forceinline__ int glu_row(int n, int half) {
    return n < half ? 256 * (n >> 7) + (n & 127) : 256 * ((n - half) >> 7) + 128 + ((n - half) & 127);
}
__device__ __forceinline__ void p0_prologue(Frame& F, const Args& args) {
    LAS float* scr = (LAS float*)(F.lds + F.wave * 16896);
    const int gw = F.bx * NWAVES + F.wave, NGW = F.G * NWAVES;
    if (gw >= NGW - 8) p0_lrufrag_item(args, F.ws, gw - (NGW - 8), F.lane);
    constexpr int I_MOD = 96 * 4, I_RT = 16, I_IN = 16 * 64, I_OUT = 16 * 32, I_GU = 32 * 8 * 64, I_DN = 32 * 8 * 32;
    constexpr int NITEMS = I_MOD + I_RT + I_IN + I_OUT + I_GU + I_DN;
    for (int it = gw; it < NITEMS; it += NGW) {
        int r = it;
        if (r < I_MOD) { p0_mod_item(F, args, scr, r); continue; } r -= I_MOD;
        if (r < I_RT) { p0_router_item(args.in[I_WR], (bf16*)(F.ws + WS_WRH), (bf16*)(F.ws + WS_WRL), scr, 64 * r, F.lane); continue; } r -= I_RT;
        if (r < I_IN) { const int kb = r >> 6, nb = r & 63, n0 = 32 * nb; const int dr = n0 < 1024 ? glu_row(n0, 512) : n0;
            p0_transpose_item(args.in[I_WIN], D, 2048, (bf16*)(F.ws + WS_WIN), dr, scr, 64 * kb, n0, F.lane); continue; } r -= I_IN;
        if (r < I_OUT) { const int kb = r >> 5, nb = r & 31; p0_transpose_item(args.in[I_WOUT], D, D, (bf16*)(F.ws + WS_WOUT), 32 * nb, scr, 64 * kb, 32 * nb, F.lane); continue; }
        break;
    }
    constexpr int I_PRE = I_MOD + I_RT + I_IN + I_OUT;
    auto decode = [&](int it, P0Item& d) { int r = it - I_PRE; const int lane = F.lane;
        if (r < I_GU) { const int e = r >> 9, q = r & 511, kb = q >> 6, nb = q & 63, n0 = 32 * nb;
            d.src = args.in[I_WGU] + (size_t)e * D * 2048 + (size_t)(128 * kb + (lane >> 3)) * 2048 + n0 + 4 * (lane & 7); d.N = 2048;
            d.dst = F.ws + WS_WGU + (size_t)e * 2048 * D + (size_t)(glu_row(n0, 1024) + (lane >> 3)) * 1024 + 128 * kb + 16 * (lane & 7); }
        else { r -= I_GU; const int e = r >> 8, q = r & 255, kb = q >> 5, nb = q & 31;
            d.src = args.in[I_WD] + (size_t)e * DE * D + (size_t)(128 * kb + (lane >> 3)) * D + 32 * nb + 4 * (lane & 7); d.N = D;
            d.dst = F.ws + WS_WD + (size_t)e * D * DE + (size_t)(32 * nb + (lane >> 3)) * 1024 + 128 * kb + 16 * (lane & 7); } };
    int it = gw; while (it < I_PRE) it += NGW;
    if (it < NITEMS) {
        P0Item da, db; f32x4 va[16], vb[16];
        decode(it, da); p0_fp8_load(da, va);
        for (;;) {
            int nx = it + NGW; const bool hb = nx < NITEMS;
            if (hb) { decode(nx, db); p0_fp8_load(db, vb); }
            p0_fp8_finish(da, va, scr, F.lane);
            if (!hb) break;
            it = nx; nx = it + NGW; const bool ha = nx < NITEMS;
            if (ha) { decode(nx, da); p0_fp8_load(da, va); }
            p0_fp8_finish(db, vb, scr, F.lane);
            if (!ha) break;
            it = nx;
        }
    }
}
__device__ __forceinline__ float mod_from_parts(const float* mp, const float* bada, int b, int j) {
    float s = bada[j];
#pragma unroll
    for (int ks = 0; ks < 4; ++ks) s += mp[(size_t)(ks * 8 + b) * NMODW + j];
    return s;
}
__device__ __forceinline__ f32x4 mod_from_parts4(const float* mp, const float* bada, int b, int j) {
    f32x4 s = *(const f32x4*)(bada + j);
#pragma unroll
    for (int ks = 0; ks < 4; ++ks) s += *(const f32x4*)(mp + (size_t)(ks * 8 + b) * NMODW + j);
    return s;
}
__device__ __forceinline__ void p1_norm1(Frame& F, const Args& args) {
    const float* mp = (const float*)(F.ws + WS_MODP); const float* bada = args.in[I_BADA]; float* mf = (float*)(F.ws + WS_MODF);
    for (int idx = F.bx * 512 + F.tid; idx < NB * NMODW; idx += F.G * 512) { const int b = idx / NMODW, j = idx - b * NMODW; mf[idx] = mod_from_parts(mp, bada, b, j); }
    const float* x = args.in[I_X]; const float* g1 = args.in[I_N1G]; bf16* H = (bf16*)(F.ws + WS_H);
    for (int rb = F.bx; rb < T / 128; rb += F.G) {
        const int b = rb >> 5;
        f32x4 A1[4], B1[4];
#pragma unroll
        for (int i = 0; i < 4; ++i) { const int k = 256 * i + 4 * F.lane; A1[i] = *(const f32x4*)(g1 + k) * (mod_from_parts4(mp, bada, b, D + k) + 1.0f); B1[i] = mod_from_parts4(mp, bada, b, k); }
        for (int r = F.wave; r < 128; r += NWAVES) {
            const size_t row = (size_t)rb * 128 + r;
            const GAS f32x4* xr = (const GAS f32x4*)(x + row * D) + F.lane;
            f32x4 v[4]; float s = 0.f;
#pragma unroll
            for (int i = 0; i < 4; ++i) { v[i] = xr[64 * i]; s += (v[i].x * v[i].x + v[i].y * v[i].y) + (v[i].z * v[i].z + v[i].w * v[i].w); }
            const float rstd = rsqrtf(wave_sum(s) * (1.0f / D) + EPS);
            GAS v2u* o8 = (GAS v2u*)(H + row * D) + F.lane;
#pragma unroll
            for (int i = 0; i < 4; ++i) { const f32x4 h = v[i] * rstd * A1[i] + B1[i]; v2u w; w.x = pk2(h.x, h.y); w.y = pk2(h.z, h.w); o8[64 * i] = w; }
        }
    }
}

template <int N, int OFF> struct TRed {
    template <int M> static __device__ __forceinline__ void run(float (&v)[M], int lane) {
        constexpr int half = N / 2; const bool up = (lane & OFF) != 0;
#pragma unroll
        for (int i = 0; i < half; ++i) { const float send = up ? v[i] : v[i + half]; const float keep = up ? v[i + half] : v[i]; v[i] = keep + __shfl_xor(send, OFF); }
        if constexpr (half > 1) TRed<half, OFF / 2>::run(v, lane);
    }
};
template <int N> __device__ __forceinline__ float treduce(float (&v)[N], int lane) {
    TRed<N, 32>::run(v, lane);
    if (N == 32) v[0] += __shfl_xor(v[0], 1);
    return v[0];
}

__device__ __forceinline__ void conv_unit(Frame& F, const Args& args, int u) {
    const int t0 = 64 * u; const bool first = (t0 & (SEQ - 1)) == 0;
    LAS unsigned char* tile = F.lds;
    LAS float* RED = (LAS float*)(F.lds + 98304);
    LAS f32x2* ST = (LAS f32x2*)(F.lds + 98304 + 2048);
    LAS float* RED2 = (LAS float*)(F.lds + 98304 + 4096);
    LAS float* ST2 = (LAS float*)(F.lds + 98304 + 6144);
    const bf16* V = (const bf16*)(F.ws + WS_V);
    for (int p = F.tid; p < 94 * 64; p += 512) { const int row = p >> 6, c16 = p & 63;
        v4u val = (v4u){0u, 0u, 0u, 0u};
        if (!(first && row < 30)) val = *(const GAS v4u*)(V + (size_t)(t0 - 30 + row) * DC + c16 * 8);
        *(LAS v4u*)(tile + row * 1024 + c16 * 16) = val; }
    __syncthreads();
    int otid = F.tid; asm volatile("" : "+v"(otid));
    const int cp = otid & 255, th = otid >> 8, wq = F.wave & 3;
    f32x2 wv[31];
    { const float* cw = args.in[I_CONVW] + 2 * cp;
#pragma unroll
      for (int k = 0; k < 31; ++k) wv[k] = *(const f32x2*)(cw + k * DC); }
    const f32x2 cb = *(const f32x2*)(args.in[I_CONVB] + 2 * cp);
    float o0[32], o1[32];
#pragma unroll
    for (int g = 0; g < 4; ++g) {
        f32x2 av[8];
#pragma unroll
        for (int j = 0; j < 8; ++j) av[j] = cb;
        const LAS unsigned char* tp = tile + (32 * th + 8 * g) * 1024 + cp * 4;
#pragma unroll
        for (int i = 0; i < 38; ++i) { const unsigned xw = *(const LAS unsigned*)(tp + i * 1024); const f32x2 xx = {bflo(xw), bfhi(xw)};
#pragma unroll
            for (int j = 0; j < 8; ++j) { const int k = i - j; if (k >= 0 && k <= 30) av[j] = __builtin_elementwise_fma(wv[k], xx, av[j]); } }
#pragma unroll
        for (int j = 0; j < 8; ++j) { o0[8 * g + j] = av[j].x; o1[8 * g + j] = av[j].y; }
    }
    { float vals[64];
#pragma unroll
      for (int t = 0; t < 32; ++t) { vals[t] = o0[t] + o1[t]; vals[32 + t] = o0[t] * o0[t] + o1[t] * o1[t]; }
      const float r = treduce<64>(vals, F.lane);
      RED[(th * 4 + wq) * 64 + F.lane] = r; }
    __syncthreads();
    if (F.tid < 64) { const int hh = F.tid >> 5, tk = F.tid & 31; float s1 = 0.f, s2 = 0.f;
#pragma unroll
        for (int w = 0; w < 4; ++w) { s1 += RED[(hh * 4 + w) * 64 + tk]; s2 += RED[(hh * 4 + w) * 64 + 32 + tk]; }
        const float mean = s1 * (1.0f / DC); const float var = fmaxf(s2 * (1.0f / DC) - mean * mean, 0.f);
        ST[F.tid] = (f32x2){mean, rsqrtf(var + EPS)}; }
    __syncthreads();
    const f32x2 lg = *(const f32x2*)(args.in[I_CLNG] + 2 * cp), lb = *(const f32x2*)(args.in[I_CLNB] + 2 * cp);
    { float vals[32];
#pragma unroll
      for (int t = 0; t < 32; ++t) { const f32x2 st = ST[th * 32 + t];
          const float y0 = (o0[t] - st.x) * st.y * lg.x + lb.x, y1 = (o1[t] - st.x) * st.y * lg.y + lb.y;
          o0[t] = y0 * sigmoidf_(y0); o1[t] = y1 * sigmoidf_(y1); vals[t] = o0[t] * o0[t] + o1[t] * o1[t]; }
      const float r = treduce<32>(vals, F.lane);
      if ((F.lane & 1) == 0) RED2[(th * 4 + wq) * 32 + (F.lane >> 1)] = r; }
    __syncthreads();
    if (F.tid < 64) { const int hh = F.tid >> 5, tk = F.tid & 31; float s = 0.f;
#pragma unroll
        for (int w = 0; w < 4; ++w) s += RED2[(hh * 4 + w) * 32 + tk];
        ST2[F.tid] = rsqrtf(s * (1.0f / DC) + EPS); }
    __syncthreads();
    const f32x2 mg = *(const f32x2*)(args.in[I_MIXG] + 2 * cp);
    bf16* YA = (bf16*)(F.ws + WS_H);
#pragma unroll
    for (int t = 0; t < 32; ++t) { const float rs = ST2[th * 32 + t];
        *(GAS unsigned*)(YA + (size_t)(t0 + 32 * th + t) * D + 2 * cp) = pk2(o0[t] * rs * mg.x, o1[t] * rs * mg.y); }
}

constexpr int LRU_WB = 12032;
__device__ __forceinline__ void lru_unit(Frame& F, const Args& args, int ck) {
    int lane = F.lane; asm volatile("" : "+v"(lane));
    const int h = F.wave, j = lane & 15, q = lane >> 4;
    const int cs = ck & 31, t0 = ck * 128;
    LAS unsigned char* wl = F.lds + h * LRU_WB;
    LAS unsigned char* xt = wl + 35 * 144;
    LAS unsigned char* pr = xt + 16 * 144;
    const bf16* UREC = (const bf16*)(F.ws + WS_UREC);
    float* SUMA = (float*)(F.ws + WS_SUMA); float* SUMH = (float*)(F.ws + WS_SUMH);
    LAS float* cst = (LAS float*)(F.lds + 8 * LRU_WB) + h * 512;
    { const int c = 64 * h + lane;
#pragma unroll
      for (int k = 0; k < 4; ++k) cst[k * 64 + lane] = args.in[I_LCW][k * 512 + c];
      cst[4 * 64 + lane] = args.in[I_LCB][c]; cst[5 * 64 + lane] = args.in[I_LBA][c]; cst[6 * 64 + lane] = args.in[I_LBX][c];
      const float z = -args.in[I_LAM][c]; cst[7 * 64 + lane] = fmaxf(z, 0.f) + log1pf(__expf(-fabsf(z))); }
    bf16x8 Ba[4][2], Bx[4][2];
    const unsigned l16 = (unsigned)lane * 16u;
#pragma unroll
    for (int n = 0; n < 4; ++n)
#pragma unroll
        for (int s = 0; s < 2; ++s) { const GAS unsigned char* fb = (const GAS unsigned char*)(F.ws + WS_LRUB) + (size_t)h * 16384 + (n * 2 + s) * 1024;
            Ba[n][s] = *(const GAS bf16x8*)(fb + l16); Bx[n][s] = *(const GAS bf16x8*)(fb + 8192 + l16); }
    float hc[4], Pt[4];
#pragma unroll
    for (int n = 0; n < 4; ++n) { hc[n] = 0.f; Pt[n] = 1.f; }
    const bool qodd = (q & 1) != 0, qhi = q >= 2;
    const unsigned lrow = (unsigned)(lane >> 3) * 1024u + (unsigned)h * 128u + (unsigned)(lane & 7) * 16u;
    v4u uv[5];
#pragma unroll
    for (int i = 0; i < 5; ++i) { const int p = lane + 64 * i; uv[i] = (v4u){0u, 0u, 0u, 0u};
        if (p < 280 && !(cs == 0 && (p >> 3) < 3)) { const GAS unsigned char* ub = (const GAS unsigned char*)UREC + (size_t)(t0 - 3 + 8 * i) * 1024; uv[i] = *(const GAS v4u*)(ub + lrow); } }
    for (int sc = 0; sc < 4; ++sc) {
        const int ts = t0 + 32 * sc;
#pragma unroll
        for (int i = 0; i < 5; ++i) { const int p = lane + 64 * i; if (p < 280) *(LAS v4u*)(wl + (p >> 3) * 144 + (p & 7) * 16) = uv[i]; }
        if (sc < 3) {
#pragma unroll
            for (int i = 0; i < 5; ++i) { const int p = lane + 64 * i;
                if (p < 280) { const GAS unsigned char* ub = (const GAS unsigned char*)UREC + (size_t)(ts + 32 - 3 + 8 * i) * 1024; uv[i] = *(const GAS v4u*)(ub + lrow); } } }
#pragma unroll 1
        for (int tile = 0; tile < 2; ++tile) {
            float xr[4][4];
#pragma unroll
            for (int n = 0; n < 4; ++n) { float uu[7];
#pragma unroll
                for (int m = 0; m < 7; ++m) uu[m] = bf2f(*(const LAS unsigned short*)(wl + (16 * tile + 4 * q + m) * 144 + (16 * n + j) * 2));
                const float c0 = cst[16 * n + j], c1 = cst[64 + 16 * n + j], c2 = cst[128 + 16 * n + j], c3 = cst[192 + 16 * n + j], cbn = cst[256 + 16 * n + j];
#pragma unroll
                for (int r = 0; r < 4; ++r) xr[n][r] = cbn + ((c0 * uu[r] + c1 * uu[r + 1]) + (c2 * uu[r + 2] + c3 * uu[r + 3])); }
#pragma unroll
            for (int n = 0; n < 4; ++n)
#pragma unroll
                for (int r = 0; r < 4; ++r) *(LAS unsigned short*)(xt + (4 * q + r) * 144 + (16 * n + j) * 2) = (unsigned short)f2bf(xr[n][r]);
            const bf16x8 a0 = *(const LAS bf16x8*)(xt + j * 144 + 16 * q), a1 = *(const LAS bf16x8*)(xt + j * 144 + 64 + 16 * q);
            f32x4 za[4], zx[4];
#pragma unroll
            for (int n = 0; n < 4; ++n) {
                za[n] = (f32x4){0.f, 0.f, 0.f, 0.f}; zx[n] = (f32x4){0.f, 0.f, 0.f, 0.f};
                za[n] = __builtin_amdgcn_mfma_f32_16x16x32_bf16(a0, Ba[n][0], za[n], 0, 0, 0); za[n] = __builtin_amdgcn_mfma_f32_16x16x32_bf16(a1, Ba[n][1], za[n], 0, 0, 0);
                zx[n] = __builtin_amdgcn_mfma_f32_16x16x32_bf16(a0, Bx[n][0], zx[n], 0, 0, 0); zx[n] = __builtin_amdgcn_mfma_f32_16x16x32_bf16(a1, Bx[n][1], zx[n], 0, 0, 0); }
#pragma unroll
            for (int n = 0; n < 4; ++n) {
                float pp[4], hh[4];
                const float ban = cst[320 + 16 * n + j], bxn = cst[384 + 16 * n + j], spn = cst[448 + 16 * n + j];
#pragma unroll
                for (int r = 0; r < 4; ++r) { const float rg = sigmoidf_(za[n][r] + ban), ig = sigmoidf_(zx[n][r] + bxn);
                    const float la = -8.0f * rg * spn; const float a = __expf(la); const float mult = __builtin_amdgcn_sqrtf(fmaxf(1.0f - a * a, 0.f)); const float inp = mult * (ig * xr[n][r]);
                    if (r == 0) { pp[0] = a; hh[0] = inp; } else { pp[r] = a * pp[r - 1]; hh[r] = a * hh[r - 1] + inp; } }
                const float P = pp[3], H = hh[3];
                float Pn, Hn;
                { const auto rp = __builtin_amdgcn_permlane16_swap(__builtin_bit_cast(unsigned, P), __builtin_bit_cast(unsigned, P), false, false);
                  const auto rh = __builtin_amdgcn_permlane16_swap(__builtin_bit_cast(unsigned, H), __builtin_bit_cast(unsigned, H), false, false);
                  Pn = __builtin_bit_cast(float, qodd ? rp[0] : rp[1]); Hn = __builtin_bit_cast(float, qodd ? rh[0] : rh[1]); }
                const float Ptp = P * Pn, Htp = qodd ? (P * Hn + H) : (Pn * H + Hn);
                float Po, Ho;
                { const auto rp = __builtin_amdgcn_permlane32_swap(__builtin_bit_cast(unsigned, Ptp), __builtin_bit_cast(unsigned, Ptp), false, false);
                  const auto rh = __builtin_amdgcn_permlane32_swap(__builtin_bit_cast(unsigned, Htp), __builtin_bit_cast(unsigned, Htp), false, false);
                  Po = __builtin_bit_cast(float, qhi ? rp[0] : rp[1]); Ho = __builtin_bit_cast(float, qhi ? rh[0] : rh[1]); }
                float Pe = qodd ? Pn : 1.0f, He = qodd ? Hn : 0.0f;
                if (qhi) { He = Pe * Ho + He; Pe = Pe * Po; }
                const float Ptl = Ptp * Po, Htl = qhi ? (Ptp * Ho + Htp) : (Po * Htp + Ho);
                const float hq = Pe * hc[n] + He, pq = Pt[n] * Pe;
#pragma unroll
                for (int r = 0; r < 4; ++r) { *(LAS unsigned short*)(wl + (16 * tile + 4 * q + r) * 144 + (16 * n + j) * 2) = (unsigned short)f2bf(pp[r] * hq + hh[r]);
                    *(LAS unsigned short*)(pr + (16 * tile + 4 * q + r) * 144 + (16 * n + j) * 2) = (unsigned short)f2bf(pq * pp[r]); }
                hc[n] = Ptl * hc[n] + Htl; Pt[n] *= Ptl;
            }
        }
#pragma unroll
        for (int i = 0; i < 4; ++i) { const int tk = (lane >> 3) + 8 * i; const v4u hw = *(const LAS v4u*)(wl + tk * 144 + 16 * (lane & 7)), pw = *(const LAS v4u*)(pr + tk * 144 + 16 * (lane & 7));
            GAS unsigned char* hb = (GAS unsigned char*)(F.ws + WS_HLOC) + (size_t)(ts + 8 * i) * 1024; GAS unsigned char* pb = (GAS unsigned char*)(F.ws + WS_PCUM) + (size_t)(ts + 8 * i) * 1024;
            *(GAS v4u*)(hb + lrow) = hw; *(GAS v4u*)(pb + lrow) = pw; }
    }
    { const float pv = q == 0 ? Pt[0] : q == 1 ? Pt[1] : q == 2 ? Pt[2] : Pt[3];
      const float hv = q == 0 ? hc[0] : q == 1 ? hc[1] : q == 2 ? hc[2] : hc[3];
      SUMA[(size_t)ck * 512 + 64 * h + lane] = pv; SUMH[(size_t)ck * 512 + 64 * h + lane] = hv; }
}
__device__ __forceinline__ void p4_lru_apply(Frame& F, const Args& args) {
    const int lane = F.lane;
    const float* SUMA = (const float*)(F.ws + WS_SUMA); const float* SUMH = (const float*)(F.ws + WS_SUMH);
    bf16* YA = (bf16*)(F.ws + WS_H);
    for (int ck = F.bx; ck < T / 128; ck += F.G) {
        const int b = ck >> 5, cs = ck & 31;
        float hin[8], mg[8];
#pragma unroll
        for (int e = 0; e < 8; ++e) hin[e] = 0.f;
        for (int c2 = 0; c2 < cs; ++c2) { const size_t o = (size_t)(b * 32 + c2) * 512 + 8 * lane;
            const f32x4 a0 = *(const f32x4*)(SUMA + o), a1 = *(const f32x4*)(SUMA + o + 4), h0 = *(const f32x4*)(SUMH + o), h1 = *(const f32x4*)(SUMH + o + 4);
#pragma unroll
            for (int e = 0; e < 4; ++e) { hin[e] = a0[e] * hin[e] + h0[e]; hin[4 + e] = a1[e] * hin[4 + e] + h1[e]; } }
        { const f32x4 m0 = *(const f32x4*)(args.in[I_MIXG] + 512 + 8 * lane), m1 = *(const f32x4*)(args.in[I_MIXG] + 512 + 8 * lane + 4);
#pragma unroll
          for (int e = 0; e < 4; ++e) { mg[e] = m0[e]; mg[4 + e] = m1[e]; } }
        for (int r = F.wave; r < 128; r += NWAVES) {
            const size_t t = (size_t)ck * 128 + r;
            const v4u hw = *((const GAS v4u*)(F.ws + WS_HLOC + t * 1024) + lane), pw = *((const GAS v4u*)(F.ws + WS_PCUM + t * 1024) + lane), gw = *((const GAS v4u*)(F.ws + WS_GG + t * 1024) + lane);
            float y[8];
            y[0] = bflo(gw.x) * (bflo(hw.x) + bflo(pw.x) * hin[0]); y[1] = bfhi(gw.x) * (bfhi(hw.x) + bfhi(pw.x) * hin[1]);
            y[2] = bflo(gw.y) * (bflo(hw.y) + bflo(pw.y) * hin[2]); y[3] = bfhi(gw.y) * (bfhi(hw.y) + bfhi(pw.y) * hin[3]);
            y[4] = bflo(gw.z) * (bflo(hw.z) + bflo(pw.z) * hin[4]); y[5] = bfhi(gw.z) * (bfhi(hw.z) + bfhi(pw.z) * hin[5]);
            y[6] = bflo(gw.w) * (bflo(hw.w) + bflo(pw.w) * hin[6]); y[7] = bfhi(gw.w) * (bfhi(hw.w) + bfhi(pw.w) * hin[7]);
            float s = 0.f;
#pragma unroll
            for (int e = 0; e < 8; ++e) s += y[e] * y[e];
            const float rs = rsqrtf(wave_sum(s) * (1.0f / 512.0f) + EPS);
            v4u w; w.x = pk2(y[0] * rs * mg[0], y[1] * rs * mg[1]); w.y = pk2(y[2] * rs * mg[2], y[3] * rs * mg[3]);
            w.z = pk2(y[4] * rs * mg[4], y[5] * rs * mg[5]); w.w = pk2(y[6] * rs * mg[6], y[7] * rs * mg[7]);
            *((GAS v4u*)(YA + t * D + 512) + lane) = w;
        }
    }
}

__device__ __forceinline__ void p6_router(Frame& F, const Args& args) {
    constexpr int RS = 2064;
    LAS unsigned char* HI = F.lds; LAS unsigned char* LO = F.lds + 16 * RS;
    LAS float* PLOG = (LAS float*)(F.lds + 32 * RS);
    LAS int* SEL = (LAS int*)(F.lds + 32 * RS + 16384);
    LAS int* CNTW = (LAS int*)(F.lds + 32 * RS + 16384 + 2048);
    LAS float* LOGT = (LAS float*)(F.lds + 32 * RS + 16384 + 4096);
    LAS int* EBASE = (LAS int*)(F.lds + 32 * RS + 16384 + 3072);
    const float brv = args.in[I_BR][F.tid & 31];
    const bf16* X1 = (const bf16*)(F.ws + WS_X1); unsigned char* H2 = F.ws + WS_H; const float* mf = (const float*)(F.ws + WS_MODF);
    const bf16* WRH = (const bf16*)(F.ws + WS_WRH); const bf16* WRL = (const bf16*)(F.ws + WS_WRL);
    int* TOPI = (int*)(F.ws + WS_TOPI); float* TOPG = (float*)(F.ws + WS_TOPG); int* ROWTOK = (int*)(F.ws + WS_ROWTOK); int* POSOF = (int*)(F.ws + WS_POSOF);
    const int lane = F.lane, w = F.wave, j = lane & 15, q = lane >> 4;
    for (int rb = F.bx; rb < T / 128; rb += F.G) {
        const int b = rb >> 5;
        f32x4 A2[4], B2[4];
#pragma unroll
        for (int i = 0; i < 4; ++i) { const int k = 256 * i + 4 * lane; const f32x4 g = *(const f32x4*)(args.in[I_N2G] + k), sc = *(const f32x4*)(mf + (size_t)b * NMODW + 4 * D + k);
            A2[i] = g * (sc + 1.0f); B2[i] = *(const f32x4*)(mf + (size_t)b * NMODW + 3 * D + k); }
        bf16x8 bh[4][2], bl[4][2];
#pragma unroll
        for (int s = 0; s < 4; ++s)
#pragma unroll
            for (int n = 0; n < 2; ++n) { const size_t o = (size_t)(16 * n + j) * D + 128 * w + 32 * s + 8 * q; bh[s][n] = *(const GAS bf16x8*)(WRH + o); bl[s][n] = *(const GAS bf16x8*)(WRL + o); }
        v2u xb[2][4];
#pragma unroll
        for (int rr = 0; rr < 2; ++rr)
#pragma unroll
            for (int i = 0; i < 4; ++i) xb[rr][i] = *((const GAS v2u*)(X1 + ((size_t)rb * 128 + 2 * w + rr) * D) + lane + 64 * i);
        for (int tile = 0; tile < 8; ++tile) {
#pragma unroll
            for (int rr = 0; rr < 2; ++rr) { const int r = 2 * w + rr; const size_t t = (size_t)rb * 128 + 16 * tile + r;
                float s = 0.f; f32x4 xv[4];
#pragma unroll
                for (int i = 0; i < 4; ++i) { xv[i] = (f32x4){bflo(xb[rr][i].x), bfhi(xb[rr][i].x), bflo(xb[rr][i].y), bfhi(xb[rr][i].y)}; s += (xv[i].x * xv[i].x + xv[i].y * xv[i].y) + (xv[i].z * xv[i].z + xv[i].w * xv[i].w); }
                const float rstd = rsqrtf(wave_sum(s) * (1.0f / D) + EPS);
#pragma unroll
                for (int i = 0; i < 4; ++i) { const f32x4 hv = xv[i] * rstd * A2[i] + B2[i];
                    unsigned hb[4], lb[4];
#pragma unroll
                    for (int e = 0; e < 4; ++e) { hb[e] = f2bf(hv[e]); lb[e] = f2bf(hv[e] - bf2f(hb[e])); }
                    v2u wh, wl2; wh.x = hb[0] | (hb[1] << 16); wh.y = hb[2] | (hb[3] << 16); wl2.x = lb[0] | (lb[1] << 16); wl2.y = lb[2] | (lb[3] << 16);
                    *((GAS unsigned*)(H2 + t * D) + lane + 64 * i) = __builtin_amdgcn_cvt_pk_fp8_f32(hv[2], hv[3], __builtin_amdgcn_cvt_pk_fp8_f32(hv[0], hv[1], 0, false), true);
                    *(LAS v2u*)(HI + r * RS + (4 * lane + 256 * i) * 2) = wh; *(LAS v2u*)(LO + r * RS + (4 * lane + 256 * i) * 2) = wl2; }
            }
            if (tile < 7) {
#pragma unroll
                for (int rr = 0; rr < 2; ++rr)
#pragma unroll
                    for (int i = 0; i < 4; ++i) xb[rr][i] = *((const GAS v2u*)(X1 + ((size_t)rb * 128 + 16 * (tile + 1) + 2 * w + rr) * D) + lane + 64 * i);
            }
            __syncthreads();
            f32x4 acc[2]; acc[0] = (f32x4){0.f, 0.f, 0.f, 0.f}; acc[1] = acc[0];
#pragma unroll
            for (int s = 0; s < 4; ++s) { const int ko = (128 * w + 32 * s + 8 * q) * 2;
                const bf16x8 ah = *(const LAS bf16x8*)(HI + j * RS + ko), al = *(const LAS bf16x8*)(LO + j * RS + ko);
#pragma unroll
                for (int n = 0; n < 2; ++n) { acc[n] = __builtin_amdgcn_mfma_f32_16x16x32_bf16(ah, bh[s][n], acc[n], 0, 0, 0);
                    acc[n] = __builtin_amdgcn_mfma_f32_16x16x32_bf16(ah, bl[s][n], acc[n], 0, 0, 0); acc[n] = __builtin_amdgcn_mfma_f32_16x16x32_bf16(al, bh[s][n], acc[n], 0, 0, 0); } }
#pragma unroll
            for (int n = 0; n < 2; ++n)
#pragma unroll
                for (int r = 0; r < 4; ++r) PLOG[(w * 16 + 4 * q + r) * 32 + 16 * n + j] = acc[n][r];
            __syncthreads();
            { const int tk = F.tid >> 5, e = F.tid & 31;
              float lg = brv;
#pragma unroll
              for (int w2 = 0; w2 < 8; ++w2) lg += PLOG[(w2 * 16 + tk) * 32 + e];
              LOGT[(16 * tile + tk) * 33 + e] = lg; }
        }
        __syncthreads();
        if (F.tid < 128) {
            const LAS float* lp = LOGT + F.tid * 33;
            float t0 = -3.0e38f, t1 = -3.0e38f, t2 = -3.0e38f, t3 = -3.0e38f; int i0 = 0, i1 = 0, i2 = 0, i3 = 0;
#pragma unroll
            for (int e = 0; e < 32; ++e) { const float v = lp[e];
                if (v > t3) { if (v > t2) { t3 = t2; i3 = i2; if (v > t1) { t2 = t1; i2 = i1; if (v > t0) { t1 = t0; i1 = i0; t0 = v; i0 = e; } else { t1 = v; i1 = e; } } else { t2 = v; i2 = e; } } else { t3 = v; i3 = e; } } }
            const float e1 = __expf(t1 - t0), e2 = __expf(t2 - t0), e3 = __expf(t3 - t0); const float inv = 1.0f / (1.0f + e1 + e2 + e3);
            const size_t t = (size_t)rb * 128 + F.tid;
            *(GAS v4u*)(TOPI + t * 4) = (v4u){(unsigned)i0, (unsigned)i1, (unsigned)i2, (unsigned)i3};
            *(GAS f32x4*)(TOPG + t * 4) = (f32x4){inv, e1 * inv, e2 * inv, e3 * inv};
            *(LAS v4u*)(SEL + F.tid * 4) = (v4u){(unsigned)i0, (unsigned)i1, (unsigned)i2, (unsigned)i3};
        }
        __syncthreads();
        { const int myE = SEL[F.tid]; int rk = 0, cm = 0;
#pragma unroll 1
          for (int e = 0; e < 32; ++e) { const unsigned long long m = __ballot(myE == e); if (myE == e) rk = __popcll(m & ((1ull << lane) - 1ull)); if (lane == e) cm = __popcll(m); }
          if (lane < 32) CNTW[w * 32 + lane] = cm;
          __syncthreads();
          int base = 0;
          for (int w2 = 0; w2 < w; ++w2) base += CNTW[w2 * 32 + myE];
          if (F.tid < 32) { int tot = 0;
#pragma unroll
              for (int w2 = 0; w2 < 8; ++w2) tot += CNTW[w2 * 32 + F.tid];
              EBASE[F.tid] = (int)__hip_atomic_fetch_add((unsigned*)(F.ctl + CW_CURSOR + 64 * F.tid), (unsigned)tot, __ATOMIC_RELAXED, __HIP_MEMORY_SCOPE_AGENT); }
          __syncthreads();
          const int local = EBASE[myE] + base + rk;
          ROWTOK[(size_t)myE * T + local] = rb * 128 + (F.tid >> 2);
          POSOF[(size_t)rb * 512 + F.tid] = (myE << 20) | local; }
        __syncthreads();
    }
}
__device__ __forceinline__ int moe_tables(Frame& F, LAS int* texp, LAS int* tst, LAS int* ecnt) {
    if (F.tid < 32) ecnt[F.tid] = (int)__hip_atomic_load((unsigned*)(F.ctl + CW_CURSOR + 64 * F.tid), __ATOMIC_RELAXED, __HIP_MEMORY_SCOPE_AGENT);
    __syncthreads();
    if (F.tid == 0) { int run = 0; for (int e = 0; e < 32; ++e) { tst[e] = run; run += (ecnt[e] + 255) >> 8; } tst[32] = run; }
    __syncthreads();
    const int MT = tst[32];
    for (int pm = F.tid; pm < MT; pm += 512) { int e = 0;
#pragma unroll 1
        for (int k = 1; k < 32; ++k) if (tst[k] <= pm) e = k;
        texp[pm] = e; }
    __syncthreads();
    return MT;
}
__device__ __forceinline__ void p10_combine(Frame& F, const Args& args) {
    const bf16* X1 = (const bf16*)(F.ws + WS_X1); const unsigned char* Y = F.ws + WS_Y; const float* mf = (const float*)(F.ws + WS_MODF);
    const int* POSOF = (const int*)(F.ws + WS_POSOF); const float* TOPG = (const float*)(F.ws + WS_TOPG);
    const int lane = F.lane;
    LAS int* tst = (LAS int*)(F.lds + 1024); (void)moe_tables(F, (LAS int*)(F.lds + 4096), tst, (LAS int*)F.lds);
    for (int rb = F.bx; rb < T / 128; rb += F.G) {
        const int b = rb >> 5;
        f32x4 g2[4], fg[4];
#pragma unroll
        for (int i = 0; i < 4; ++i) { g2[i] = *(const f32x4*)(mf + (size_t)b * NMODW + 5 * D + 256 * i + 4 * lane); fg[i] = *(const f32x4*)(args.in[I_FNG] + 256 * i + 4 * lane); }
        int pv = POSOF[((size_t)rb * 128 + F.wave + 8 * (lane >> 2)) * 4 + (lane & 3)]; pv = tst[pv >> 20] * 256 + (pv & 0xfffff);
        const float gvv = TOPG[((size_t)rb * 128 + F.wave + 8 * (lane >> 2)) * 4 + (lane & 3)] * Y8_INV;
        v2u xw[2][4]; unsigned yw[2][4][4];
#define P10_LOAD(buf, it) do { const size_t _t = (size_t)rb * 128 + F.wave + 8 * (it); \
            _Pragma("unroll") for (int i = 0; i < 4; ++i) xw[buf][i] = *((const GAS v2u*)(X1 + _t * D) + lane + 64 * i); \
            _Pragma("unroll") for (int k = 0; k < 4; ++k) { const int _p = __builtin_amdgcn_readlane(pv, 4 * (it) + k); \
                _Pragma("unroll") for (int i = 0; i < 4; ++i) yw[buf][k][i] = *((const GAS unsigned*)(Y + (size_t)_p * D) + lane + 64 * i); } } while (0)
#define P10_ROW(buf, it) do { const size_t _t = (size_t)rb * 128 + F.wave + 8 * (it); float _g[4]; \
            _Pragma("unroll") for (int k = 0; k < 4; ++k) _g[k] = __builtin_bit_cast(float, __builtin_amdgcn_readlane(__builtin_bit_cast(int, gvv), 4 * (it) + k)); \
            f32x4 o[4]; float s = 0.f; \
            _Pragma("unroll") for (int i = 0; i < 4; ++i) { f32x4 m = {0.f, 0.f, 0.f, 0.f}; \
                _Pragma("unroll") for (int k = 0; k < 4; ++k) { const f32x2 a = __builtin_amdgcn_cvt_pk_f32_fp8(yw[buf][k][i], false), b = __builtin_amdgcn_cvt_pk_f32_fp8(yw[buf][k][i], true); \
                    m.x += _g[k] * a.x; m.y += _g[k] * a.y; m.z += _g[k] * b.x; m.w += _g[k] * b.y; } \
                const f32x4 xv = (f32x4){bflo(xw[buf][i].x), bfhi(xw[buf][i].x), bflo(xw[buf][i].y), bfhi(xw[buf][i].y)}; \
                o[i] = xv + g2[i] * m; s += (o[i].x * o[i].x + o[i].y * o[i].y) + (o[i].z * o[i].z + o[i].w * o[i].w); } \
            const float rstd = rsqrtf(wave_sum(s) * (1.0f / D) + EPS); \
            _Pragma("unroll") for (int i = 0; i < 4; ++i) *((GAS f32x4*)(F.out + _t * D) + lane + 64 * i) = o[i] * rstd * fg[i]; } while (0)
        P10_LOAD(0, 0);
#pragma unroll 1
        for (int it = 0; it < 16; it += 2) {
            P10_LOAD(1, it + 1);
            P10_ROW(0, it);
            if (it + 2 < 16) P10_LOAD(0, it + 2);
            P10_ROW(1, it + 1);
        }
#undef P10_LOAD
#undef P10_ROW
    }
}

__global__ void __launch_bounds__(NWAVES * 64, 2) hymba_fwd(Args args) {
    extern __shared__ __attribute__((aligned(16))) unsigned char lds[];
    Frame F;
    F.lds = (LAS unsigned char*)lds;
    F.MISC = (volatile LAS unsigned*)(F.lds + MISC_OFF);
    F.tid = threadIdx.x; F.lane = F.tid & 63; F.wave = __builtin_amdgcn_readfirstlane(F.tid >> 6);
    F.G = gridDim.x; F.bx = blockIdx.x;
    F.out = args.out; F.ws = args.ws; F.ctl = (gu32*)(args.ws + WS_CTL);
    for (int u = F.tid; u < (LDS_BYTES - LDSCTL_OFF) / 4; u += NWAVES * 64) ((LAS unsigned*)(F.lds + LDSCTL_OFF))[u] = 0u;
    __syncthreads();
    XcdBarrier bar; bar.bar = (unsigned*)(F.ctl + CW_BAR); bar.x = 0; bar.st = nullptr;
    if (N_LAUNCHES != PER_PHASE) bar = xcd_barrier_post((unsigned*)(F.ctl + CW_BAR) + args.li * XCD_BAR_WORDS, F.MISC + 8);
#define GRID_BAR() do { if (N_LAUNCHES != PER_PHASE) xcd_barrier(bar); } while (0)
    const int lo = args.ph_lo, hi = args.ph_hi;
#define IN(k) (lo <= (k) && (k) < hi)
#define BOTH(k) (IN(k) && IN((k) + 1))
    const PG8_LAS unsigned* gtab = (const PG8_LAS unsigned*)(F.lds + AUX_OFF);
    LAS int* texp = (LAS int*)(F.lds + AUX_OFF + AUX_TEXP);
    LAS int* tst = (LAS int*)(F.lds + AUX_OFF + AUX_UTAB + 128); LAS int* ecnt = tst + 40;

    if (IN(0)) { p0_prologue(F, args); if (BOTH(0)) GRID_BAR(); }
    if (IN(1)) { p1_norm1(F, args); if (BOTH(1)) GRID_BAR(); }
    if (IN(2)) {
        pg8::Order S; S.init(T / 256, 2048 / 256, F.G, F.bx, F.ws + WS_H, F.ws + WS_WIN, D, 0, nullptr, false);
        pg8::EpiInProj E{(bf16*)(F.ws + WS_V), (bf16*)(F.ws + WS_GG), (bf16*)(F.ws + WS_UREC)};
        pg8::gemm_phase<pg8::EpiInProj, pg8::Order, false, true, true, false>(F.lds, D, S, E, gtab);
        if (BOTH(2)) GRID_BAR();
    }
    if (IN(3)) {
        for (int ck = F.bx; ck < T / 128; ck += F.G) { lru_unit(F, args, ck); __syncthreads(); }
        for (int u = F.bx; u < T / 64; u += F.G) { conv_unit(F, args, u); __syncthreads(); }
        if (BOTH(3)) GRID_BAR();
    }
    if (IN(4)) { p4_lru_apply(F, args); if (BOTH(4)) GRID_BAR(); }
    if (IN(5)) {
        pg8::Order S; S.init(T / 256, D / 256, F.G, F.bx, F.ws + WS_H, F.ws + WS_WOUT, D, 0, nullptr, false);
        pg8::EpiOutProj E{args.in[I_X], (bf16*)(F.ws + WS_X1), (const float*)(F.ws + WS_MODF)};
        pg8::gemm_phase<pg8::EpiOutProj, pg8::Order, false, true, true, false>(F.lds, D, S, E, gtab);
        if (BOTH(5)) GRID_BAR();
    }
    if (IN(6)) { p6_router(F, args); if (BOTH(6)) GRID_BAR(); }
    if (IN(8)) {
        const int MT = moe_tables(F, texp, tst, ecnt);
        pg8::Order S; S.init(MT, 2048 / 256, F.G, F.bx, F.ws + WS_H, F.ws + WS_WGU, D / 2, (size_t)2048 * D, texp, true);
        LAS int* ut = (LAS int*)(F.lds + AUX_OFF + AUX_UTAB); LAS unsigned short* bt = (LAS unsigned short*)(F.lds + AUX_OFF + AUX_BIAS);
        { const int* ROWTOK = (const int*)(F.ws + WS_ROWTOK); pg8::Unit u; LAS unsigned* gt = (LAS unsigned*)(F.lds + AUX_OFF);
          for (int i = 0; i <= MAXU; ++i) { const bool ok = i < MAXU && S.compute(i, u); if (F.tid == 0) ut[i] = ok ? (u.pm | (u.pn << 12) | (u.e << 16)) : -1; if (!ok) break;
              if (F.tid < 256) { const int lr = (u.pm - tst[u.e]) * 256 + F.tid; gt[i * 256 + F.tid] = (lr < ecnt[u.e] ? (unsigned)ROWTOK[(size_t)u.e * T + lr] : 0u) * (unsigned)D;
                  bt[i * 256 + F.tid] = (unsigned short)f2bf(args.in[I_BGU][(size_t)u.e * 2 * DE + (F.tid < 128 ? 0 : DE - 128) + u.pn * 128 + F.tid]); } } }
        __syncthreads();
        S.utab = ut;
        pg8::EpiSwiglu E{F.ws + WS_ACT, (const PG8_LAS unsigned char*)bt};
        pg8::gemm_phase<pg8::EpiSwiglu, pg8::Order, true, true, true, true>(F.lds, D / 2, S, E, gtab);
        if (BOTH(8)) GRID_BAR();
    }
    if (IN(9)) {
        const int MT = moe_tables(F, texp, tst, ecnt);
        pg8::Order S; S.init(MT, D / 256, F.G, F.bx, F.ws + WS_ACT, F.ws + WS_WD, DE / 2, (size_t)D * DE, texp, false);
        LAS int* ut = (LAS int*)(F.lds + AUX_OFF + AUX_UTAB); LAS unsigned short* bt = (LAS unsigned short*)(F.lds + AUX_OFF + AUX_BIAS);
        { pg8::Unit u;
          for (int i = 0; i <= MAXU; ++i) { const bool ok = i < MAXU && S.compute(i, u); if (F.tid == 0) ut[i] = ok ? (u.pm | (u.pn << 12) | (u.e << 16)) : -1; if (!ok) break;
              if (F.tid < 256) bt[i * 256 + F.tid] = (unsigned short)f2bf(args.in[I_BD][(size_t)u.e * D + u.pn * 256 + F.tid]); } }
        __syncthreads();
        S.utab = ut;
        pg8::EpiDown E{F.ws + WS_Y, (const PG8_LAS unsigned char*)bt};
        pg8::gemm_phase<pg8::EpiDown, pg8::Order, false, true, true, true>(F.lds, DE / 2, S, E, gtab);
        if (BOTH(9)) GRID_BAR();
    }
    if (IN(10)) { p10_combine(F, args); }
#undef IN
#undef BOTH
}

extern "C" void kernel_launch(void* const* d_in, const int* in_sizes, int n_in, void* d_out, int out_size, void* d_ws, size_t ws_size, hipStream_t stream) {
    static int grid = 0;
    if (grid == 0) {
        if (n_in != 27 || in_sizes[0] != T * D || out_size != T * D || ws_size < WS_END) { fprintf(stderr, "kernel_launch: unexpected shapes (n_in %d, in0 %d, out %d, ws %zu); nothing launched\n", n_in, n_in > 0 ? in_sizes[0] : -1, out_size, ws_size); grid = -1; return; }
        int dev = 0, cus = 0, per_cu = 0;
        if (hipGetDevice(&dev) != hipSuccess || hipDeviceGetAttribute(&cus, hipDeviceAttributeMultiprocessorCount, dev) != hipSuccess) { grid = -1; return; }
        if (hipFuncSetAttribute((const void*)hymba_fwd, hipFuncAttributeMaxDynamicSharedMemorySize, LDS_BYTES) != hipSuccess) { fprintf(stderr, "kernel_launch: hipFuncSetAttribute failed\n"); grid = -1; return; }
        if (hipOccupancyMaxActiveBlocksPerMultiprocessor(&per_cu, (const void*)hymba_fwd, NWAVES * 64, LDS_BYTES) != hipSuccess || per_cu < 1)
            fprintf(stderr, "kernel_launch: note: occupancy query reports %d workgroups per CU\n", per_cu);
        (void)hipGetLastError();
        grid = cus;
    }
    if (grid < 0) return;
    if (hipMemsetAsync((char*)d_ws + WS_CTL, 0, CTL_ZERO_BYTES, stream) != hipSuccess) return;
    Args a{};
    for (int i = 0; i < 27; ++i) a.in[i] = (const float*)d_in[i];
    a.out = (float*)d_out; a.ws = (unsigned char*)d_ws;
    if (N_LAUNCHES == 1) { a.ph_lo = 0; a.ph_hi = PER_PHASE; a.li = 0; hipLaunchKernelGGL(hymba_fwd, dim3(grid), dim3(NWAVES * 64), LDS_BYTES, stream, a); }
    else { for (int li = 0; li < PER_PHASE; ++li) { a.ph_lo = li; a.ph_hi = li + 1; a.li = 0; hipLaunchKernelGGL(hymba_fwd, dim3(grid), dim3(NWAVES * 64), LDS_BYTES, stream, a); } }
    const hipError_t le = hipPeekAtLastError();
    if (le != hipSuccess) fprintf(stderr, "kernel_launch: launch failed: %s\n", hipGetErrorName(le));
}
```
